# Optimizing an MI355X kernel written in HIP

```python
import math
import jax, jax.numpy as jnp
from jax import lax
import numpy as np

D_MODEL = 1024
BATCH = 4
SEQ = 4096
DEPTH = 2

CHUNK = 64
NORM_EPS = 1e-6
ATT_HEADS = 8
ATT_HEAD_DIM = 64
ATT_WIDTH = ATT_HEADS * ATT_HEAD_DIM
LEFT_CHUNKS = 8
BAND_CHUNKS = LEFT_CHUNKS + 1
MAX_REL_DIST = 256
N_REL = 2 * MAX_REL_DIST + 1
MLSTM_HEADS = 4
MLSTM_HEAD_DIM = 128
MLSTM_WIDTH = MLSTM_HEADS * MLSTM_HEAD_DIM
CONV_WIDTH = 4
D_FF = 4 * D_MODEL
IN_SIZES = (ATT_WIDTH, ATT_WIDTH, ATT_WIDTH,
            MLSTM_WIDTH, MLSTM_WIDTH, MLSTM_WIDTH, MLSTM_WIDTH,
            MLSTM_HEADS, MLSTM_HEADS,
            D_MODEL, D_MODEL)
D_IN = 3 * ATT_WIDTH + 4 * MLSTM_WIDTH + 2 * MLSTM_HEADS + 2 * D_MODEL

kernel_name = "hybrid_gated_chunkattn_mlstm_block"


def rms_norm(x, g):
    xf = x.astype(jnp.float32)
    y = xf * lax.rsqrt(jnp.mean(xf * xf, axis=-1, keepdims=True) + NORM_EPS)
    return (y * g.astype(jnp.float32)).astype(x.dtype)


def causal_depthwise_conv(x, w, bias):
    c = x.shape[-1]
    out = lax.conv_general_dilated(
        x, w[:, None, :].astype(x.dtype), window_strides=(1,),
        padding=[(CONV_WIDTH - 1, 0)], dimension_numbers=('NWC', 'WIO', 'NWC'),
        feature_group_count=c)
    return out + bias.astype(x.dtype)


def chunk_band_attention(q, k, v, rel_bias):
    b, s, h, d = q.shape
    nc = s // CHUNK
    f32 = jnp.float32
    qc = q.astype(f32).reshape(b, nc, CHUNK, h, d)
    pad = ((0, 0), (LEFT_CHUNKS, 0), (0, 0), (0, 0), (0, 0))
    kp = jnp.pad(k.astype(f32).reshape(b, nc, CHUNK, h, d), pad)
    vp = jnp.pad(v.astype(f32).reshape(b, nc, CHUNK, h, d), pad)
    kband = jnp.concatenate([kp[:, j:j + nc] for j in range(BAND_CHUNKS)], axis=2)
    vband = jnp.concatenate([vp[:, j:j + nc] for j in range(BAND_CHUNKS)], axis=2)
    scores = jnp.einsum('bclhd,bckhd->bchlk', qc, kband) * (1.0 / math.sqrt(d))
    t_idx = jnp.arange(CHUNK)[:, None]
    kb_idx = jnp.arange(BAND_CHUNKS * CHUNK)[None, :]
    rel = t_idx - kb_idx + LEFT_CHUNKS * CHUNK
    rel_idx = jnp.clip(rel, -MAX_REL_DIST, MAX_REL_DIST) + MAX_REL_DIST
    bias = rel_bias.astype(f32)[:, rel_idx]
    key_chunk = jnp.arange(nc)[:, None] - LEFT_CHUNKS + kb_idx // CHUNK
    valid = key_chunk >= 0
    scores = scores + bias[None, None]
    scores = jnp.where(valid[None, :, None, None, :], scores, -1e30)
    p = jax.nn.softmax(scores, axis=-1)
    out = jnp.einsum('bchlk,bckhd->bclhd', p, vband)
    return out.reshape(b, s, h * d).astype(q.dtype)


def mlstm_chunkwise(q, k, v, i_pre, f_pre):
    b, s, h, d = q.shape
    nc = s // CHUNK
    L = CHUNK
    f32 = jnp.float32
    q = q.astype(f32).reshape(b, nc, L, h, d)
    k = k.astype(f32).reshape(b, nc, L, h, d) * (1.0 / math.sqrt(d))
    v = v.astype(f32).reshape(b, nc, L, h, d)
    ig = i_pre.astype(f32).reshape(b, nc, L, h)
    logf = jax.nn.log_sigmoid(f_pre.astype(f32)).reshape(b, nc, L, h)
    bcum = jnp.cumsum(logf, axis=2)
    b_last = bcum[:, :, -1]
    a = b_last[:, :, None] - bcum + ig
    m_loc = jnp.max(a, axis=2)
    w = jnp.exp(a - m_loc[:, :, None])
    c_loc = jnp.einsum('bclh,bclhv,bclhk->bchvk', w, v, k)
    n_loc = jnp.einsum('bclh,bclhk->bchk', w, k)

    def step(carry, xs):
        c_prev, n_prev, m_prev = carry
        c_l, n_l, m_l, bl = xs
        m_new = jnp.maximum(bl + m_prev, m_l)
        s_prev = jnp.exp(bl + m_prev - m_new)
        s_loc = jnp.exp(m_l - m_new)
        c_new = s_prev[..., None, None] * c_prev + s_loc[..., None, None] * c_l
        n_new = s_prev[..., None] * n_prev + s_loc[..., None] * n_l
        return (c_new, n_new, m_new), (c_prev, n_prev, m_prev)

    init = (jnp.zeros((b, h, d, d), f32), jnp.zeros((b, h, d), f32), jnp.zeros((b, h), f32))
    xs = (jnp.moveaxis(c_loc, 1, 0), jnp.moveaxis(n_loc, 1, 0),
          jnp.moveaxis(m_loc, 1, 0), jnp.moveaxis(b_last, 1, 0))
    _, (c_st, n_st, m_st) = lax.scan(step, init, xs)
    c_st = jnp.moveaxis(c_st, 0, 1)
    n_st = jnp.moveaxis(n_st, 0, 1)
    m_st = jnp.moveaxis(m_st, 0, 1)

    g = bcum + m_st[:, :, None]
    dmat = bcum[:, :, :, None, :] - bcum[:, :, None, :, :] + ig[:, :, None, :, :]
    causal = jnp.tril(jnp.ones((L, L), dtype=bool))
    dmat = jnp.where(causal[None, None, :, :, None], dmat, -jnp.inf)
    m_t = jnp.maximum(g, jnp.max(dmat, axis=3))
    dw = jnp.exp(dmat - m_t[:, :, :, None, :])
    qk = jnp.einsum('bcthd,bcshd->bctsh', q, k) * dw
    inter = jnp.exp(g - m_t)
    num = (inter[..., None] * jnp.einsum('bchvk,bcthk->bcthv', c_st, q)
           + jnp.einsum('bctsh,bcshv->bcthv', qk, v))
    den = inter * jnp.einsum('bchk,bcthk->bcth', n_st, q) + jnp.sum(qk, axis=3)
    hout = num / jnp.maximum(jnp.abs(den), jnp.exp(-m_t))[..., None]
    return hout.reshape(b, s, h * d)


def hybrid_layer(x, mix_norm_g, w_in, conv_w, conv_b, b_igate, b_fgate, rel_bias,
                 mh_norm_g, w_att_proj, w_mlstm_proj, w_out, ffn_norm_g, w_up, w_down):
    bsz, s, _ = x.shape
    xn = rms_norm(x, mix_norm_g)
    proj = xn @ w_in
    points = []
    acc = 0
    for size in IN_SIZES[:-1]:
        acc += size
        points.append(acc)
    aq, ak, av, mq, mk, mv, mo, ipre, fpre, ga, gm = jnp.split(proj, points, axis=-1)

    att = chunk_band_attention(
        aq.reshape(bsz, s, ATT_HEADS, ATT_HEAD_DIM),
        ak.reshape(bsz, s, ATT_HEADS, ATT_HEAD_DIM),
        av.reshape(bsz, s, ATT_HEADS, ATT_HEAD_DIM), rel_bias)

    mqk = jax.nn.silu(causal_depthwise_conv(jnp.concatenate([mq, mk], axis=-1), conv_w, conv_b))
    mq_c, mk_c = jnp.split(mqk, [MLSTM_WIDTH], axis=-1)
    hm = mlstm_chunkwise(
        mq_c.reshape(bsz, s, MLSTM_HEADS, MLSTM_HEAD_DIM),
        mk_c.reshape(bsz, s, MLSTM_HEADS, MLSTM_HEAD_DIM),
        mv.reshape(bsz, s, MLSTM_HEADS, MLSTM_HEAD_DIM),
        ipre + b_igate, fpre + b_fgate)
    hm = rms_norm(hm.reshape(bsz, s, MLSTM_HEADS, MLSTM_HEAD_DIM),
                  mh_norm_g.reshape(MLSTM_HEADS, MLSTM_HEAD_DIM)).reshape(bsz, s, MLSTM_WIDTH)
    mlstm_out = (jax.nn.sigmoid(mo.astype(jnp.float32)) * hm).astype(x.dtype)

    y = jax.nn.sigmoid(ga) * (att @ w_att_proj) + jax.nn.sigmoid(gm) * (mlstm_out @ w_mlstm_proj)
    x = x + y @ w_out

    hn = rms_norm(x, ffn_norm_g)
    x = x + jnp.square(jax.nn.relu(hn @ w_up)) @ w_down
    return x


def setup_inputs(seed: int = 0) -> dict:
    key = jax.random.key(seed)
    ks = jax.random.split(key, 16)
    f32 = jnp.float32
    nrm = lambda k, shape, scale: jax.random.normal(k, shape, f32) * scale
    return {
        "x": nrm(ks[0], (BATCH, SEQ, D_MODEL), 1.0),
        "mix_norm_g": 1.0 + nrm(ks[1], (DEPTH, D_MODEL), 0.02),
        "w_in": nrm(ks[2], (DEPTH, D_MODEL, D_IN), D_MODEL ** -0.5),
        "conv_w": nrm(ks[3], (DEPTH, CONV_WIDTH, 2 * MLSTM_WIDTH), CONV_WIDTH ** -0.5),
        "conv_b": nrm(ks[4], (DEPTH, 2 * MLSTM_WIDTH), 0.01),
        "b_igate": nrm(ks[5], (DEPTH, MLSTM_HEADS), 0.1),
        "b_fgate": 3.0 + 3.0 * jax.random.uniform(ks[6], (DEPTH, MLSTM_HEADS), f32),
        "rel_bias": nrm(ks[7], (DEPTH, ATT_HEADS, N_REL), 0.2),
        "mh_norm_g": 1.0 + nrm(ks[8], (DEPTH, MLSTM_WIDTH), 0.02),
        "w_att_proj": nrm(ks[9], (DEPTH, ATT_WIDTH, D_MODEL), ATT_WIDTH ** -0.5),
        "w_mlstm_proj": nrm(ks[10], (DEPTH, MLSTM_WIDTH, D_MODEL), MLSTM_WIDTH ** -0.5),
        "w_out": nrm(ks[11], (DEPTH, D_MODEL, D_MODEL), D_MODEL ** -0.5),
        "ffn_norm_g": 1.0 + nrm(ks[12], (DEPTH, D_MODEL), 0.02),
        "w_up": nrm(ks[13], (DEPTH, D_MODEL, D_FF), D_MODEL ** -0.5),
        "w_down": nrm(ks[14], (DEPTH, D_FF, D_MODEL), D_FF ** -0.5),
        "final_norm_g": 1.0 + nrm(ks[15], (D_MODEL,), 0.02),
    }


def reference(x, mix_norm_g, w_in, conv_w, conv_b, b_igate, b_fgate, rel_bias, mh_norm_g,
              w_att_proj, w_mlstm_proj, w_out, ffn_norm_g, w_up, w_down, final_norm_g):
    for l in range(DEPTH):
        x = hybrid_layer(x, mix_norm_g[l], w_in[l], conv_w[l], conv_b[l], b_igate[l], b_fgate[l],
                         rel_bias[l], mh_norm_g[l], w_att_proj[l], w_mlstm_proj[l], w_out[l],
                         ffn_norm_g[l], w_up[l], w_down[l])
    return rms_norm(x, final_norm_g)
```

```cpp
#include <hip/hip_runtime.h>
#include <cstdio>
#include <cstdint>
namespace pg8 {
#define PG8_LAS __attribute__((address_space(3)))
typedef unsigned short bf16_t;
typedef short bf16x8 __attribute__((ext_vector_type(8)));
typedef float f32x4 __attribute__((ext_vector_type(4)));
typedef unsigned u32x4 __attribute__((ext_vector_type(4)));
constexpr int BM = 256, BK = 64, HALF = 128, HTB = HALF * BK * 2  , STAGE_BYTES = 8 * HTB, NXCD = 8, WGM = 8;

__host__ __device__ __forceinline__ int lds_byte(int r, int c) { const int st = (r >> 4) * 2 + (c >> 5), rr = r & 15, cc = c & 31, ob = rr * 64 + cc * 2; return st * 1024 + (ob ^ (((ob >> 9) & 1) << 5)); }
__host__ __device__ __forceinline__ void stage_rc(int b, int& R, int& C) { const int st = b / 1024, sb = b % 1024, swz = sb ^ (((sb >> 9) & 1) << 5); R = (st >> 1) * 16 + swz / 64; C = (st & 1) * 32 + (swz % 64) / 2; }
__host__ __device__ __forceinline__ int perm32(int rho) { const int n = rho >> 4, i = rho & 15; return 8 * (i >> 2) + 4 * n + (i & 3); }

struct Unit { int pm, pn; };
struct Gemm { const bf16_t* A; const bf16_t* Bt; int M, N, K; };

struct StaticOrder {
    int nM, nN, nwg, G, c;
    __host__ __device__ void init(int M, int N, int G_, int c_) { nM = M / BM; nN = N / BM; nwg = nM * nN; G = G_; c = c_; }
    __host__ __device__ bool next(int i, Unit& u) const {
        const long L = (long)i * G + c; if (L >= nwg) return false;
        int wgid = (int)L; { const int q = nwg / NXCD, r = nwg % NXCD, xcd = wgid % NXCD, off = wgid / NXCD; wgid = (xcd < r ? xcd * (q + 1) : r * (q + 1) + (xcd - r) * q) + off; }
        const int nig = WGM * nN, gid = wgid / nig, fm = gid * WGM, gsz = (nM - fm) < WGM ? (nM - fm) : WGM;
        u.pm = fm + ((wgid % nig) % gsz); u.pn = (wgid % nig) / gsz; return true;
    }
    __device__ __forceinline__ void a_ready(const Unit&) const {}
    __device__ __forceinline__ void done(const Unit&) const {}
};

__device__ __forceinline__ unsigned cvt_pk_bf16(float lo, float hi) { unsigned r; asm volatile("v_cvt_pk_bf16_f32 %0, %1, %2" : "=v"(r) : "v"(lo), "v"(hi)); return r; }
__device__ __forceinline__ float bflo(unsigned w) { return __uint_as_float(w << 16); }
__device__ __forceinline__ float bfhi(unsigned w) { return __uint_as_float(w & 0xffff0000u); }
__device__ __forceinline__ float rstd_of(float ss) { return rsqrtf(ss * (1.0f / 1024.0f) + 1e-6f); }
__device__ __forceinline__ float sigm(float x) { return 1.0f / (1.0f + __expf(-x)); }
typedef unsigned u32x2 __attribute__((ext_vector_type(2)));

template <int mode> struct EpiAny {
    static constexpr bool PERM = true, AFTER_DRAIN = false;
    bf16_t* O; int ldc; const bf16_t* Z; const float* ssq_in; const float* base; float* outf; float* ssq_out;
    __device__ __forceinline__ void operator()(const f32x4 (&acc)[2][2][4][2], const Unit& u, int wr, int wc, int fr, int fq) const {
        const int row0 = u.pm * BM + wr * 64 + fr, col0 = u.pn * BM + wc * 32 + 8 * fq;
        if (mode <= 1) {
#pragma unroll
            for (int ai = 0; ai < 2; ++ai)
#pragma unroll
                for (int m = 0; m < 4; ++m) {
                    const int row = row0 + ai * HALF + m * 16; const float rs = rstd_of(ssq_in[row]);
                    bf16_t* rowp = O + (size_t)row * ldc + col0;
#pragma unroll
                    for (int bj = 0; bj < 2; ++bj) {
                        f32x4 v0 = acc[ai][bj][m][0] * rs, v1 = acc[ai][bj][m][1] * rs;
                        if (mode == 1) {
#pragma unroll
                            for (int e = 0; e < 4; ++e) { const float a = fmaxf(v0[e], 0.f), b = fmaxf(v1[e], 0.f); v0[e] = a * a; v1[e] = b * b; }
                        }
                        u32x4 w; w.x = cvt_pk_bf16(v0[0], v0[1]); w.y = cvt_pk_bf16(v0[2], v0[3]); w.z = cvt_pk_bf16(v1[0], v1[1]); w.w = cvt_pk_bf16(v1[2], v1[3]);
                        *(u32x4*)(rowp + bj * HALF) = w;
                    }
                }
        } else if (mode == 2) {
#pragma unroll
            for (int ai = 0; ai < 2; ++ai)
#pragma unroll
                for (int m = 0; m < 4; ++m) {
                    const int row = row0 + ai * HALF + m * 16; bf16_t* rowp = O + (size_t)row * ldc + col0;
#pragma unroll
                    for (int bj = 0; bj < 2; ++bj) {
                        const f32x4 v0 = acc[ai][bj][m][0], v1 = acc[ai][bj][m][1];
                        u32x4 w; w.x = cvt_pk_bf16(v0[0], v0[1]); w.y = cvt_pk_bf16(v0[2], v0[3]); w.z = cvt_pk_bf16(v1[0], v1[1]); w.w = cvt_pk_bf16(v1[2], v1[3]);
                        *(u32x4*)(rowp + bj * HALF) = w;
                    }
                }
        } else if (mode <= 4) {
#pragma unroll
            for (int ai = 0; ai < 2; ++ai)
#pragma unroll
                for (int m = 0; m < 4; ++m) {
                    const int row = row0 + ai * HALF + m * 16; const float rs = rstd_of(ssq_in[row]);
                    bf16_t* rowp = O + (size_t)row * ldc + col0; const bf16_t* zp = Z + (size_t)row * ldc + col0;
#pragma unroll
                    for (int bj = 0; bj < 2; ++bj) {
                        const f32x4 a0 = acc[ai][bj][m][0] * rs, a1 = acc[ai][bj][m][1] * rs;
                        const u32x4 y = *(const u32x4*)(rowp + bj * HALF);
                        float yv[8] = {bflo(y.x), bfhi(y.x), bflo(y.y), bfhi(y.y), bflo(y.z), bfhi(y.z), bflo(y.w), bfhi(y.w)};
                        float gv[8] = {sigm(a0[0]), sigm(a0[1]), sigm(a0[2]), sigm(a0[3]), sigm(a1[0]), sigm(a1[1]), sigm(a1[2]), sigm(a1[3])};
                        float ov[8];
                        if (mode == 3) {
#pragma unroll
                            for (int e = 0; e < 8; ++e) ov[e] = gv[e] * yv[e];
                        } else {
                            const u32x4 z = *(const u32x4*)(zp + bj * HALF);
                            float zv[8] = {bflo(z.x), bfhi(z.x), bflo(z.y), bfhi(z.y), bflo(z.z), bfhi(z.z), bflo(z.w), bfhi(z.w)};
#pragma unroll
                            for (int e = 0; e < 8; ++e) ov[e] = yv[e] + gv[e] * zv[e];
                        }
                        u32x4 w; w.x = cvt_pk_bf16(ov[0], ov[1]); w.y = cvt_pk_bf16(ov[2], ov[3]); w.z = cvt_pk_bf16(ov[4], ov[5]); w.w = cvt_pk_bf16(ov[6], ov[7]);
                        *(u32x4*)(rowp + bj * HALF) = w;
                    }
                }
        } else {
#pragma unroll
            for (int ai = 0; ai < 2; ++ai)
#pragma unroll
                for (int m = 0; m < 4; ++m) {
                    const int row = row0 + ai * HALF + m * 16; const size_t off = (size_t)row * ldc + col0; float s = 0.f;
#pragma unroll
                    for (int bj = 0; bj < 2; ++bj) {
                        const f32x4 b0 = *(const f32x4*)(base + off + bj * HALF), b1 = *(const f32x4*)(base + off + bj * HALF + 4);
                        const f32x4 o0 = b0 + acc[ai][bj][m][0], o1 = b1 + acc[ai][bj][m][1];
                        *(f32x4*)(outf + off + bj * HALF) = o0; *(f32x4*)(outf + off + bj * HALF + 4) = o1;
                        u32x4 w; w.x = cvt_pk_bf16(o0[0], o0[1]); w.y = cvt_pk_bf16(o0[2], o0[3]); w.z = cvt_pk_bf16(o1[0], o1[1]); w.w = cvt_pk_bf16(o1[2], o1[3]);
                        *(u32x4*)(O + off + bj * HALF) = w;
                        s += (o0[0] * o0[0] + o0[1] * o0[1]) + (o0[2] * o0[2] + o0[3] * o0[3]) + (o1[0] * o1[0] + o1[1] * o1[1]) + (o1[2] * o1[2] + o1[3] * o1[3]);
                    }
                    s += __shfl_xor(s, 16); s += __shfl_xor(s, 32);
                    if (fq == 0) atomicAdd(ssq_out + row, s);
                }
        }
    }
};

template <class Epi, class Sched, bool ALIGN_EPI = false, bool SP2 = false>
__device__ __forceinline__ void gemm_phase(PG8_LAS unsigned char* lds, const Gemm g, const Sched& S, const Epi& E) {
    int tid_ = threadIdx.x; asm volatile("" : "+v"(tid_));
    const int tid = tid_, wid = __builtin_amdgcn_readfirstlane(tid >> 6), lane = tid & 63, wr = wid >> 2, wc = wid & 3, fr = lane & 15, fq = lane >> 4;
    const int K = g.K, nt = K / BK;
    unsigned voffA[2], voffB[2];
#pragma unroll
    for (int i = 0; i < 2; ++i) { int R, C; stage_rc(tid * 16 + i * 8192, R, C); const int Rb = Epi::PERM ? ((R & ~31) + perm32(R & 31)) : R;
        voffA[i] = (unsigned)(R * K + C) * 2u; voffB[i] = (unsigned)(Rb * K + C) * 2u; }
    const size_t kstep = (size_t)(BK * 2);
    const size_t hstep = (size_t)HALF * K * 2;
    const size_t tstep = 2 * hstep;
    const unsigned ldsw = (unsigned)wid * 1024u;
    const int aoff = lds_byte(wr * 64 + fr, fq * 8), boff = lds_byte(wc * 32 + fr, fq * 8);
#define PG8_SA(b, h) (((b) * 2 + (h)) * HTB)
#define PG8_SB(b, h) ((4 + (b) * 2 + (h)) * HTB)
#define PG8_STAGE(bufoff, gbase, voff) do { _Pragma("unroll") for (int _i = 0; _i < 2; ++_i) \
        __builtin_amdgcn_global_load_lds((const unsigned*)((const char*)(gbase) + (voff)[_i]), (PG8_LAS unsigned*)(lds + (bufoff) + ldsw + _i * 8192), 16, 0, 0); } while (0)
#define PG8_LDA(dst, b, h) do { _Pragma("unroll") for (int m = 0; m < 4; ++m) _Pragma("unroll") for (int k = 0; k < 2; ++k) dst[m][k] = *(const PG8_LAS bf16x8*)(lds + PG8_SA(b, h) + aoff + m * 2048 + k * 1024); } while (0)
#define PG8_LDB(dst, b, h) do { _Pragma("unroll") for (int n = 0; n < 2; ++n) _Pragma("unroll") for (int k = 0; k < 2; ++k) dst[n][k] = *(const PG8_LAS bf16x8*)(lds + PG8_SB(b, h) + boff + n * 2048 + k * 1024); } while (0)
#define PG8_MMA(ai, bj, At, Bt) do { __builtin_amdgcn_s_setprio(1); _Pragma("unroll") for (int m = 0; m < 4; ++m) _Pragma("unroll") for (int n = 0; n < 2; ++n) _Pragma("unroll") for (int k = 0; k < 2; ++k) \
        acc[ai][bj][m][n] = __builtin_amdgcn_mfma_f32_16x16x32_bf16(Bt[n][k], At[m][k], acc[ai][bj][m][n], 0, 0, 0); __builtin_amdgcn_s_setprio(0); } while (0)
#define PG8_WAIT_V(n) asm volatile("s_waitcnt vmcnt(" #n ")" ::: "memory")
#define PG8_WAIT_L(n) asm volatile("s_waitcnt lgkmcnt(" #n ")" ::: "memory")
#define PG8_BAR __builtin_amdgcn_s_barrier()
#define PG8_SCHED __builtin_amdgcn_sched_barrier(0)
    Unit cur, nxt; int ui = 0;
    if (!S.next(0, cur)) return;
    f32x4 acc[2][2][4][2];
#pragma unroll
    for (int a = 0; a < 2; ++a)
#pragma unroll
        for (int b = 0; b < 2; ++b)
#pragma unroll
            for (int m = 0; m < 4; ++m)
#pragma unroll
                for (int n = 0; n < 2; ++n) acc[a][b][m][n] = (f32x4){0.f, 0.f, 0.f, 0.f};
    bf16x8 At[4][2], B0[2][2], B1[2][2];
    const char* cA = (const char*)g.A + (size_t)cur.pm * tstep; const char* cB = (const char*)g.Bt + (size_t)cur.pn * tstep;
    S.a_ready(cur);
    if constexpr (SP2) {
        PG8_STAGE(PG8_SB(0, 0), cB, voffB); PG8_STAGE(PG8_SB(0, 1), cB + hstep, voffB); PG8_STAGE(PG8_SA(0, 0), cA, voffA); PG8_STAGE(PG8_SA(0, 1), cA + hstep, voffA);
        if (wr == 1) PG8_BAR;
        PG8_WAIT_V(2); PG8_BAR;
        PG8_STAGE(PG8_SB(1, 0), cB + kstep, voffB); PG8_STAGE(PG8_SA(1, 0), cA + kstep, voffA); PG8_STAGE(PG8_SB(1, 1), cB + hstep + kstep, voffB);
        PG8_WAIT_V(6); PG8_BAR;
    } else {
        PG8_STAGE(PG8_SB(0, 0), cB, voffB); PG8_STAGE(PG8_SA(0, 0), cA, voffA); PG8_STAGE(PG8_SB(0, 1), cB + hstep, voffB); PG8_STAGE(PG8_SA(0, 1), cA + hstep, voffA);
        if (wr == 1) PG8_BAR;
        PG8_WAIT_V(4); PG8_BAR;
        PG8_STAGE(PG8_SB(1, 0), cB + kstep, voffB); PG8_STAGE(PG8_SA(1, 0), cA + kstep, voffA); PG8_STAGE(PG8_SB(1, 1), cB + hstep + kstep, voffB);
        PG8_WAIT_V(6); PG8_BAR;
    }
    for (;;) {
        const bool has_next = S.next(ui + 1, nxt);
        const char* nA = has_next ? (const char*)g.A + (size_t)nxt.pm * tstep : cA; const char* nB = has_next ? (const char*)g.Bt + (size_t)nxt.pn * tstep : cB;
        for (int t = 0; t < nt; t += 2) {
            const bool last = (t == nt - 2);
            const char* a1 = cA + (size_t)(t + 1) * kstep;
            const char* a2 = last ? nA : cA + (size_t)(t + 2) * kstep; const char* b2 = last ? nB : cB + (size_t)(t + 2) * kstep;
            const char* a3 = a2 + kstep; const char* b3 = b2 + kstep;
            if (last && has_next) S.a_ready(nxt);
            if constexpr (SP2) {
            PG8_LDB(B0, 0, 0); PG8_LDB(B1, 0, 1); PG8_SCHED; PG8_LDA(At, 0, 0); PG8_STAGE(PG8_SA(1, 1), a1 + hstep, voffA);
            PG8_WAIT_V(8); PG8_WAIT_L(0); PG8_BAR; PG8_MMA(0, 0, At, B0); PG8_MMA(0, 1, At, B1); PG8_BAR; PG8_SCHED;
            PG8_LDA(At, 0, 1); PG8_STAGE(PG8_SB(0, 0), b2, voffB); PG8_STAGE(PG8_SB(0, 1), b2 + hstep, voffB); PG8_STAGE(PG8_SA(0, 0), a2, voffA);
            PG8_WAIT_V(8); PG8_WAIT_L(0); PG8_BAR; PG8_MMA(1, 0, At, B0); PG8_MMA(1, 1, At, B1); PG8_BAR; PG8_SCHED;
            PG8_LDB(B0, 1, 0); PG8_LDB(B1, 1, 1); PG8_SCHED; PG8_LDA(At, 1, 0); PG8_STAGE(PG8_SA(0, 1), a2 + hstep, voffA);
            PG8_WAIT_V(8); PG8_WAIT_L(0); PG8_BAR; PG8_MMA(0, 0, At, B0); PG8_MMA(0, 1, At, B1); PG8_BAR; PG8_SCHED;
            PG8_LDA(At, 1, 1); PG8_STAGE(PG8_SB(1, 0), b3, voffB); PG8_STAGE(PG8_SB(1, 1), b3 + hstep, voffB); PG8_STAGE(PG8_SA(1, 0), a3, voffA);
            PG8_WAIT_V(8); PG8_WAIT_L(0); PG8_BAR; PG8_MMA(1, 0, At, B0); PG8_MMA(1, 1, At, B1); PG8_BAR; PG8_SCHED;
            } else {
            PG8_LDB(B0, 0, 0); PG8_SCHED; PG8_LDA(At, 0, 0); PG8_STAGE(PG8_SA(1, 1), a1 + hstep, voffA);
            PG8_WAIT_L(8); PG8_BAR; PG8_WAIT_L(0); PG8_MMA(0, 0, At, B0); PG8_BAR; PG8_SCHED;
            PG8_LDB(B1, 0, 1); PG8_STAGE(PG8_SB(0, 0), b2, voffB);
            PG8_BAR; PG8_WAIT_L(0); PG8_MMA(0, 1, At, B1); PG8_BAR;
            PG8_LDA(At, 0, 1); PG8_STAGE(PG8_SA(0, 0), a2, voffA);
            PG8_BAR; PG8_WAIT_L(0); PG8_MMA(1, 0, At, B0); PG8_BAR; PG8_SCHED;
            PG8_STAGE(PG8_SB(0, 1), b2 + hstep, voffB);
            PG8_WAIT_V(6); PG8_BAR; PG8_MMA(1, 1, At, B1); PG8_BAR;
            PG8_LDB(B0, 1, 0); PG8_SCHED; PG8_LDA(At, 1, 0); PG8_STAGE(PG8_SA(0, 1), a2 + hstep, voffA);
            PG8_WAIT_L(8); PG8_BAR; PG8_WAIT_L(0); PG8_MMA(0, 0, At, B0); PG8_BAR; PG8_SCHED;
            PG8_LDB(B1, 1, 1); PG8_STAGE(PG8_SB(1, 0), b3, voffB);
            PG8_BAR; PG8_WAIT_L(0); PG8_MMA(0, 1, At, B1); PG8_BAR;
            PG8_LDA(At, 1, 1); PG8_STAGE(PG8_SA(1, 0), a3, voffA);
            PG8_BAR; PG8_WAIT_L(0); PG8_MMA(1, 0, At, B0); PG8_BAR; PG8_SCHED;
            PG8_STAGE(PG8_SB(1, 1), b3 + hstep, voffB);
            PG8_WAIT_V(6); PG8_BAR; PG8_MMA(1, 1, At, B1); PG8_BAR;
            }
        }
        if constexpr (ALIGN_EPI) { if (wr == 0) PG8_BAR; }
        if constexpr (!Epi::AFTER_DRAIN) { E(acc, cur, wr, wc, fr, fq); S.done(cur); }
        if (!has_next) break;
#pragma unroll
        for (int a = 0; a < 2; ++a)
#pragma unroll
            for (int b = 0; b < 2; ++b)
#pragma unroll
                for (int m = 0; m < 4; ++m)
#pragma unroll
                    for (int n = 0; n < 2; ++n) acc[a][b][m][n] = (f32x4){0.f, 0.f, 0.f, 0.f};
        cur = nxt; cA = nA; cB = nB; ++ui;
        if constexpr (ALIGN_EPI) { if (wr == 1) PG8_BAR; }
    }
    PG8_WAIT_V(0);
    if constexpr (!ALIGN_EPI) { if (wr == 0) PG8_BAR; }
    PG8_BAR;
    if constexpr (Epi::AFTER_DRAIN) { E.fused(acc, cur, wr, wc, fr, fq, lds, wid, lane); S.done(cur); }
#undef PG8_SA
#undef PG8_SB
#undef PG8_STAGE
#undef PG8_LDA
#undef PG8_LDB
#undef PG8_MMA
#undef PG8_WAIT_V
#undef PG8_WAIT_L
#undef PG8_BAR
#undef PG8_SCHED
}
}
#define GAS __attribute__((address_space(1)))
#define LAS __attribute__((address_space(3)))
typedef unsigned short bf16;
typedef unsigned v4u __attribute__((ext_vector_type(4)));
typedef float f32x4 __attribute__((ext_vector_type(4)));
#define LDS_WAIT() asm volatile("s_waitcnt lgkmcnt(0)" ::: "memory")

#ifndef MK_ONE_LAUNCH
#define MK_ONE_LAUNCH 1
#endif

constexpr int M = 16384, DM = 1024, SEQ = 4096, NCHK = 64, CHK = 64, DFF = 4096, DIN_SRC = 5640;
constexpr int LDP = 3584;
constexpr int P_AQ = 0, P_AK = 512, P_AV = 1024, P_MQ = 1536, P_MK = 2048, P_MV = 2560, P_MO = 3072;
constexpr int NUNIT = 1024;
constexpr float EPS = 1e-6f;

constexpr size_t MiB = 1u << 20;
constexpr size_t WS_CTL = 0, CTL_ZERO_BYTES = 1 * MiB;
constexpr size_t WS_SSQ = 1 * MiB;
constexpr size_t WS_WG = 1 * MiB + 320 * 1024;
constexpr size_t WS_GATES = 1 * MiB + 512 * 1024;
constexpr size_t WS_NLOC = 2 * MiB;
constexpr size_t WS_MLOC = 2 * MiB + 512 * 1024;
constexpr size_t WS_BLAST = WS_MLOC + 4096, WS_MST = WS_BLAST + 4096;
constexpr size_t WS_W = 3 * MiB;
constexpr size_t W_IN = 0, W_A = (size_t)5632 * 1024, W_M = W_A + 512 * 1024, W_O = W_M + 512 * 1024, W_UP = W_O + 1024 * 1024, W_DN = W_UP + (size_t)4096 * 1024, W_END = W_DN + (size_t)4096 * 1024;
static_assert(WS_W + W_END * 2 <= 34 * MiB, "weights");
constexpr size_t WS_XB = 34 * MiB;
constexpr size_t WS_PROJ = 66 * MiB;
constexpr size_t WS_ATT = 178 * MiB;
constexpr size_t WS_CLOC = 194 * MiB;
constexpr size_t WS_MOUT = 226 * MiB;
constexpr size_t WS_Y = 66 * MiB, WS_Z = 98 * MiB;
constexpr size_t WS_H = 66 * MiB;
constexpr size_t WS_END = 242 * MiB;

constexpr int RING_BYTES = 131072, LDSCTL_OFF = RING_BYTES, MISC_OFF = LDSCTL_OFF + 320, LDS_BYTES = 147456;
constexpr int CW_BAR = 4096;

__device__ __forceinline__ unsigned f2bf(float f) { unsigned u = __builtin_bit_cast(unsigned, f); return (u + 0x7fffu + ((u >> 16) & 1u)) >> 16; }
__device__ __forceinline__ unsigned pk2(float lo, float hi) { return f2bf(lo) | (f2bf(hi) << 16); }
__device__ __forceinline__ float bf2f(bf16 v) { return __uint_as_float(((unsigned)v) << 16); }
__device__ __forceinline__ float blo(unsigned w) { return __uint_as_float(w << 16); }
__device__ __forceinline__ float bhi(unsigned w) { return __uint_as_float(w & 0xffff0000u); }
__device__ __forceinline__ float sigmf(float x) { return 1.0f / (1.0f + __expf(-x)); }
__device__ __forceinline__ float wave_sum(float v) {
#pragma unroll
    for (int o = 1; o < 64; o <<= 1) v += __shfl_xor(v, o);
    return v;
}

__device__ __forceinline__ void transpose_item(const float* W, int ldw, int skip_at, const float* g, bf16* WT, int K, int nblk, LAS float* scr, int item, int lane) {
    const int kb = item / nblk, nb = item % nblk, k0 = 64 * kb, n0 = 32 * nb, sc0 = n0 + (n0 >= skip_at ? 8 : 0);
#pragma unroll 8
    for (int i = 0; i < 32; ++i) { const int kk = 2 * i + (lane >> 5); const float gv = g ? g[k0 + kk] : 1.0f; scr[kk * 33 + (lane & 31)] = W[(size_t)(k0 + kk) * ldw + sc0 + (lane & 31)] * gv; }
    LDS_WAIT(); asm volatile("" ::: "memory");
    const int c = lane & 7;
#pragma unroll
    for (int j = 0; j < 4; ++j) { const int n = (lane >> 3) + 8 * j; const LAS float* s = scr + (8 * c) * 33 + n;
        v4u o; o.x = pk2(s[0 * 33], s[1 * 33]); o.y = pk2(s[2 * 33], s[3 * 33]); o.z = pk2(s[4 * 33], s[5 * 33]); o.w = pk2(s[6 * 33], s[7 * 33]);
        *(v4u*)(WT + (size_t)(n0 + n) * K + k0 + 8 * c) = o; }
    LDS_WAIT(); asm volatile("" ::: "memory");
}

__device__ __forceinline__ void attn_naive(const bf16* proj, const float* relb, bf16* att, int bid, int G, int wave, int lane) {
    for (int unit = bid; unit < 256; unit += G) {
        const int b = unit >> 6, c = unit & 63, h = wave, t = lane;
        const size_t tok = (size_t)b * SEQ + c * CHK + t;
        float q[64], acc[64];
        { const v4u* qp = (const v4u*)(proj + tok * LDP + P_AQ + h * 64);
#pragma unroll
          for (int i = 0; i < 8; ++i) { const v4u w = qp[i]; q[8 * i + 0] = blo(w.x) * 0.125f; q[8 * i + 1] = bhi(w.x) * 0.125f; q[8 * i + 2] = blo(w.y) * 0.125f; q[8 * i + 3] = bhi(w.y) * 0.125f;
              q[8 * i + 4] = blo(w.z) * 0.125f; q[8 * i + 5] = bhi(w.z) * 0.125f; q[8 * i + 6] = blo(w.w) * 0.125f; q[8 * i + 7] = bhi(w.w) * 0.125f; } }
#pragma unroll
        for (int d = 0; d < 64; ++d) acc[d] = 0.f;
        float mx = -1e30f, l = 0.f;
        const float* bh = relb + h * 513;
        for (int j = (c >= 8 ? 0 : 8 - c); j <= 8; ++j) {
            const size_t ktok0 = (size_t)b * SEQ + (size_t)(c - 8 + j) * CHK;
            for (int u = 0; u < 64; ++u) {
                int uo = u; asm volatile("" : "+v"(uo));
                const bf16* rowp = proj + (ktok0 + uo) * LDP + h * 64;
                const v4u* kp = (const v4u*)(rowp + P_AK); float s = 0.f;
#pragma unroll
                for (int i = 0; i < 8; ++i) { const v4u w = kp[i];
                    s += q[8 * i + 0] * blo(w.x) + q[8 * i + 1] * bhi(w.x) + q[8 * i + 2] * blo(w.y) + q[8 * i + 3] * bhi(w.y) + q[8 * i + 4] * blo(w.z) + q[8 * i + 5] * bhi(w.z) + q[8 * i + 6] * blo(w.w) + q[8 * i + 7] * bhi(w.w); }
                int rel = t - u + 64 * (8 - j); rel = rel < -256 ? -256 : (rel > 256 ? 256 : rel);
                s += bh[rel + 256];
                if (s > mx) { const float corr = __expf(mx - s); l *= corr;
#pragma unroll
                    for (int d = 0; d < 64; ++d) acc[d] *= corr;
                    mx = s; }
                const float p = __expf(s - mx); l += p;
                const v4u* vp = (const v4u*)(rowp + P_AV);
#pragma unroll
                for (int i = 0; i < 8; ++i) { const v4u w = vp[i];
                    acc[8 * i + 0] += p * blo(w.x); acc[8 * i + 1] += p * bhi(w.x); acc[8 * i + 2] += p * blo(w.y); acc[8 * i + 3] += p * bhi(w.y);
                    acc[8 * i + 4] += p * blo(w.z); acc[8 * i + 5] += p * bhi(w.z); acc[8 * i + 6] += p * blo(w.w); acc[8 * i + 7] += p * bhi(w.w); }
            }
        }
        const float inv = 1.0f / l;
        v4u* op = (v4u*)(att + tok * 512 + h * 64);
#pragma unroll
        for (int i = 0; i < 8; ++i) { v4u o; o.x = pk2(acc[8 * i + 0] * inv, acc[8 * i + 1] * inv); o.y = pk2(acc[8 * i + 2] * inv, acc[8 * i + 3] * inv); o.z = pk2(acc[8 * i + 4] * inv, acc[8 * i + 5] * inv); o.w = pk2(acc[8 * i + 6] * inv, acc[8 * i + 7] * inv); op[i] = o; }
    }
}

__device__ __forceinline__ void mlstm_local_naive(const bf16* proj, const float* gates, const float* cw, const float* cb, bf16* cloc, float* nloc, float* mloc, float* blast, float* lds, int bid, int G, int tid) {
    float* KS = lds; float* WV = lds + 8192; float* sm = lds + 16384;
    for (int unit = bid; unit < NUNIT; unit += G) {
        const int b = unit >> 8, c = (unit >> 2) & 63, h = unit & 3; const size_t tok0 = (size_t)b * SEQ + c * CHK;
        if (tid < 64) { sm[tid] = gates[(tok0 + tid) * 8 + 4 + h]; sm[64 + tid] = gates[(tok0 + tid) * 8 + h]; }
        __syncthreads();
        if (tid == 0) { float cum = 0.f; for (int l = 0; l < 64; ++l) { cum += sm[l]; sm[128 + l] = cum; }
            float mxa = -INFINITY; for (int l = 0; l < 64; ++l) { const float a = cum - sm[128 + l] + sm[64 + l]; sm[192 + l] = a; mxa = fmaxf(mxa, a); }
            for (int l = 0; l < 64; ++l) sm[192 + l] = __expf(sm[192 + l] - mxa);
            sm[256] = mxa; sm[257] = cum; }
        __syncthreads();
        for (int e = tid; e < 8192; e += 512) { const int l = e >> 7, d = e & 127, pos = c * CHK + l, ch = 512 + h * 128 + d;
            float a = cb[ch];
#pragma unroll
            for (int j = 0; j < 4; ++j) { const int p = pos - 3 + j; if (p >= 0) a += cw[j * 1024 + ch] * bf2f(proj[((size_t)b * SEQ + p) * LDP + P_MK + h * 128 + d]); }
            KS[e] = a * sigmf(a) * 0.08838834764831845f;
            WV[e] = sm[192 + l] * bf2f(proj[(tok0 + l) * LDP + P_MV + h * 128 + d]); }
        __syncthreads();
        { const int k = tid & 127, vg = tid >> 7; float a[32];
#pragma unroll
          for (int i = 0; i < 32; ++i) a[i] = 0.f;
          for (int l = 0; l < 64; ++l) { const float kk = KS[l * 128 + k];
#pragma unroll
              for (int i = 0; i < 32; ++i) a[i] += WV[l * 128 + vg * 32 + i] * kk; }
          bf16* cp = cloc + (size_t)unit * 16384 + (size_t)(vg * 32) * 128 + k;
#pragma unroll
          for (int i = 0; i < 32; ++i) cp[i * 128] = (bf16)f2bf(a[i]); }
        if (tid < 128) { float s = 0.f; for (int l = 0; l < 64; ++l) s += sm[192 + l] * KS[l * 128 + tid]; nloc[unit * 128 + tid] = s; }
        if (tid == 0) { mloc[unit] = sm[256]; blast[unit] = sm[257]; }
        __syncthreads();
    }
}

__device__ __forceinline__ void mlstm_scan(bf16* cloc, float* nloc, const float* mloc, const float* blast, float* mst, int bid, int G, int tid) {
    const int gt = bid * 512 + tid, NT = G * 512;
    for (int it = gt; it < 16 * 8192; it += NT) {
        const int bh = it >> 13, e2 = it & 8191, b = bh >> 2, h = bh & 3; float C0 = 0.f, C1 = 0.f, m = 0.f;
        for (int c = 0; c < NCHK; ++c) { const int unit = (b * NCHK + c) * 4 + h; const float ml = mloc[unit], bl = blast[unit];
            unsigned* p = (unsigned*)(cloc + (size_t)unit * 16384) + e2; const unsigned w = *p;
            *p = pk2(C0, C1);
            if (e2 == 0) mst[unit] = m;
            const float mn = fmaxf(bl + m, ml), sp = __expf(bl + m - mn), sl = __expf(ml - mn);
            C0 = sp * C0 + sl * blo(w); C1 = sp * C1 + sl * bhi(w); m = mn; }
    }
    for (int it = gt; it < 16 * 128; it += NT) {
        const int bh = it >> 7, k = it & 127, b = bh >> 2, h = bh & 3; float n = 0.f, m = 0.f;
        for (int c = 0; c < NCHK; ++c) { const int unit = (b * NCHK + c) * 4 + h; const float ml = mloc[unit], bl = blast[unit];
            const float nl = nloc[unit * 128 + k]; nloc[unit * 128 + k] = n;
            const float mn = fmaxf(bl + m, ml), sp = __expf(bl + m - mn), sl = __expf(ml - mn);
            n = sp * n + sl * nl; m = mn; }
    }
}

__device__ __forceinline__ void mlstm_out_naive(const bf16* proj, const float* gates, const float* cw, const float* cb, const bf16* cst, const float* nst, const float* mst, const float* mhg, bf16* mout, float* lds, int bid, int G, int tid) {
    constexpr int QP = 129, DP = 65;
    float* QS = lds; float* KS = lds + 64 * QP; float* VS = lds + 2 * 64 * QP; float* DS = VS + 8192; float* sm = DS + 64 * DP;
    for (int unit = bid; unit < NUNIT; unit += G) {
        const int b = unit >> 8, c = (unit >> 2) & 63, h = unit & 3; const size_t tok0 = (size_t)b * SEQ + c * CHK;
        for (int e = tid; e < 8192; e += 512) { const int l = e >> 7, d = e & 127, pos = c * CHK + l, chq = h * 128 + d, chk = 512 + chq;
            float aq = cb[chq], ak = cb[chk];
#pragma unroll
            for (int j = 0; j < 4; ++j) { const int p = pos - 3 + j; if (p >= 0) { const bf16* rp = proj + ((size_t)b * SEQ + p) * LDP; aq += cw[j * 1024 + chq] * bf2f(rp[P_MQ + chq]); ak += cw[j * 1024 + chk] * bf2f(rp[P_MK + chq]); } }
            QS[l * QP + d] = aq * sigmf(aq); KS[l * QP + d] = ak * sigmf(ak) * 0.08838834764831845f;
            VS[e] = bf2f(proj[(tok0 + l) * LDP + P_MV + chq]); }
        if (tid < 64) { sm[tid] = gates[(tok0 + tid) * 8 + 4 + h]; sm[64 + tid] = gates[(tok0 + tid) * 8 + h]; }
        __syncthreads();
        if (tid == 0) { float cum = 0.f, pm = -INFINITY; const float ms = mst[unit];
            for (int t = 0; t < 64; ++t) { cum += sm[t]; sm[128 + t] = cum; pm = fmaxf(pm, sm[64 + t] - cum); const float g = cum + ms, mt = fmaxf(g, cum + pm); sm[192 + t] = mt; sm[256 + t] = __expf(g - mt); } }
        __syncthreads();
        for (int e = tid; e < 4096; e += 512) { const int t = e >> 6, s = e & 63; float val = 0.f;
            if (s <= t) { float dot = 0.f;
#pragma unroll 8
                for (int d = 0; d < 128; ++d) dot += QS[t * QP + d] * KS[s * QP + d];
                val = dot * __expf(sm[128 + t] - sm[128 + s] + sm[64 + s] - sm[192 + t]); }
            DS[t * DP + s] = val; }
        __syncthreads();
        if (tid < 64) { const int t = tid; float sq = 0.f, sd = 0.f;
            for (int k = 0; k < 128; ++k) sq += nst[unit * 128 + k] * QS[t * QP + k];
            for (int s = 0; s < 64; ++s) sd += DS[t * DP + s];
            const float den = sm[256 + t] * sq + sd; sm[320 + t] = fmaxf(fabsf(den), __expf(-sm[192 + t])); }
        const int v = tid & 127, tg = tid >> 7; float a[16];
#pragma unroll
        for (int i = 0; i < 16; ++i) a[i] = 0.f;
        { const bf16* crow = cst + (size_t)unit * 16384 + (size_t)v * 128;
          for (int k = 0; k < 128; ++k) { const float cv = bf2f(crow[k]);
#pragma unroll
              for (int i = 0; i < 16; ++i) a[i] += cv * QS[(tg * 16 + i) * QP + k]; } }
#pragma unroll
        for (int i = 0; i < 16; ++i) a[i] *= sm[256 + tg * 16 + i];
        for (int s = 0; s < 64; ++s) { const float vv = VS[s * 128 + v];
#pragma unroll
            for (int i = 0; i < 16; ++i) a[i] += DS[(tg * 16 + i) * DP + s] * vv; }
        __syncthreads();
        float* HS = KS;
#pragma unroll
        for (int i = 0; i < 16; ++i) HS[(tg * 16 + i) * QP + v] = a[i] / sm[320 + tg * 16 + i];
        __syncthreads();
        if (tid < 64) { float s = 0.f; for (int k = 0; k < 128; ++k) { const float x = HS[tid * QP + k]; s += x * x; } sm[384 + tid] = rsqrtf(s * (1.0f / 128.0f) + EPS); }
        __syncthreads();
        for (int e = tid; e < 8192; e += 512) { const int t = e >> 7, vv = e & 127;
            const float mo = bf2f(proj[(tok0 + t) * LDP + P_MO + h * 128 + vv]);
            mout[(tok0 + t) * 512 + h * 128 + vv] = (bf16)f2bf(sigmf(mo) * HS[t * QP + vv] * sm[384 + t] * mhg[h * 128 + vv]); }
        __syncthreads();
    }
}

#define XB_TMO      128
#define XB_XCNT(j)  (256  + 64 * (j))
#define XB_XSUB(j)  (1280 + 64 * (j))
#define XB_XGEN(j)  (2304 + 64 * (j))
#define XB_TOP      3328
#define XB_TOPGEN   3392
#define XCD_BAR_WORDS 3456
#define XB_SPIN_CAP (1u << 18)

__device__ __forceinline__ unsigned xb_ld(unsigned* p)              { return __hip_atomic_load(p, __ATOMIC_RELAXED, __HIP_MEMORY_SCOPE_AGENT); }
__device__ __forceinline__ unsigned xb_add(unsigned* p, unsigned v) { return __hip_atomic_fetch_add(p, v, __ATOMIC_RELAXED, __HIP_MEMORY_SCOPE_AGENT); }
__device__ __forceinline__ unsigned xb_xcc_id() { return (unsigned)__builtin_amdgcn_s_getreg((3 << 11) | 20) & 0xFu; }
#define XB_SPIN(cond, bar) do { unsigned _sp = 0; while (cond) { __builtin_amdgcn_s_sleep(1); \
    if ((++_sp & 255u) == 0u) { if (xb_ld(&(bar)[XB_TMO])) break; if (_sp > XB_SPIN_CAP) { atomicAdd(&(bar)[XB_TMO], 1u); break; } } } } while (0)

struct XcdBarrier {
    unsigned* bar; unsigned x;
    volatile LAS unsigned* st;
};

__device__ __forceinline__ XcdBarrier xcd_barrier_post(unsigned* bar, volatile LAS unsigned* st) {
    XcdBarrier b; b.bar = bar; b.x = xb_xcc_id(); b.st = st;
    if (threadIdx.x == 0) (void)xb_add(&bar[XB_XCNT(b.x)], 1u);
    return b;
}
__device__ __forceinline__ void xcd_barrier_complete(unsigned* bar, unsigned x, unsigned& nloc, unsigned& nx) {
    const unsigned G = gridDim.x * gridDim.y * gridDim.z;
    unsigned sum, cnt, mine, sp = 0u;
    for (;;) {
        sum = 0u; cnt = 0u; mine = 0u;
#pragma unroll
        for (unsigned j = 0; j < 16; ++j) { const unsigned c = xb_ld(&bar[XB_XCNT(j)]); sum += c; cnt += (c > 0u) ? 1u : 0u; mine = (j == x) ? c : mine; }
        if (sum == G) break;
        __builtin_amdgcn_s_sleep(1);
        if ((++sp & 255u) == 0u) { if (xb_ld(&bar[XB_TMO])) break; if (sp > XB_SPIN_CAP) { atomicAdd(&bar[XB_TMO], 1u); break; } }
    }
    nloc = mine > 0u ? mine : 1u; nx = cnt > 0u ? cnt : 1u;
}

__device__ __forceinline__ void xcd_barrier(const XcdBarrier& b) {
    asm volatile("s_waitcnt vmcnt(0)" ::: "memory");
    __syncthreads();
    if (threadIdx.x == 0) {
        unsigned* bar = b.bar;
        __builtin_amdgcn_s_waitcnt(0);
        unsigned nloc = b.st[0], nx = b.st[1];
        if (nloc == 0u) { xcd_barrier_complete(bar, b.x, nloc, nx); b.st[0] = nloc; b.st[1] = nx; }
        const unsigned old = xb_add(&bar[XB_XSUB(b.x)], 1u);
        const unsigned gen = old / nloc;
        if (old + 1u == (gen + 1u) * nloc) {
            __builtin_amdgcn_fence(__ATOMIC_RELEASE, "agent");
            asm volatile("s_waitcnt vmcnt(0)" ::: "memory");
            const unsigned og = xb_add(&bar[XB_TOP], 1u);
            const unsigned tg = og / nx;
            if (og + 1u == (tg + 1u) * nx) xb_add(&bar[XB_TOPGEN], 1u);
            else XB_SPIN(xb_ld(&bar[XB_TOPGEN]) == tg, bar);
            __builtin_amdgcn_fence(__ATOMIC_ACQUIRE, "agent");
            xb_add(&bar[XB_XGEN(b.x)], 1u);
            asm volatile("s_waitcnt vmcnt(0)" ::: "memory");
        } else {
            XB_SPIN(xb_ld(&bar[XB_XGEN(b.x)]) == gen, bar);
            __builtin_amdgcn_fence(__ATOMIC_ACQUIRE, "agent");
            asm volatile("s_waitcnt vmcnt(0)" ::: "memory");
        }
    }
    __syncthreads();
}
constexpr int N_STEPS = 27, STEP_PRO1 = 13, STEP_FIN = 26, KPL = 13;
enum { K_PRO = 100, K_FIN = 101, K_A = 0, K_A2 = 1, K_B = 2, K_C = 3, K_D = 4, K_E1 = 5, K_E2 = 6, K_E3 = 7, K_E4 = 8, K_F = 9, K_G = 10, K_H = 11 };
struct Args { const float* in[16]; float* out; unsigned char* ws; int ph_lo, ph_hi; };

enum { SEL_ALL = 0, SEL_PRO = 1, SEL_FIN = 2, SEL_B = 3, SEL_C = 4, SEL_D = 5, SEL_GEMM = 6, SEL_GATES = 7 };
template <int SEL> __global__ void __launch_bounds__(512, 2) mk_fwd(Args args) {
    extern __shared__ __attribute__((aligned(16))) unsigned char lds[];
    const int G = gridDim.x, bid = blockIdx.x;
    {
        LAS unsigned char* ldsl0 = (LAS unsigned char*)lds;
        for (int u = threadIdx.x; u < (LDS_BYTES - LDSCTL_OFF) / 4; u += 512) ((LAS unsigned*)(ldsl0 + LDSCTL_OFF))[u] = 0u;
        __syncthreads();
    }
    XcdBarrier bar; bar.bar = (unsigned*)(args.ws + WS_CTL) + CW_BAR; bar.x = 0; bar.st = nullptr;
    if (MK_ONE_LAUNCH) bar = xcd_barrier_post((unsigned*)(args.ws + WS_CTL) + CW_BAR, (volatile LAS unsigned*)((LAS unsigned char*)lds + MISC_OFF) + 8);

    for (int step = args.ph_lo; step < args.ph_hi; ++step) {
        int tid = threadIdx.x; asm volatile("" : "+v"(tid));
        const int lane = tid & 63, wave = __builtin_amdgcn_readfirstlane(tid >> 6), gw = bid * 8 + wave, NGW = G * 8;
        unsigned char* ws = args.ws; asm volatile("" : "+s"(ws));
        int zi = 0; asm volatile("" : "+s"(zi));
#define INP(k) (args.in[(k) + zi])
        LAS unsigned char* ldsl = (LAS unsigned char*)lds;
        const float* x_in = INP(0); float* xout = args.out; asm volatile("" : "+s"(xout));
        float* ssq = (float*)(ws + WS_SSQ); float* wg = (float*)(ws + WS_WG); float* gates = (float*)(ws + WS_GATES);
        float* nloc = (float*)(ws + WS_NLOC); float* mloc = (float*)(ws + WS_MLOC); float* blast = (float*)(ws + WS_BLAST); float* mst = (float*)(ws + WS_MST);
        bf16* Wb = (bf16*)(ws + WS_W); bf16* xb = (bf16*)(ws + WS_XB); bf16* proj = (bf16*)(ws + WS_PROJ); bf16* att = (bf16*)(ws + WS_ATT);
        bf16* cloc = (bf16*)(ws + WS_CLOC); bf16* mout = (bf16*)(ws + WS_MOUT); bf16* Yb = (bf16*)(ws + WS_Y); bf16* Zb = (bf16*)(ws + WS_Z); bf16* Hb = (bf16*)(ws + WS_H);
        const int layer = step >= STEP_PRO1 ? 1 : 0;
        const int kind = (step == 0 || step == STEP_PRO1) ? K_PRO : (step == STEP_FIN ? K_FIN : (step - 1) % KPL);
        float* ssqA = ssq + (size_t)(2 * layer) * M; float* ssqF = ssq + (size_t)(2 * layer + 1) * M; float* ssqN = ssq + (size_t)(2 * layer + 2) * M;
        const float* xres = layer == 0 ? x_in : xout;

        if ((SEL == SEL_ALL || SEL == SEL_PRO) && kind == K_PRO) {
            LAS float* scr = (LAS float*)(ldsl + wave * 16384);
            const float* w_in = INP(2) + (size_t)layer * DM * DIN_SRC; const float* g_mix = INP(1) + layer * DM;
            const float* w_a = INP(9) + (size_t)layer * 512 * DM; const float* w_m = INP(10) + (size_t)layer * 512 * DM;
            const float* w_o = INP(11) + (size_t)layer * DM * DM; const float* g_ffn = INP(12) + layer * DM;
            const float* w_up = INP(13) + (size_t)layer * DM * DFF; const float* w_dn = INP(14) + (size_t)layer * DFF * DM;
            constexpr int I_IN = 16 * 176, I_A = 8 * 32, I_M = 8 * 32, I_O = 16 * 32, I_UP = 16 * 128, I_DN = 64 * 32, NITEMS = I_IN + I_A + I_M + I_O + I_UP + I_DN;
            for (int it = gw; it < NITEMS; it += NGW) {
                int r = it;
                if (r < I_IN) { transpose_item(w_in, DIN_SRC, 3584, g_mix, Wb + W_IN, 1024, 176, scr, r, lane); continue; } r -= I_IN;
                if (r < I_A) { transpose_item(w_a, DM, 1 << 30, nullptr, Wb + W_A, 512, 32, scr, r, lane); continue; } r -= I_A;
                if (r < I_M) { transpose_item(w_m, DM, 1 << 30, nullptr, Wb + W_M, 512, 32, scr, r, lane); continue; } r -= I_M;
                if (r < I_O) { transpose_item(w_o, DM, 1 << 30, nullptr, Wb + W_O, 1024, 32, scr, r, lane); continue; } r -= I_O;
                if (r < I_UP) { transpose_item(w_up, DFF, 1 << 30, g_ffn, Wb + W_UP, 1024, 128, scr, r, lane); continue; } r -= I_UP;
                transpose_item(w_dn, DM, 1 << 30, nullptr, Wb + W_DN, 4096, 32, scr, r, lane);
            }
            for (int i = bid * 512 + tid; i < 8 * 1024; i += G * 512) { const int j = i >> 10, k = i & 1023; wg[i] = g_mix[k] * w_in[(size_t)k * DIN_SRC + 3584 + j]; }
            if (layer == 0) {
                for (int i = bid * 512 + tid; i < 4 * M; i += G * 512) ssq[M + i] = 0.f;
                for (int m = gw; m < M; m += NGW) {
                    const f32x4* xr = (const f32x4*)(x_in + (size_t)m * DM) + lane; f32x4 v[4]; float s = 0.f;
#pragma unroll
                    for (int j = 0; j < 4; ++j) { v[j] = xr[64 * j]; s += (v[j].x * v[j].x + v[j].y * v[j].y) + (v[j].z * v[j].z + v[j].w * v[j].w); }
                    s = wave_sum(s); if (lane == 0) ssq[m] = s;
                    unsigned long long* o8 = (unsigned long long*)(xb + (size_t)m * DM) + lane;
#pragma unroll
                    for (int j = 0; j < 4; ++j) o8[64 * j] = (unsigned long long)pk2(v[j].x, v[j].y) | ((unsigned long long)pk2(v[j].z, v[j].w) << 32);
                }
            }
        } else if ((SEL == SEL_ALL || SEL == SEL_FIN) && kind == K_FIN) {
            const float* gf = INP(15);
            for (int m = gw; m < M; m += NGW) {
                const float rs = rsqrtf(ssqN[m] * (1.0f / 1024.0f) + EPS);
                f32x4* xr = (f32x4*)(xout + (size_t)m * DM) + lane; const f32x4* gr = (const f32x4*)gf + lane;
#pragma unroll
                for (int j = 0; j < 4; ++j) { const f32x4 v = xr[64 * j], g = gr[64 * j]; xr[64 * j] = v * rs * g; }
            }
        } else if ((SEL == SEL_ALL || SEL == SEL_B) && kind == K_B) {
            attn_naive(proj, INP(7) + (size_t)layer * 8 * 513, att, bid, G, wave, lane);
            mlstm_local_naive(proj, gates, INP(3) + (size_t)layer * 4096, INP(4) + (size_t)layer * 1024, cloc, nloc, mloc, blast, (float*)lds, bid, G, tid);
        } else if ((SEL == SEL_ALL || SEL == SEL_C) && kind == K_C) {
            mlstm_scan(cloc, nloc, mloc, blast, mst, bid, G, tid);
        } else if ((SEL == SEL_ALL || SEL == SEL_D) && kind == K_D) {
            mlstm_out_naive(proj, gates, INP(3) + (size_t)layer * 4096, INP(4) + (size_t)layer * 1024, cloc, nloc, mst, INP(8) + (size_t)layer * 512, mout, (float*)lds, bid, G, tid);
        } else if ((SEL == SEL_ALL || SEL == SEL_GEMM) && kind <= K_H && kind != K_A2) {
#ifndef GATES_ON
#define GATES_ON 1
#endif
#ifdef GEMM_ONLY
#define GEMM_ON(k) ((k) == GEMM_ONLY)
#else
#define GEMM_ON(k) true
#endif
            pg8::StaticOrder S;
#define RUN_GEMM(MODE, A_, BT_, N_, K_, O_, LDC_, Z_, SSQI_, BASE_, OUTF_, SSQO_) do { pg8::Gemm g; g.A = (A_); g.Bt = (BT_); g.M = M; g.N = (N_); g.K = (K_); \
                pg8::EpiAny<MODE> E; E.O = (O_); E.ldc = (LDC_); E.Z = (Z_); E.ssq_in = (SSQI_); E.base = (BASE_); E.outf = (OUTF_); E.ssq_out = (SSQO_); \
                S.init(M, (N_), G, bid); pg8::gemm_phase<pg8::EpiAny<MODE>, pg8::StaticOrder, true, true>(ldsl, g, S, E); } while (0)
            if (GEMM_ON(K_A) && kind == K_A)       RUN_GEMM(0, xb, Wb + W_IN, 3584, 1024, proj, LDP, nullptr, ssqA, nullptr, nullptr, nullptr);
            else if (GEMM_ON(K_E1) && kind == K_E1) RUN_GEMM(2, att, Wb + W_A, 1024, 512, Yb, 1024, nullptr, nullptr, nullptr, nullptr, nullptr);
            else if (GEMM_ON(K_E2) && kind == K_E2) RUN_GEMM(3, xb, Wb + W_IN + (size_t)3584 * 1024, 1024, 1024, Yb, 1024, nullptr, ssqA, nullptr, nullptr, nullptr);
            else if (GEMM_ON(K_E3) && kind == K_E3) RUN_GEMM(2, mout, Wb + W_M, 1024, 512, Zb, 1024, nullptr, nullptr, nullptr, nullptr, nullptr);
            else if (GEMM_ON(K_E4) && kind == K_E4) RUN_GEMM(4, xb, Wb + W_IN + (size_t)4608 * 1024, 1024, 1024, Yb, 1024, Zb, ssqA, nullptr, nullptr, nullptr);
            else if (GEMM_ON(K_F) && kind == K_F)  RUN_GEMM(5, Yb, Wb + W_O, 1024, 1024, xb, 1024, nullptr, nullptr, xres, xout, ssqF);
            else if (GEMM_ON(K_G) && kind == K_G)  RUN_GEMM(1, xb, Wb + W_UP, 4096, 1024, Hb, DFF, nullptr, ssqF, nullptr, nullptr, nullptr);
            else if (GEMM_ON(K_H)) RUN_GEMM(5, Hb, Wb + W_DN, 1024, 4096, xb, 1024, nullptr, nullptr, xout, xout, ssqN);
        } else if ((SEL == SEL_ALL || SEL == SEL_GATES) && kind == K_A2) {
                const float* bi = INP(5) + layer * 4; const float* bf_ = INP(6) + layer * 4;
                for (int m = gw; m < M; m += NGW) {
                    const f32x4* xr = (const f32x4*)(xres + (size_t)m * DM) + lane; f32x4 v[4]; float s = 0.f; float d[8];
#pragma unroll
                    for (int j = 0; j < 4; ++j) { v[j] = xr[64 * j]; s += (v[j].x * v[j].x + v[j].y * v[j].y) + (v[j].z * v[j].z + v[j].w * v[j].w); }
#pragma unroll
                    for (int q = 0; q < 8; ++q) { const f32x4* wr_ = (const f32x4*)(wg + q * 1024) + lane; float a = 0.f;
#pragma unroll
                        for (int j = 0; j < 4; ++j) { const f32x4 w = wr_[64 * j]; a += (v[j].x * w.x + v[j].y * w.y) + (v[j].z * w.z + v[j].w * w.w); }
                        d[q] = wave_sum(a); }
                    s = wave_sum(s); const float rs = rsqrtf(s * (1.0f / 1024.0f) + EPS);
                    float val = d[0];
#pragma unroll
                    for (int q = 1; q < 8; ++q) val = (lane == q) ? d[q] : val;
                    if (lane < 4) gates[(size_t)m * 8 + lane] = val * rs + bi[lane];
                    else if (lane < 8) { const float f = val * rs + bf_[lane - 4]; gates[(size_t)m * 8 + lane] = fminf(f, 0.f) - log1pf(__expf(-fabsf(f))); }
                }
        }
        const bool seam = !(kind == K_A || kind == K_E1 || kind == K_E2 || kind == K_E3);
        if (seam && step + 1 < args.ph_hi) { if (MK_ONE_LAUNCH) xcd_barrier(bar); }
    }
}

extern "C" void kernel_launch(void* const* d_in, const int* in_sizes, int n_in, void* d_out, int out_size, void* d_ws, size_t ws_size, hipStream_t stream) {
    static int grid = 0;
    if (grid == 0) {
        if (n_in != 16 || in_sizes[0] != M * DM || out_size != M * DM || ws_size < WS_END) { fprintf(stderr, "kernel_launch: unexpected shapes (n_in %d, in0 %d, out %d, ws %zu)\n", n_in, n_in > 0 ? in_sizes[0] : -1, out_size, ws_size); grid = -1; return; }
        int dev = 0, cus = 0;
        if (hipGetDevice(&dev) != hipSuccess || hipDeviceGetAttribute(&cus, hipDeviceAttributeMultiprocessorCount, dev) != hipSuccess) { grid = -1; return; }
        bool ok = true;
#if MK_ONE_LAUNCH
        ok &= hipFuncSetAttribute((const void*)mk_fwd<SEL_ALL>, hipFuncAttributeMaxDynamicSharedMemorySize, LDS_BYTES) == hipSuccess;
#endif
#if !MK_ONE_LAUNCH
        ok &= hipFuncSetAttribute((const void*)mk_fwd<SEL_PRO>, hipFuncAttributeMaxDynamicSharedMemorySize, LDS_BYTES) == hipSuccess;
        ok &= hipFuncSetAttribute((const void*)mk_fwd<SEL_FIN>, hipFuncAttributeMaxDynamicSharedMemorySize, LDS_BYTES) == hipSuccess;
        ok &= hipFuncSetAttribute((const void*)mk_fwd<SEL_B>, hipFuncAttributeMaxDynamicSharedMemorySize, LDS_BYTES) == hipSuccess;
        ok &= hipFuncSetAttribute((const void*)mk_fwd<SEL_C>, hipFuncAttributeMaxDynamicSharedMemorySize, LDS_BYTES) == hipSuccess;
        ok &= hipFuncSetAttribute((const void*)mk_fwd<SEL_D>, hipFuncAttributeMaxDynamicSharedMemorySize, LDS_BYTES) == hipSuccess;
        ok &= hipFuncSetAttribute((const void*)mk_fwd<SEL_GATES>, hipFuncAttributeMaxDynamicSharedMemorySize, LDS_BYTES) == hipSuccess;
        ok &= hipFuncSetAttribute((const void*)mk_fwd<SEL_GEMM>, hipFuncAttributeMaxDynamicSharedMemorySize, LDS_BYTES) == hipSuccess;
#endif
        if (!ok) { fprintf(stderr, "kernel_launch: hipFuncSetAttribute failed\n"); grid = -1; return; }
        (void)hipGetLastError();
        grid = cus;
    }
    if (grid < 0) return;
    if (hipMemsetAsync((char*)d_ws + WS_CTL, 0, CTL_ZERO_BYTES, stream) != hipSuccess) return;
    Args a{};
    for (int i = 0; i < 16; ++i) a.in[i] = (const float*)d_in[i];
    a.out = (float*)d_out; a.ws = (unsigned char*)d_ws;
#if MK_ONE_LAUNCH
    {
        a.ph_lo = 0; a.ph_hi = N_STEPS;
        hipLaunchKernelGGL(mk_fwd<SEL_ALL>, dim3(grid), dim3(512), LDS_BYTES, stream, a);
    }
#else
    {
        int s = 0;
        while (s < N_STEPS) {
            int e = s + 1;
            const int k = (s == 0 || s == STEP_PRO1 || s == STEP_FIN) ? -1 : (s - 1) % KPL;
            if (k == K_E1) e = s + 4;
            a.ph_lo = s; a.ph_hi = e;
            if (k == -1 && s != STEP_FIN) hipLaunchKernelGGL(mk_fwd<SEL_PRO>, dim3(grid), dim3(512), LDS_BYTES, stream, a);
            else if (k == -1) hipLaunchKernelGGL(mk_fwd<SEL_FIN>, dim3(grid), dim3(512), LDS_BYTES, stream, a);
            else if (k == K_A2) hipLaunchKernelGGL(mk_fwd<SEL_GATES>, dim3(grid), dim3(512), LDS_BYTES, stream, a);
            else if (k == K_B) hipLaunchKernelGGL(mk_fwd<SEL_B>, dim3(grid), dim3(512), LDS_BYTES, stream, a);
            else if (k == K_C) hipLaunchKernelGGL(mk_fwd<SEL_C>, dim3(grid), dim3(512), LDS_BYTES, stream, a);
            else if (k == K_D) hipLaunchKernelGGL(mk_fwd<SEL_D>, dim3(grid), dim3(512), LDS_BYTES, stream, a);
            else hipLaunchKernelGGL(mk_fwd<SEL_GEMM>, dim3(grid), dim3(512), LDS_BYTES, stream, a);
            s = e;
        }
    }
#endif
}
```

```cpp
#include <hip/hip_runtime.h>
#include <cstdio>
#include <cstdint>

namespace pg8 {
#define PG8_LAS __attribute__((address_space(3)))
typedef unsigned short bf16_t;
typedef short bf16x8 __attribute__((ext_vector_type(8)));
typedef float f32x4 __attribute__((ext_vector_type(4)));
typedef unsigned u32x4 __attribute__((ext_vector_type(4)));
constexpr int BM = 256, BK = 64, HALF = 128, HTB = HALF * BK * 2  , STAGE_BYTES = 8 * HTB, NXCD = 8, WGM = 8;

__host__ __device__ __forceinline__ int lds_byte(int r, int c) { const int st = (r >> 4) * 2 + (c >> 5), rr = r & 15, cc = c & 31, ob = rr * 64 + cc * 2; return st * 1024 + (ob ^ (((ob >> 9) & 1) << 5)); }
__host__ __device__ __forceinline__ void stage_rc(int b, int& R, int& C) { const int st = b / 1024, sb = b % 1024, swz = sb ^ (((sb >> 9) & 1) << 5); R = (st >> 1) * 16 + swz / 64; C = (st & 1) * 32 + (swz % 64) / 2; }
__host__ __device__ __forceinline__ int perm32(int rho) { const int n = rho >> 4, i = rho & 15; return 8 * (i >> 2) + 4 * n + (i & 3); }

struct Unit { int pm, pn; };
struct Gemm { const bf16_t* A; const bf16_t* Bt; int M, N, K; };

struct StaticOrder {
    int nM, nN, nwg, G, c;
    __host__ __device__ void init(int M, int N, int G_, int c_) { nM = M / BM; nN = N / BM; nwg = nM * nN; G = G_; c = c_; }
    __host__ __device__ bool next(int i, Unit& u) const {
        const long L = (long)i * G + c; if (L >= nwg) return false;
        int wgid = (int)L; { const int q = nwg / NXCD, r = nwg % NXCD, xcd = wgid % NXCD, off = wgid / NXCD; wgid = (xcd < r ? xcd * (q + 1) : r * (q + 1) + (xcd - r) * q) + off; }
        const int nig = WGM * nN, gid = wgid / nig, fm = gid * WGM, gsz = (nM - fm) < WGM ? (nM - fm) : WGM;
        u.pm = fm + ((wgid % nig) % gsz); u.pn = (wgid % nig) / gsz; return true;
    }
    __device__ __forceinline__ void a_ready(const Unit&) const {}
    __device__ __forceinline__ void done(const Unit&) const {}
};

__device__ __forceinline__ unsigned cvt_pk_bf16(float lo, float hi) { unsigned r; asm volatile("v_cvt_pk_bf16_f32 %0, %1, %2" : "=v"(r) : "v"(lo), "v"(hi)); return r; }
__device__ __forceinline__ float bflo(unsigned w) { return __uint_as_float(w << 16); }
__device__ __forceinline__ float bfhi(unsigned w) { return __uint_as_float(w & 0xffff0000u); }
__device__ __forceinline__ float rstd_of(float ss) { return rsqrtf(ss * (1.0f / 1024.0f) + 1e-6f); }
__device__ __forceinline__ float sigm(float x) { return 1.0f / (1.0f + __expf(-x)); }
typedef unsigned u32x2 __attribute__((ext_vector_type(2)));

template <int mode> struct EpiAny {
    static constexpr bool PERM = true, AFTER_DRAIN = false;
    bf16_t* O; int ldc; const bf16_t* Z; const float* ssq_in; const float* base; float* outf; float* ssq_out; bf16_t* O2; int ldc2, split;
    __device__ __forceinline__ void operator()(const f32x4 (&acc)[2][2][4][2], const Unit& u, int wr, int wc, int fr, int fq) const {
        const int row0 = u.pm * BM + wr * 64 + fr, col0 = u.pn * BM + wc * 32 + 8 * fq;
        if (mode == 6) {
            float rs[2][8];
#pragma unroll
            for (int bj = 0; bj < 2; ++bj) { const f32x4 s0 = *(const f32x4*)(ssq_in + col0 + bj * HALF), s1 = *(const f32x4*)(ssq_in + col0 + bj * HALF + 4);
#pragma unroll
                for (int e = 0; e < 4; ++e) { rs[bj][e] = rstd_of(s0[e]); rs[bj][4 + e] = rstd_of(s1[e]); } }
#pragma unroll
            for (int ai = 0; ai < 2; ++ai)
#pragma unroll
                for (int m = 0; m < 4; ++m) {
                    const int row = row0 + ai * HALF + m * 16; bf16_t* rowp = O + (size_t)row * ldc + col0;
#pragma unroll
                    for (int bj = 0; bj < 2; ++bj) {
                        const f32x4 v0 = acc[ai][bj][m][0], v1 = acc[ai][bj][m][1];
                        u32x4 w; w.x = cvt_pk_bf16(v0[0] * rs[bj][0], v0[1] * rs[bj][1]); w.y = cvt_pk_bf16(v0[2] * rs[bj][2], v0[3] * rs[bj][3]);
                        w.z = cvt_pk_bf16(v1[0] * rs[bj][4], v1[1] * rs[bj][5]); w.w = cvt_pk_bf16(v1[2] * rs[bj][6], v1[3] * rs[bj][7]);
                        *(u32x4*)(rowp + bj * HALF) = w;
                    }
                }
        } else if (mode <= 1) {
            bf16_t* ob = O; int ld = ldc, cc = col0;
            if (mode == 0 && u.pn * BM >= split) { ob = O2; ld = ldc2; cc = col0 - split; }
#pragma unroll
            for (int ai = 0; ai < 2; ++ai)
#pragma unroll
                for (int m = 0; m < 4; ++m) {
                    const int row = row0 + ai * HALF + m * 16; const float rs = rstd_of(ssq_in[row]);
                    bf16_t* rowp = ob + (size_t)row * ld + cc;
#pragma unroll
                    for (int bj = 0; bj < 2; ++bj) {
                        f32x4 v0 = acc[ai][bj][m][0] * rs, v1 = acc[ai][bj][m][1] * rs;
                        if (mode == 1) {
#pragma unroll
                            for (int e = 0; e < 4; ++e) { const float a = fmaxf(v0[e], 0.f), b = fmaxf(v1[e], 0.f); v0[e] = a * a; v1[e] = b * b; }
                        }
                        u32x4 w; w.x = cvt_pk_bf16(v0[0], v0[1]); w.y = cvt_pk_bf16(v0[2], v0[3]); w.z = cvt_pk_bf16(v1[0], v1[1]); w.w = cvt_pk_bf16(v1[2], v1[3]);
                        *(u32x4*)(rowp + bj * HALF) = w;
                    }
                }
        } else if (mode == 2) {
#pragma unroll
            for (int ai = 0; ai < 2; ++ai)
#pragma unroll
                for (int m = 0; m < 4; ++m) {
                    const int row = row0 + ai * HALF + m * 16; bf16_t* rowp = O + (size_t)row * ldc + col0;
#pragma unroll
                    for (int bj = 0; bj < 2; ++bj) {
                        const f32x4 v0 = acc[ai][bj][m][0], v1 = acc[ai][bj][m][1];
                        u32x4 w; w.x = cvt_pk_bf16(v0[0], v0[1]); w.y = cvt_pk_bf16(v0[2], v0[3]); w.z = cvt_pk_bf16(v1[0], v1[1]); w.w = cvt_pk_bf16(v1[2], v1[3]);
                        *(u32x4*)(rowp + bj * HALF) = w;
                    }
                }
        } else if (mode <= 4) {
#pragma unroll
            for (int ai = 0; ai < 2; ++ai)
#pragma unroll
                for (int m = 0; m < 4; ++m) {
                    const int row = row0 + ai * HALF + m * 16; const float rs = rstd_of(ssq_in[row]);
                    bf16_t* rowp = O + (size_t)row * ldc + col0; const bf16_t* zp = Z + (size_t)row * ldc + col0;
#pragma unroll
                    for (int bj = 0; bj < 2; ++bj) {
                        const f32x4 a0 = acc[ai][bj][m][0] * rs, a1 = acc[ai][bj][m][1] * rs;
                        const u32x4 y = *(const u32x4*)(rowp + bj * HALF);
                        float yv[8] = {bflo(y.x), bfhi(y.x), bflo(y.y), bfhi(y.y), bflo(y.z), bfhi(y.z), bflo(y.w), bfhi(y.w)};
                        float gv[8] = {sigm(a0[0]), sigm(a0[1]), sigm(a0[2]), sigm(a0[3]), sigm(a1[0]), sigm(a1[1]), sigm(a1[2]), sigm(a1[3])};
                        float ov[8];
                        if (mode == 3) {
#pragma unroll
                            for (int e = 0; e < 8; ++e) ov[e] = gv[e] * yv[e];
                        } else {
                            const u32x4 z = *(const u32x4*)(zp + bj * HALF);
                            float zv[8] = {bflo(z.x), bfhi(z.x), bflo(z.y), bfhi(z.y), bflo(z.z), bfhi(z.z), bflo(z.w), bfhi(z.w)};
#pragma unroll
                            for (int e = 0; e < 8; ++e) ov[e] = yv[e] + gv[e] * zv[e];
                        }
                        u32x4 w; w.x = cvt_pk_bf16(ov[0], ov[1]); w.y = cvt_pk_bf16(ov[2], ov[3]); w.z = cvt_pk_bf16(ov[4], ov[5]); w.w = cvt_pk_bf16(ov[6], ov[7]);
                        *(u32x4*)(rowp + bj * HALF) = w;
                    }
                }
        } else {
#pragma unroll
            for (int ai = 0; ai < 2; ++ai)
#pragma unroll
                for (int m = 0; m < 4; ++m) {
                    const int row = row0 + ai * HALF + m * 16; const size_t off = (size_t)row * ldc + col0; float s = 0.f;
#pragma unroll
                    for (int bj = 0; bj < 2; ++bj) {
                        const f32x4 b0 = *(const f32x4*)(base + off + bj * HALF), b1 = *(const f32x4*)(base + off + bj * HALF + 4);
                        const f32x4 o0 = b0 + acc[ai][bj][m][0], o1 = b1 + acc[ai][bj][m][1];
                        *(f32x4*)(outf + off + bj * HALF) = o0; *(f32x4*)(outf + off + bj * HALF + 4) = o1;
                        u32x4 w; w.x = cvt_pk_bf16(o0[0], o0[1]); w.y = cvt_pk_bf16(o0[2], o0[3]); w.z = cvt_pk_bf16(o1[0], o1[1]); w.w = cvt_pk_bf16(o1[2], o1[3]);
                        *(u32x4*)(O + off + bj * HALF) = w;
                        s += (o0[0] * o0[0] + o0[1] * o0[1]) + (o0[2] * o0[2] + o0[3] * o0[3]) + (o1[0] * o1[0] + o1[1] * o1[1]) + (o1[2] * o1[2] + o1[3] * o1[3]);
                    }
                    s += __shfl_xor(s, 16); s += __shfl_xor(s, 32);
                    if (fq == 0) atomicAdd(ssq_out + row, s);
                }
        }
    }
};

template <class Epi, class Sched, bool ALIGN_EPI = false, bool SP2 = false>
__device__ __forceinline__ void gemm_phase(PG8_LAS unsigned char* lds, const Gemm g, const Sched& S, const Epi& E) {
    int tid_ = threadIdx.x; asm volatile("" : "+v"(tid_));
    const int tid = tid_, wid = __builtin_amdgcn_readfirstlane(tid >> 6), lane = tid & 63, wr = wid >> 2, wc = wid & 3, fr = lane & 15, fq = lane >> 4;
    const int K = g.K, nt = K / BK;
    unsigned voffA[2], voffB[2];
#pragma unroll
    for (int i = 0; i < 2; ++i) { int R, C; stage_rc(tid * 16 + i * 8192, R, C); const int Rb = Epi::PERM ? ((R & ~31) + perm32(R & 31)) : R;
        voffA[i] = (unsigned)(R * K + C) * 2u; voffB[i] = (unsigned)(Rb * K + C) * 2u; }
    const size_t kstep = (size_t)(BK * 2);
    const size_t hstep = (size_t)HALF * K * 2;
    const size_t tstep = 2 * hstep;
    const unsigned ldsw = (unsigned)wid * 1024u;
    const int aoff = lds_byte(wr * 64 + fr, fq * 8), boff = lds_byte(wc * 32 + fr, fq * 8);
#define PG8_SA(b, h) (((b) * 2 + (h)) * HTB)
#define PG8_SB(b, h) ((4 + (b) * 2 + (h)) * HTB)
#define PG8_STAGE(bufoff, gbase, voff) do { _Pragma("unroll") for (int _i = 0; _i < 2; ++_i) \
        __builtin_amdgcn_global_load_lds((const unsigned*)((const char*)(gbase) + (voff)[_i]), (PG8_LAS unsigned*)(lds + (bufoff) + ldsw + _i * 8192), 16, 0, 0); } while (0)
#define PG8_LDA(dst, b, h) do { _Pragma("unroll") for (int m = 0; m < 4; ++m) _Pragma("unroll") for (int k = 0; k < 2; ++k) dst[m][k] = *(const PG8_LAS bf16x8*)(lds + PG8_SA(b, h) + aoff + m * 2048 + k * 1024); } while (0)
#define PG8_LDB(dst, b, h) do { _Pragma("unroll") for (int n = 0; n < 2; ++n) _Pragma("unroll") for (int k = 0; k < 2; ++k) dst[n][k] = *(const PG8_LAS bf16x8*)(lds + PG8_SB(b, h) + boff + n * 2048 + k * 1024); } while (0)
#define PG8_MMA(ai, bj, At, Bt) do { __builtin_amdgcn_s_setprio(1); _Pragma("unroll") for (int m = 0; m < 4; ++m) _Pragma("unroll") for (int n = 0; n < 2; ++n) _Pragma("unroll") for (int k = 0; k < 2; ++k) \
        acc[ai][bj][m][n] = __builtin_amdgcn_mfma_f32_16x16x32_bf16(Bt[n][k], At[m][k], acc[ai][bj][m][n], 0, 0, 0); __builtin_amdgcn_s_setprio(0); } while (0)
#define PG8_WAIT_V(n) asm volatile("s_waitcnt vmcnt(" #n ")" ::: "memory")
#define PG8_WAIT_L(n) asm volatile("s_waitcnt lgkmcnt(" #n ")" ::: "memory")
#define PG8_BAR __builtin_amdgcn_s_barrier()
#define PG8_SCHED __builtin_amdgcn_sched_barrier(0)
    Unit cur, nxt; int ui = 0;
    if (!S.next(0, cur)) return;
    f32x4 acc[2][2][4][2];
#pragma unroll
    for (int a = 0; a < 2; ++a)
#pragma unroll
        for (int b = 0; b < 2; ++b)
#pragma unroll
            for (int m = 0; m < 4; ++m)
#pragma unroll
                for (int n = 0; n < 2; ++n) acc[a][b][m][n] = (f32x4){0.f, 0.f, 0.f, 0.f};
    bf16x8 At[4][2], B0[2][2], B1[2][2];
    const char* cA = (const char*)g.A + (size_t)cur.pm * tstep; const char* cB = (const char*)g.Bt + (size_t)cur.pn * tstep;
    S.a_ready(cur);
    if constexpr (SP2) {
        PG8_STAGE(PG8_SB(0, 0), cB, voffB); PG8_STAGE(PG8_SB(0, 1), cB + hstep, voffB); PG8_STAGE(PG8_SA(0, 0), cA, voffA); PG8_STAGE(PG8_SA(0, 1), cA + hstep, voffA);
        if (wr == 1) PG8_BAR;
        PG8_WAIT_V(2); PG8_BAR;
        PG8_STAGE(PG8_SB(1, 0), cB + kstep, voffB); PG8_STAGE(PG8_SA(1, 0), cA + kstep, voffA); PG8_STAGE(PG8_SB(1, 1), cB + hstep + kstep, voffB);
        PG8_WAIT_V(6); PG8_BAR;
    } else {
        PG8_STAGE(PG8_SB(0, 0), cB, voffB); PG8_STAGE(PG8_SA(0, 0), cA, voffA); PG8_STAGE(PG8_SB(0, 1), cB + hstep, voffB); PG8_STAGE(PG8_SA(0, 1), cA + hstep, voffA);
        if (wr == 1) PG8_BAR;
        PG8_WAIT_V(4); PG8_BAR;
        PG8_STAGE(PG8_SB(1, 0), cB + kstep, voffB); PG8_STAGE(PG8_SA(1, 0), cA + kstep, voffA); PG8_STAGE(PG8_SB(1, 1), cB + hstep + kstep, voffB);
        PG8_WAIT_V(6); PG8_BAR;
    }
    for (;;) {
        const bool has_next = S.next(ui + 1, nxt);
        const char* nA = has_next ? (const char*)g.A + (size_t)nxt.pm * tstep : cA; const char* nB = has_next ? (const char*)g.Bt + (size_t)nxt.pn * tstep : cB;
        for (int t = 0; t < nt; t += 2) {
            const bool last = (t == nt - 2);
            const char* a1 = cA + (size_t)(t + 1) * kstep;
            const char* a2 = last ? nA : cA + (size_t)(t + 2) * kstep; const char* b2 = last ? nB : cB + (size_t)(t + 2) * kstep;
            const char* a3 = a2 + kstep; const char* b3 = b2 + kstep;
            if (last && has_next) S.a_ready(nxt);
            if constexpr (SP2) {
            PG8_LDB(B0, 0, 0); PG8_LDB(B1, 0, 1); PG8_SCHED; PG8_LDA(At, 0, 0); PG8_STAGE(PG8_SA(1, 1), a1 + hstep, voffA);
            PG8_WAIT_V(8); PG8_WAIT_L(0); PG8_BAR; PG8_MMA(0, 0, At, B0); PG8_MMA(0, 1, At, B1); PG8_BAR; PG8_SCHED;
            PG8_LDA(At, 0, 1); PG8_STAGE(PG8_SB(0, 0), b2, voffB); PG8_STAGE(PG8_SB(0, 1), b2 + hstep, voffB); PG8_STAGE(PG8_SA(0, 0), a2, voffA);
            PG8_WAIT_V(8); PG8_WAIT_L(0); PG8_BAR; PG8_MMA(1, 0, At, B0); PG8_MMA(1, 1, At, B1); PG8_BAR; PG8_SCHED;
            PG8_LDB(B0, 1, 0); PG8_LDB(B1, 1, 1); PG8_SCHED; PG8_LDA(At, 1, 0); PG8_STAGE(PG8_SA(0, 1), a2 + hstep, voffA);
            PG8_WAIT_V(8); PG8_WAIT_L(0); PG8_BAR; PG8_MMA(0, 0, At, B0); PG8_MMA(0, 1, At, B1); PG8_BAR; PG8_SCHED;
            PG8_LDA(At, 1, 1); PG8_STAGE(PG8_SB(1, 0), b3, voffB); PG8_STAGE(PG8_SB(1, 1), b3 + hstep, voffB); PG8_STAGE(PG8_SA(1, 0), a3, voffA);
            PG8_WAIT_V(8); PG8_WAIT_L(0); PG8_BAR; PG8_MMA(1, 0, At, B0); PG8_MMA(1, 1, At, B1); PG8_BAR; PG8_SCHED;
            } else {
            PG8_LDB(B0, 0, 0); PG8_SCHED; PG8_LDA(At, 0, 0); PG8_STAGE(PG8_SA(1, 1), a1 + hstep, voffA);
            PG8_WAIT_L(8); PG8_BAR; PG8_WAIT_L(0); PG8_MMA(0, 0, At, B0); PG8_BAR; PG8_SCHED;
            PG8_LDB(B1, 0, 1); PG8_STAGE(PG8_SB(0, 0), b2, voffB);
            PG8_BAR; PG8_WAIT_L(0); PG8_MMA(0, 1, At, B1); PG8_BAR;
            PG8_LDA(At, 0, 1); PG8_STAGE(PG8_SA(0, 0), a2, voffA);
            PG8_BAR; PG8_WAIT_L(0); PG8_MMA(1, 0, At, B0); PG8_BAR; PG8_SCHED;
            PG8_STAGE(PG8_SB(0, 1), b2 + hstep, voffB);
            PG8_WAIT_V(6); PG8_BAR; PG8_MMA(1, 1, At, B1); PG8_BAR;
            PG8_LDB(B0, 1, 0); PG8_SCHED; PG8_LDA(At, 1, 0); PG8_STAGE(PG8_SA(0, 1), a2 + hstep, voffA);
            PG8_WAIT_L(8); PG8_BAR; PG8_WAIT_L(0); PG8_MMA(0, 0, At, B0); PG8_BAR; PG8_SCHED;
            PG8_LDB(B1, 1, 1); PG8_STAGE(PG8_SB(1, 0), b3, voffB);
            PG8_BAR; PG8_WAIT_L(0); PG8_MMA(0, 1, At, B1); PG8_BAR;
            PG8_LDA(At, 1, 1); PG8_STAGE(PG8_SA(1, 0), a3, voffA);
            PG8_BAR; PG8_WAIT_L(0); PG8_MMA(1, 0, At, B0); PG8_BAR; PG8_SCHED;
            PG8_STAGE(PG8_SB(1, 1), b3 + hstep, voffB);
            PG8_WAIT_V(6); PG8_BAR; PG8_MMA(1, 1, At, B1); PG8_BAR;
            }
        }
        if constexpr (ALIGN_EPI) { if (wr == 0) PG8_BAR; }
        if constexpr (!Epi::AFTER_DRAIN) { E(acc, cur, wr, wc, fr, fq); S.done(cur); }
        if (!has_next) break;
#pragma unroll
        for (int a = 0; a < 2; ++a)
#pragma unroll
            for (int b = 0; b < 2; ++b)
#pragma unroll
                for (int m = 0; m < 4; ++m)
#pragma unroll
                    for (int n = 0; n < 2; ++n) acc[a][b][m][n] = (f32x4){0.f, 0.f, 0.f, 0.f};
        cur = nxt; cA = nA; cB = nB; ++ui;
        if constexpr (ALIGN_EPI) { if (wr == 1) PG8_BAR; }
    }
    PG8_WAIT_V(0);
    if constexpr (!ALIGN_EPI) { if (wr == 0) PG8_BAR; }
    PG8_BAR;
    if constexpr (Epi::AFTER_DRAIN) { E.fused(acc, cur, wr, wc, fr, fq, lds, wid, lane); S.done(cur); }
#undef PG8_SA
#undef PG8_SB
#undef PG8_STAGE
#undef PG8_LDA
#undef PG8_LDB
#undef PG8_MMA
#undef PG8_WAIT_V
#undef PG8_WAIT_L
#undef PG8_BAR
#undef PG8_SCHED
}
}
#define GAS __attribute__((address_space(1)))
#define LAS __attribute__((address_space(3)))
typedef unsigned short bf16;
typedef unsigned v4u __attribute__((ext_vector_type(4)));
typedef float f32x4 __attribute__((ext_vector_type(4)));
#define LDS_WAIT() asm volatile("s_waitcnt lgkmcnt(0)" ::: "memory")

#ifndef FAST_ATTN
#define FAST_ATTN 1
#endif
#ifndef MK_ONE_LAUNCH
#define MK_ONE_LAUNCH 1
#endif

constexpr int M = 16384, DM = 1024, SEQ = 4096, NCHK = 64, CHK = 64, DFF = 4096, DIN_SRC = 5640;
constexpr int LD1 = 1024, LD2 = 1536, N2_MQ = 0, N2_MO = 512, N2_MK = 1024, T_MK = 0, T_AV = 512, T_MV = 1024;
constexpr int NUNIT = 1024;
constexpr float EPS = 1e-6f;

constexpr size_t MiB = 1u << 20;
constexpr size_t WS_CTL = 0, CTL_ZERO_BYTES = 1 * MiB;
constexpr size_t WS_SSQ = 1 * MiB;
constexpr size_t WS_WG = 1 * MiB + 320 * 1024;
constexpr size_t WS_GATES = 1 * MiB + 512 * 1024;
constexpr size_t WS_NLOC = 2 * MiB;
constexpr size_t WS_MLOC = 2 * MiB + 512 * 1024;
constexpr size_t WS_BLAST = WS_MLOC + 4096, WS_MST = WS_BLAST + 4096;
constexpr size_t WS_W = 3 * MiB;
constexpr size_t W_IN = 0, W_A = (size_t)5632 * 1024, W_M = W_A + 512 * 1024, W_O = W_M + 512 * 1024, W_UP = W_O + 1024 * 1024, W_DN = W_UP + (size_t)4096 * 1024, W_END = W_DN + (size_t)4096 * 1024;
static_assert(WS_W + W_END * 2 <= 34 * MiB, "weights");
constexpr size_t WS_XB = 34 * MiB;
constexpr size_t WS_N1 = 66 * MiB;
constexpr size_t WS_N2 = 98 * MiB;
constexpr size_t WS_T = 146 * MiB;
constexpr size_t WS_MOUT = 146 * MiB;
constexpr size_t WS_Y = 162 * MiB;
constexpr size_t WS_Z = 66 * MiB;
constexpr size_t WS_ATT = 194 * MiB;
constexpr size_t WS_CLOC = 210 * MiB;
constexpr size_t WS_H = 66 * MiB;
constexpr size_t WS_END = 242 * MiB;

constexpr int RING_BYTES = 131072, LDSCTL_OFF = RING_BYTES, MISC_OFF = LDSCTL_OFF + 320, LDS_BYTES = 147456;
constexpr int CW_BAR = 4096;

__device__ __forceinline__ unsigned f2bf(float f) { unsigned u = __builtin_bit_cast(unsigned, f); return (u + 0x7fffu + ((u >> 16) & 1u)) >> 16; }
__device__ __forceinline__ unsigned pk2(float lo, float hi) { return f2bf(lo) | (f2bf(hi) << 16); }
__device__ __forceinline__ float bf2f(bf16 v) { return __uint_as_float(((unsigned)v) << 16); }
__device__ __forceinline__ float blo(unsigned w) { return __uint_as_float(w << 16); }
__device__ __forceinline__ float bhi(unsigned w) { return __uint_as_float(w & 0xffff0000u); }
__device__ __forceinline__ float sigmf(float x) { return 1.0f / (1.0f + __expf(-x)); }
__device__ __forceinline__ float wave_sum(float v) {
#pragma unroll
    for (int o = 1; o < 64; o <<= 1) v += __shfl_xor(v, o);
    return v;
}

__device__ __forceinline__ int win_src_col(int n0) {
    if (n0 >= 3584) return n0 + 8;
    const int blk = n0 >> 9; const int st = blk == 0 ? 0 : blk == 1 ? 512 : blk == 2 ? 1536 : blk == 3 ? 3072 : blk == 4 ? 2048 : blk == 5 ? 1024 : 2560;
    return st + (n0 & 511);
}
__device__ __forceinline__ void transpose_item(const float* W, int ldw, int is_win, const float* g, bf16* WT, int K, int nblk, LAS float* scr, int item, int lane) {
    const int kb = item / nblk, nb = item % nblk, k0 = 64 * kb, n0 = 32 * nb, sc0 = is_win ? win_src_col(n0) : n0;
#pragma unroll 8
    for (int i = 0; i < 32; ++i) { const int kk = 2 * i + (lane >> 5); const float gv = g ? g[k0 + kk] : 1.0f; scr[kk * 33 + (lane & 31)] = W[(size_t)(k0 + kk) * ldw + sc0 + (lane & 31)] * gv; }
    LDS_WAIT(); asm volatile("" ::: "memory");
    const int c = lane & 7;
#pragma unroll
    for (int j = 0; j < 4; ++j) { const int n = (lane >> 3) + 8 * j; const LAS float* s = scr + (8 * c) * 33 + n;
        v4u o; o.x = pk2(s[0 * 33], s[1 * 33]); o.y = pk2(s[2 * 33], s[3 * 33]); o.z = pk2(s[4 * 33], s[5 * 33]); o.w = pk2(s[6 * 33], s[7 * 33]);
        *(v4u*)(WT + (size_t)(n0 + n) * K + k0 + 8 * c) = o; }
    LDS_WAIT(); asm volatile("" ::: "memory");
}

__device__ __forceinline__ void attn_naive(const bf16* n1, const bf16* tT, const float* relb, bf16* att, int bid, int G, int wave, int lane) {
    for (int unit = bid; unit < 256; unit += G) {
        const int b = unit >> 6, c = unit & 63, h = wave, t = lane;
        const size_t tok = (size_t)b * SEQ + c * CHK + t;
        float q[64], acc[64];
        { const v4u* qp = (const v4u*)(n1 + tok * LD1 + h * 64);
#pragma unroll
          for (int i = 0; i < 8; ++i) { const v4u w = qp[i]; q[8 * i + 0] = blo(w.x) * 0.125f; q[8 * i + 1] = bhi(w.x) * 0.125f; q[8 * i + 2] = blo(w.y) * 0.125f; q[8 * i + 3] = bhi(w.y) * 0.125f;
              q[8 * i + 4] = blo(w.z) * 0.125f; q[8 * i + 5] = bhi(w.z) * 0.125f; q[8 * i + 6] = blo(w.w) * 0.125f; q[8 * i + 7] = bhi(w.w) * 0.125f; } }
#pragma unroll
        for (int d = 0; d < 64; ++d) acc[d] = 0.f;
        float mx = -1e30f, l = 0.f;
        const float* bh = relb + h * 513;
        for (int j = (c >= 8 ? 0 : 8 - c); j <= 8; ++j) {
            const size_t ktok0 = (size_t)b * SEQ + (size_t)(c - 8 + j) * CHK;
            for (int u = 0; u < 64; ++u) {
                int uo = u; asm volatile("" : "+v"(uo));
                const bf16* rowp = n1 + (ktok0 + uo) * LD1 + h * 64;
                const v4u* kp = (const v4u*)(rowp + 512); float s = 0.f;
#pragma unroll
                for (int i = 0; i < 8; ++i) { const v4u w = kp[i];
                    s += q[8 * i + 0] * blo(w.x) + q[8 * i + 1] * bhi(w.x) + q[8 * i + 2] * blo(w.y) + q[8 * i + 3] * bhi(w.y) + q[8 * i + 4] * blo(w.z) + q[8 * i + 5] * bhi(w.z) + q[8 * i + 6] * blo(w.w) + q[8 * i + 7] * bhi(w.w); }
                int rel = t - u + 64 * (8 - j); rel = rel < -256 ? -256 : (rel > 256 ? 256 : rel);
                s += bh[rel + 256];
                if (s > mx) { const float corr = __expf(mx - s); l *= corr;
#pragma unroll
                    for (int d = 0; d < 64; ++d) acc[d] *= corr;
                    mx = s; }
                const float p = __expf(s - mx); l += p;
                const bf16* vp = tT + (size_t)(T_AV + h * 64) * M + (ktok0 + uo);
#pragma unroll
                for (int d = 0; d < 64; ++d) acc[d] += p * bf2f(vp[(size_t)d * M]);
            }
        }
        const float inv = 1.0f / l;
        v4u* op = (v4u*)(att + tok * 512 + h * 64);
#pragma unroll
        for (int i = 0; i < 8; ++i) { v4u o; o.x = pk2(acc[8 * i + 0] * inv, acc[8 * i + 1] * inv); o.y = pk2(acc[8 * i + 2] * inv, acc[8 * i + 3] * inv); o.z = pk2(acc[8 * i + 4] * inv, acc[8 * i + 5] * inv); o.w = pk2(acc[8 * i + 6] * inv, acc[8 * i + 7] * inv); op[i] = o; }
    }
}

typedef short bf16x8_t __attribute__((ext_vector_type(8)));
typedef float f32x16_t __attribute__((ext_vector_type(16)));
__device__ __forceinline__ unsigned cvtpk(float lo, float hi) { unsigned r; asm volatile("v_cvt_pk_bf16_f32 %0, %1, %2" : "=v"(r) : "v"(lo), "v"(hi)); return r; }
__device__ __forceinline__ void attn_mfma(const bf16* n1, const bf16* tT, const float* relb, bf16* att, LAS float* ldsf, int bid, int G, int wave, int lane) {
    constexpr float LOG2E = 1.4426950408889634f, SC = 0.125f * LOG2E;
    const int h = wave, r32 = lane & 31, hi = lane >> 5;
    LAS float* ext = ldsf + wave * 384;
    for (int r = lane; r < 384; r += 64) { const int rel = r - 63; const int idx = (rel > 256 ? 256 : rel) + 256; ext[r] = relb[h * 513 + idx] * LOG2E; }
    const float bconst = relb[h * 513 + 512] * LOG2E;
    LDS_WAIT();
    const int pir = (r32 & ~12) | ((r32 & 4) << 1) | ((r32 & 8) >> 1);
    for (int unit = bid; unit < 256; unit += G) {
        const int b = unit >> 6, c = unit & 63; const size_t tq0 = (size_t)b * SEQ + c * CHK;
        bf16x8_t qf[2][4];
#pragma unroll
        for (int qb = 0; qb < 2; ++qb)
#pragma unroll
            for (int s = 0; s < 4; ++s) qf[qb][s] = *(const bf16x8_t*)(n1 + (tq0 + qb * 32 + r32) * LD1 + h * 64 + 32 * hi + 8 * s);
        f32x16_t o[2][2];
#pragma unroll
        for (int qb = 0; qb < 2; ++qb)
#pragma unroll
            for (int db = 0; db < 2; ++db)
#pragma unroll
                for (int i = 0; i < 16; ++i) o[qb][db][i] = 0.f;
        float mrun[2] = {-1e30f, -1e30f}, lrun[2] = {0.f, 0.f};
        const int kb0 = (c >= 8 ? 0 : 8 - c) * 2;
        bf16x8_t kf[4], vf[2][2];
        { const size_t ktok = (size_t)b * SEQ + (size_t)(c - 8) * CHK + (size_t)kb0 * 32;
#pragma unroll
          for (int s = 0; s < 4; ++s) kf[s] = *(const bf16x8_t*)(n1 + (ktok + pir) * LD1 + 512 + h * 64 + 32 * hi + 8 * s);
#pragma unroll
          for (int db = 0; db < 2; ++db)
#pragma unroll
              for (int s2 = 0; s2 < 2; ++s2) vf[db][s2] = *(const bf16x8_t*)(tT + (size_t)(T_AV + h * 64 + db * 32 + r32) * M + ktok + 16 * s2 + 8 * hi); }
        for (int kbI = kb0; kbI < 18; ++kbI) {
            const int j = kbI >> 1, kb = kbI & 1;
            bf16x8_t kn[4], vn[2][2];
            { const int nx = kbI + 1 < 18 ? kbI + 1 : 17; const size_t ktok = (size_t)b * SEQ + (size_t)(c - 8) * CHK + (size_t)nx * 32;
#pragma unroll
              for (int s = 0; s < 4; ++s) kn[s] = *(const bf16x8_t*)(n1 + (ktok + pir) * LD1 + 512 + h * 64 + 32 * hi + 8 * s);
#pragma unroll
              for (int db = 0; db < 2; ++db)
#pragma unroll
                  for (int s2 = 0; s2 < 2; ++s2) vn[db][s2] = *(const bf16x8_t*)(tT + (size_t)(T_AV + h * 64 + db * 32 + r32) * M + ktok + 16 * s2 + 8 * hi); }
#pragma unroll
            for (int qb = 0; qb < 2; ++qb) {
                f32x16_t sa;
#pragma unroll
                for (int i = 0; i < 16; ++i) sa[i] = 0.f;
#pragma unroll
                for (int s = 0; s < 4; ++s) sa = __builtin_amdgcn_mfma_f32_32x32x16_bf16(kf[s], qf[qb][s], sa, 0, 0, 0);
                float sv[16];
                if (j >= 4) {
                    const int rbase = (qb * 32 + r32) - (kb * 32 + 8 * hi) + 64 * (8 - j) + 63;
#pragma unroll
                    for (int i = 0; i < 16; ++i) sv[i] = sa[i] * SC + ext[rbase - (i & 7) - 16 * (i >> 3)];
                } else {
#pragma unroll
                    for (int i = 0; i < 16; ++i) sv[i] = sa[i] * SC + bconst;
                }
                float mx = sv[0];
#pragma unroll
                for (int i = 1; i < 16; ++i) mx = fmaxf(mx, sv[i]);
                mx = fmaxf(mx, __shfl_xor(mx, 32));
                const float mnew = fmaxf(mrun[qb], mx), alpha = __builtin_amdgcn_exp2f(mrun[qb] - mnew); mrun[qb] = mnew;
                float ps = 0.f;
#pragma unroll
                for (int i = 0; i < 16; ++i) { sv[i] = __builtin_amdgcn_exp2f(sv[i] - mnew); ps += sv[i]; }
                lrun[qb] = lrun[qb] * alpha + ps;
#pragma unroll
                for (int db = 0; db < 2; ++db)
#pragma unroll
                    for (int i = 0; i < 16; ++i) o[qb][db][i] *= alpha;
                bf16x8_t pf[2];
#pragma unroll
                for (int s2 = 0; s2 < 2; ++s2) { v4u w; w.x = cvtpk(sv[8 * s2 + 0], sv[8 * s2 + 1]); w.y = cvtpk(sv[8 * s2 + 2], sv[8 * s2 + 3]); w.z = cvtpk(sv[8 * s2 + 4], sv[8 * s2 + 5]); w.w = cvtpk(sv[8 * s2 + 6], sv[8 * s2 + 7]);
                    pf[s2] = __builtin_bit_cast(bf16x8_t, w); }
#pragma unroll
                for (int db = 0; db < 2; ++db)
#pragma unroll
                    for (int s2 = 0; s2 < 2; ++s2) o[qb][db] = __builtin_amdgcn_mfma_f32_32x32x16_bf16(vf[db][s2], pf[s2], o[qb][db], 0, 0, 0);
            }
#pragma unroll
            for (int s = 0; s < 4; ++s) kf[s] = kn[s];
#pragma unroll
            for (int db = 0; db < 2; ++db)
#pragma unroll
                for (int s2 = 0; s2 < 2; ++s2) vf[db][s2] = vn[db][s2];
        }
#pragma unroll
        for (int qb = 0; qb < 2; ++qb) {
            const float lt = lrun[qb] + __shfl_xor(lrun[qb], 32), inv = 1.0f / lt;
            bf16* op = att + (tq0 + qb * 32 + r32) * 512 + h * 64 + 4 * hi;
#pragma unroll
            for (int db = 0; db < 2; ++db)
#pragma unroll
                for (int g4 = 0; g4 < 4; ++g4) { unsigned long long w = (unsigned long long)cvtpk(o[qb][db][4 * g4 + 0] * inv, o[qb][db][4 * g4 + 1] * inv) | ((unsigned long long)cvtpk(o[qb][db][4 * g4 + 2] * inv, o[qb][db][4 * g4 + 3] * inv) << 32);
                    *(unsigned long long*)(op + db * 32 + 8 * g4) = w; }
        }
    }
}

__device__ __forceinline__ void mlstm_local_naive(const bf16* n2, const bf16* tT, const float* gates, const float* cw, const float* cb, bf16* cloc, float* nloc, float* mloc, float* blast, float* lds, int bid, int G, int tid) {
    float* KS = lds; float* WV = lds + 8192; float* sm = lds + 16384;
    for (int unit = bid; unit < NUNIT; unit += G) {
        const int b = unit >> 8, c = (unit >> 2) & 63, h = unit & 3; const size_t tok0 = (size_t)b * SEQ + c * CHK;
        if (tid < 64) { sm[tid] = gates[(tok0 + tid) * 8 + 4 + h]; sm[64 + tid] = gates[(tok0 + tid) * 8 + h]; }
        __syncthreads();
        if (tid == 0) { float cum = 0.f; for (int l = 0; l < 64; ++l) { cum += sm[l]; sm[128 + l] = cum; }
            float mxa = -INFINITY; for (int l = 0; l < 64; ++l) { const float a = cum - sm[128 + l] + sm[64 + l]; sm[192 + l] = a; mxa = fmaxf(mxa, a); }
            for (int l = 0; l < 64; ++l) sm[192 + l] = __expf(sm[192 + l] - mxa);
            sm[256] = mxa; sm[257] = cum; }
        __syncthreads();
        for (int e = tid; e < 8192; e += 512) { const int l = e >> 7, d = e & 127, pos = c * CHK + l, ch = 512 + h * 128 + d;
            float a = cb[ch];
#pragma unroll
            for (int j = 0; j < 4; ++j) { const int p = pos - 3 + j; if (p >= 0) a += cw[j * 1024 + ch] * bf2f(n2[((size_t)b * SEQ + p) * LD2 + N2_MK + h * 128 + d]); }
            KS[e] = a * sigmf(a) * 0.08838834764831845f;
            WV[e] = sm[192 + l] * bf2f(tT[(size_t)(T_MV + h * 128 + d) * M + tok0 + l]); }
        __syncthreads();
        { const int k = tid & 127, vg = tid >> 7; float a[32];
#pragma unroll
          for (int i = 0; i < 32; ++i) a[i] = 0.f;
          for (int l = 0; l < 64; ++l) { const float kk = KS[l * 128 + k];
#pragma unroll
              for (int i = 0; i < 32; ++i) a[i] += WV[l * 128 + vg * 32 + i] * kk; }
          bf16* cp = cloc + (size_t)unit * 16384 + (size_t)(vg * 32) * 128 + k;
#pragma unroll
          for (int i = 0; i < 32; ++i) cp[i * 128] = (bf16)f2bf(a[i]); }
        if (tid < 128) { float s = 0.f; for (int l = 0; l < 64; ++l) s += sm[192 + l] * KS[l * 128 + tid]; nloc[unit * 128 + tid] = s; }
        if (tid == 0) { mloc[unit] = sm[256]; blast[unit] = sm[257]; }
        __syncthreads();
    }
}

__device__ __forceinline__ void mlstm_scan(bf16* cloc, float* nloc, const float* mloc, const float* blast, float* mst, int bid, int G, int tid) {
    const int gt = bid * 512 + tid, NT = G * 512;
    for (int it = gt; it < 16 * 8192; it += NT) {
        const int bh = it >> 13, e2 = it & 8191, b = bh >> 2, h = bh & 3; float C0 = 0.f, C1 = 0.f, m = 0.f;
        for (int c = 0; c < NCHK; ++c) { const int unit = (b * NCHK + c) * 4 + h; const float ml = mloc[unit], bl = blast[unit];
            unsigned* p = (unsigned*)(cloc + (size_t)unit * 16384) + e2; const unsigned w = *p;
            *p = pk2(C0, C1);
            if (e2 == 0) mst[unit] = m;
            const float mn = fmaxf(bl + m, ml), sp = __expf(bl + m - mn), sl = __expf(ml - mn);
            C0 = sp * C0 + sl * blo(w); C1 = sp * C1 + sl * bhi(w); m = mn; }
    }
    for (int it = gt; it < 16 * 128; it += NT) {
        const int bh = it >> 7, k = it & 127, b = bh >> 2, h = bh & 3; float n = 0.f, m = 0.f;
        for (int c = 0; c < NCHK; ++c) { const int unit = (b * NCHK + c) * 4 + h; const float ml = mloc[unit], bl = blast[unit];
            const float nl = nloc[unit * 128 + k]; nloc[unit * 128 + k] = n;
            const float mn = fmaxf(bl + m, ml), sp = __expf(bl + m - mn), sl = __expf(ml - mn);
            n = sp * n + sl * nl; m = mn; }
    }
}

__device__ __forceinline__ void mlstm_out_naive(const bf16* n2, const bf16* tT, const float* gates, const float* cw, const float* cb, const bf16* cst, const float* nst, const float* mst, const float* mhg, bf16* mout, float* lds, int bid, int G, int tid) {
    constexpr int QP = 129, DP = 65;
    float* QS = lds; float* KS = lds + 64 * QP; float* VS = lds + 2 * 64 * QP; float* DS = VS + 8192; float* sm = DS + 64 * DP;
    for (int unit = bid; unit < NUNIT; unit += G) {
        const int b = unit >> 8, c = (unit >> 2) & 63, h = unit & 3; const size_t tok0 = (size_t)b * SEQ + c * CHK;
        for (int e = tid; e < 8192; e += 512) { const int l = e >> 7, d = e & 127, pos = c * CHK + l, chq = h * 128 + d, chk = 512 + chq;
            float aq = cb[chq], ak = cb[chk];
#pragma unroll
            for (int j = 0; j < 4; ++j) { const int p = pos - 3 + j; if (p >= 0) { const bf16* rp = n2 + ((size_t)b * SEQ + p) * LD2; aq += cw[j * 1024 + chq] * bf2f(rp[N2_MQ + chq]); ak += cw[j * 1024 + chk] * bf2f(rp[N2_MK + chq]); } }
            QS[l * QP + d] = aq * sigmf(aq); KS[l * QP + d] = ak * sigmf(ak) * 0.08838834764831845f;
            VS[e] = bf2f(tT[(size_t)(T_MV + chq) * M + tok0 + l]); }
        if (tid < 64) { sm[tid] = gates[(tok0 + tid) * 8 + 4 + h]; sm[64 + tid] = gates[(tok0 + tid) * 8 + h]; }
        __syncthreads();
        if (tid == 0) { float cum = 0.f, pm = -INFINITY; const float ms = mst[unit];
            for (int t = 0; t < 64; ++t) { cum += sm[t]; sm[128 + t] = cum; pm = fmaxf(pm, sm[64 + t] - cum); const float g = cum + ms, mt = fmaxf(g, cum + pm); sm[192 + t] = mt; sm[256 + t] = __expf(g - mt); } }
        __syncthreads();
        for (int e = tid; e < 4096; e += 512) { const int t = e >> 6, s = e & 63; float val = 0.f;
            if (s <= t) { float dot = 0.f;
#pragma unroll 8
                for (int d = 0; d < 128; ++d) dot += QS[t * QP + d] * KS[s * QP + d];
                val = dot * __expf(sm[128 + t] - sm[128 + s] + sm[64 + s] - sm[192 + t]); }
            DS[t * DP + s] = val; }
        __syncthreads();
        if (tid < 64) { const int t = tid; float sq = 0.f, sd = 0.f;
            for (int k = 0; k < 128; ++k) sq += nst[unit * 128 + k] * QS[t * QP + k];
            for (int s = 0; s < 64; ++s) sd += DS[t * DP + s];
            const float den = sm[256 + t] * sq + sd; sm[320 + t] = fmaxf(fabsf(den), __expf(-sm[192 + t])); }
        const int v = tid & 127, tg = tid >> 7; float a[16];
#pragma unroll
        for (int i = 0; i < 16; ++i) a[i] = 0.f;
        { const bf16* crow = cst + (size_t)unit * 16384 + (size_t)v * 128;
          for (int k = 0; k < 128; ++k) { const float cv = bf2f(crow[k]);
#pragma unroll
              for (int i = 0; i < 16; ++i) a[i] += cv * QS[(tg * 16 + i) * QP + k]; } }
#pragma unroll
        for (int i = 0; i < 16; ++i) a[i] *= sm[256 + tg * 16 + i];
        for (int s = 0; s < 64; ++s) { const float vv = VS[s * 128 + v];
#pragma unroll
            for (int i = 0; i < 16; ++i) a[i] += DS[(tg * 16 + i) * DP + s] * vv; }
        __syncthreads();
        float* HS = KS;
#pragma unroll
        for (int i = 0; i < 16; ++i) HS[(tg * 16 + i) * QP + v] = a[i] / sm[320 + tg * 16 + i];
        __syncthreads();
        if (tid < 64) { float s = 0.f; for (int k = 0; k < 128; ++k) { const float x = HS[tid * QP + k]; s += x * x; } sm[384 + tid] = rsqrtf(s * (1.0f / 128.0f) + EPS); }
        __syncthreads();
        for (int e = tid; e < 8192; e += 512) { const int t = e >> 7, vv = e & 127;
            const float mo = bf2f(n2[(tok0 + t) * LD2 + N2_MO + h * 128 + vv]);
            mout[(tok0 + t) * 512 + h * 128 + vv] = (bf16)f2bf(sigmf(mo) * HS[t * QP + vv] * sm[384 + t] * mhg[h * 128 + vv]); }
        __syncthreads();
    }
}

#define XB_TMO      128
#define XB_XCNT(j)  (256  + 64 * (j))
#define XB_XSUB(j)  (1280 + 64 * (j))
#define XB_XGEN(j)  (2304 + 64 * (j))
#define XB_TOP      3328
#define XB_TOPGEN   3392
#define XCD_BAR_WORDS 3456
#define XB_SPIN_CAP (1u << 18)

__device__ __forceinline__ unsigned xb_ld(unsigned* p)              { return __hip_atomic_load(p, __ATOMIC_RELAXED, __HIP_MEMORY_SCOPE_AGENT); }
__device__ __forceinline__ unsigned xb_add(unsigned* p, unsigned v) { return __hip_atomic_fetch_add(p, v, __ATOMIC_RELAXED, __HIP_MEMORY_SCOPE_AGENT); }
__device__ __forceinline__ unsigned xb_xcc_id() { return (unsigned)__builtin_amdgcn_s_getreg((3 << 11) | 20) & 0xFu; }
#define XB_SPIN(cond, bar) do { unsigned _sp = 0; while (cond) { __builtin_amdgcn_s_sleep(1); \
    if ((++_sp & 255u) == 0u) { if (xb_ld(&(bar)[XB_TMO])) break; if (_sp > XB_SPIN_CAP) { atomicAdd(&(bar)[XB_TMO], 1u); break; } } } } while (0)

struct XcdBarrier {
    unsigned* bar; unsigned x;
    volatile LAS unsigned* st;
};

__device__ __forceinline__ XcdBarrier xcd_barrier_post(unsigned* bar, volatile LAS unsigned* st) {
    XcdBarrier b; b.bar = bar; b.x = xb_xcc_id(); b.st = st;
    if (threadIdx.x == 0) (void)xb_add(&bar[XB_XCNT(b.x)], 1u);
    return b;
}
__device__ __forceinline__ void xcd_barrier_complete(unsigned* bar, unsigned x, unsigned& nloc, unsigned& nx) {
    const unsigned G = gridDim.x * gridDim.y * gridDim.z;
    unsigned sum, cnt, mine, sp = 0u;
    for (;;) {
        sum = 0u; cnt = 0u; mine = 0u;
#pragma unroll
        for (unsigned j = 0; j < 16; ++j) { const unsigned c = xb_ld(&bar[XB_XCNT(j)]); sum += c; cnt += (c > 0u) ? 1u : 0u; mine = (j == x) ? c : mine; }
        if (sum == G) break;
        __builtin_amdgcn_s_sleep(1);
        if ((++sp & 255u) == 0u) { if (xb_ld(&bar[XB_TMO])) break; if (sp > XB_SPIN_CAP) { atomicAdd(&bar[XB_TMO], 1u); break; } }
    }
    nloc = mine > 0u ? mine : 1u; nx = cnt > 0u ? cnt : 1u;
}

__device__ __forceinline__ void xcd_barrier(const XcdBarrier& b) {
    asm volatile("s_waitcnt vmcnt(0)" ::: "memory");
    __syncthreads();
    if (threadIdx.x == 0) {
        unsigned* bar = b.bar;
        __builtin_amdgcn_s_waitcnt(0);
        unsigned nloc = b.st[0], nx = b.st[1];
        if (nloc == 0u) { xcd_barrier_complete(bar, b.x, nloc, nx); b.st[0] = nloc; b.st[1] = nx; }
        const unsigned old = xb_add(&bar[XB_XSUB(b.x)], 1u);
        const unsigned gen = old / nloc;
        if (old + 1u == (gen + 1u) * nloc) {
            __builtin_amdgcn_fence(__ATOMIC_RELEASE, "agent");
            asm volatile("s_waitcnt vmcnt(0)" ::: "memory");
            const unsigned og = xb_add(&bar[XB_TOP], 1u);
            const unsigned tg = og / nx;
            if (og + 1u == (tg + 1u) * nx) xb_add(&bar[XB_TOPGEN], 1u);
            else XB_SPIN(xb_ld(&bar[XB_TOPGEN]) == tg, bar);
            __builtin_amdgcn_fence(__ATOMIC_ACQUIRE, "agent");
            xb_add(&bar[XB_XGEN(b.x)], 1u);
            asm volatile("s_waitcnt vmcnt(0)" ::: "memory");
        } else {
            XB_SPIN(xb_ld(&bar[XB_XGEN(b.x)]) == gen, bar);
            __builtin_amdgcn_fence(__ATOMIC_ACQUIRE, "agent");
            asm volatile("s_waitcnt vmcnt(0)" ::: "memory");
        }
    }
    __syncthreads();
}
constexpr int N_STEPS = 27, STEP_PRO1 = 13, STEP_FIN = 26, KPL = 13;
enum { K_PRO = 100, K_FIN = 101, K_A = 0, K_A2 = 1, K_B = 2, K_C = 3, K_D = 4, K_E1 = 5, K_E2 = 6, K_E3 = 7, K_E4 = 8, K_F = 9, K_G = 10, K_H = 11 };
struct Args { const float* in[16]; float* out; unsigned char* ws; int ph_lo, ph_hi; };

enum { SEL_ALL = 0, SEL_PRO = 1, SEL_FIN = 2, SEL_B = 3, SEL_C = 4, SEL_D = 5, SEL_GEMM = 6, SEL_GATES = 7 };
template <int SEL> __global__ void __launch_bounds__(512, 2) mk_fwd(Args args) {
    extern __shared__ __attribute__((aligned(16))) unsigned char lds[];
    const int G = gridDim.x, bid = blockIdx.x;
    {
        LAS unsigned char* ldsl0 = (LAS unsigned char*)lds;
        for (int u = threadIdx.x; u < (LDS_BYTES - LDSCTL_OFF) / 4; u += 512) ((LAS unsigned*)(ldsl0 + LDSCTL_OFF))[u] = 0u;
        __syncthreads();
    }
    XcdBarrier bar; bar.bar = (unsigned*)(args.ws + WS_CTL) + CW_BAR; bar.x = 0; bar.st = nullptr;
    if (MK_ONE_LAUNCH) bar = xcd_barrier_post((unsigned*)(args.ws + WS_CTL) + CW_BAR, (volatile LAS unsigned*)((LAS unsigned char*)lds + MISC_OFF) + 8);

    int prep = 0;
    for (int step = args.ph_lo; step < args.ph_hi;) {
        int tid = threadIdx.x; asm volatile("" : "+v"(tid));
        const int lane = tid & 63, wave = __builtin_amdgcn_readfirstlane(tid >> 6), gw = bid * 8 + wave, NGW = G * 8;
        unsigned char* ws = args.ws; asm volatile("" : "+s"(ws));
        int zi = 0; asm volatile("" : "+s"(zi));
#define INP(k) (args.in[(k) + zi])
        LAS unsigned char* ldsl = (LAS unsigned char*)lds;
        const float* x_in = INP(0); float* xout = args.out; asm volatile("" : "+s"(xout));
        float* ssq = (float*)(ws + WS_SSQ); float* wg = (float*)(ws + WS_WG); float* gates = (float*)(ws + WS_GATES);
        float* nloc = (float*)(ws + WS_NLOC); float* mloc = (float*)(ws + WS_MLOC); float* blast = (float*)(ws + WS_BLAST); float* mst = (float*)(ws + WS_MST);
        bf16* Wb = (bf16*)(ws + WS_W); bf16* xb = (bf16*)(ws + WS_XB); bf16* n1 = (bf16*)(ws + WS_N1); bf16* n2 = (bf16*)(ws + WS_N2); bf16* tT = (bf16*)(ws + WS_T); bf16* att = (bf16*)(ws + WS_ATT);
        bf16* cloc = (bf16*)(ws + WS_CLOC); bf16* mout = (bf16*)(ws + WS_MOUT); bf16* Yb = (bf16*)(ws + WS_Y); bf16* Zb = (bf16*)(ws + WS_Z); bf16* Hb = (bf16*)(ws + WS_H);
        const int layer = step >= STEP_PRO1 ? 1 : 0;
        const int kind = (step == 0 || step == STEP_PRO1) ? K_PRO : (step == STEP_FIN ? K_FIN : (step - 1) % KPL);
        float* ssqA = ssq + (size_t)(2 * layer) * M; float* ssqF = ssq + (size_t)(2 * layer + 1) * M; float* ssqN = ssq + (size_t)(2 * layer + 2) * M;
        const float* xres = layer == 0 ? x_in : xout;

        if ((SEL == SEL_ALL || SEL == SEL_PRO) && kind == K_PRO) {
            LAS float* scr = (LAS float*)(ldsl + wave * 16384);
            const float* w_in = INP(2) + (size_t)layer * DM * DIN_SRC; const float* g_mix = INP(1) + layer * DM;
            const float* w_a = INP(9) + (size_t)layer * 512 * DM; const float* w_m = INP(10) + (size_t)layer * 512 * DM;
            const float* w_o = INP(11) + (size_t)layer * DM * DM; const float* g_ffn = INP(12) + layer * DM;
            const float* w_up = INP(13) + (size_t)layer * DM * DFF; const float* w_dn = INP(14) + (size_t)layer * DFF * DM;
            constexpr int I_IN = 16 * 176, I_A = 8 * 32, I_M = 8 * 32, I_O = 16 * 32, I_UP = 16 * 128, I_DN = 64 * 32, NITEMS = I_IN + I_A + I_M + I_O + I_UP + I_DN;
            for (int it = gw; it < NITEMS; it += NGW) {
                int r = it;
                if (r < I_IN) { transpose_item(w_in, DIN_SRC, 1, g_mix, Wb + W_IN, 1024, 176, scr, r, lane); continue; } r -= I_IN;
                if (r < I_A) { transpose_item(w_a, DM, 0, nullptr, Wb + W_A, 512, 32, scr, r, lane); continue; } r -= I_A;
                if (r < I_M) { transpose_item(w_m, DM, 0, nullptr, Wb + W_M, 512, 32, scr, r, lane); continue; } r -= I_M;
                if (r < I_O) { transpose_item(w_o, DM, 0, nullptr, Wb + W_O, 1024, 32, scr, r, lane); continue; } r -= I_O;
                if (r < I_UP) { transpose_item(w_up, DFF, 0, g_ffn, Wb + W_UP, 1024, 128, scr, r, lane); continue; } r -= I_UP;
                transpose_item(w_dn, DM, 0, nullptr, Wb + W_DN, 4096, 32, scr, r, lane);
            }
            for (int i = bid * 512 + tid; i < 8 * 1024; i += G * 512) { const int j = i >> 10, k = i & 1023; wg[i] = g_mix[k] * w_in[(size_t)k * DIN_SRC + 3584 + j]; }
            if (layer == 0) {
                for (int i = bid * 512 + tid; i < 4 * M; i += G * 512) ssq[M + i] = 0.f;
                for (int m = gw; m < M; m += NGW) {
                    const f32x4* xr = (const f32x4*)(x_in + (size_t)m * DM) + lane; f32x4 v[4]; float s = 0.f;
#pragma unroll
                    for (int j = 0; j < 4; ++j) { v[j] = xr[64 * j]; s += (v[j].x * v[j].x + v[j].y * v[j].y) + (v[j].z * v[j].z + v[j].w * v[j].w); }
                    s = wave_sum(s); if (lane == 0) ssq[m] = s;
                    unsigned long long* o8 = (unsigned long long*)(xb + (size_t)m * DM) + lane;
#pragma unroll
                    for (int j = 0; j < 4; ++j) o8[64 * j] = (unsigned long long)pk2(v[j].x, v[j].y) | ((unsigned long long)pk2(v[j].z, v[j].w) << 32);
                }
            }
        } else if ((SEL == SEL_ALL || SEL == SEL_FIN) && kind == K_FIN) {
            const float* gf = INP(15);
            for (int m = gw; m < M; m += NGW) {
                const float rs = rsqrtf(ssqN[m] * (1.0f / 1024.0f) + EPS);
                f32x4* xr = (f32x4*)(xout + (size_t)m * DM) + lane; const f32x4* gr = (const f32x4*)gf + lane;
#pragma unroll
                for (int j = 0; j < 4; ++j) { const f32x4 v = xr[64 * j], g = gr[64 * j]; xr[64 * j] = v * rs * g; }
            }
        } else if ((SEL == SEL_ALL || SEL == SEL_B) && kind == K_B) {
#if FAST_ATTN
            attn_mfma(n1, tT, INP(7) + (size_t)layer * 8 * 513, att, (LAS float*)ldsl, bid, G, wave, lane);
            __syncthreads();
#else
            attn_naive(n1, tT, INP(7) + (size_t)layer * 8 * 513, att, bid, G, wave, lane);
#endif
            mlstm_local_naive(n2, tT, gates, INP(3) + (size_t)layer * 4096, INP(4) + (size_t)layer * 1024, cloc, nloc, mloc, blast, (float*)lds, bid, G, tid);
        } else if ((SEL == SEL_ALL || SEL == SEL_C) && kind == K_C) {
            mlstm_scan(cloc, nloc, mloc, blast, mst, bid, G, tid);
        } else if ((SEL == SEL_ALL || SEL == SEL_D) && kind == K_D) {
            mlstm_out_naive(n2, tT, gates, INP(3) + (size_t)layer * 4096, INP(4) + (size_t)layer * 1024, cloc, nloc, mst, INP(8) + (size_t)layer * 512, mout, (float*)lds, bid, G, tid);
        } else if ((SEL == SEL_ALL || SEL == SEL_GEMM) && kind <= K_H && kind != K_A2) {
#ifndef GATES_ON
#define GATES_ON 1
#endif
#ifdef GEMM_ONLY
#define GEMM_ON(k) ((k) == GEMM_ONLY)
#else
#define GEMM_ON(k) true
#endif
            pg8::StaticOrder S;
#define RUN_GEMM_X(MODE, MR_, CU_, A_, BT_, N_, K_, O_, LDC_, Z_, SSQI_, BASE_, OUTF_, SSQO_, O2_, LDC2_, SPLIT_) do { pg8::Gemm g; g.A = (A_); g.Bt = (BT_); g.M = (MR_); g.N = (N_); g.K = (K_); \
                pg8::EpiAny<MODE> E; E.O = (O_); E.ldc = (LDC_); E.Z = (Z_); E.ssq_in = (SSQI_); E.base = (BASE_); E.outf = (OUTF_); E.ssq_out = (SSQO_); E.O2 = (O2_); E.ldc2 = (LDC2_); E.split = (SPLIT_); \
                S.init((MR_), (N_), G, (CU_)); pg8::gemm_phase<pg8::EpiAny<MODE>, pg8::StaticOrder, true, true>(ldsl, g, S, E); } while (0)
#define RUN_GEMM(MODE, A_, BT_, N_, K_, O_, LDC_, Z_, SSQI_, BASE_, OUTF_, SSQO_) RUN_GEMM_X(MODE, M, bid, A_, BT_, N_, K_, O_, LDC_, Z_, SSQI_, BASE_, OUTF_, SSQO_, nullptr, 0, 0)
            if (GEMM_ON(K_A) && kind == K_A) {
                RUN_GEMM_X(0, M, bid, xb, Wb + W_IN, 2560, 1024, n1, LD1, nullptr, ssqA, nullptr, nullptr, nullptr, n2, LD2, 1024);
                RUN_GEMM_X(6, 1536, (bid + G / 2) % G, Wb + W_IN + (size_t)2048 * 1024, xb, M, 1024, tT, M, nullptr, ssqA, nullptr, nullptr, nullptr, nullptr, 0, 0);
            }
            else if (GEMM_ON(K_E1) && kind == K_E1) RUN_GEMM(2, att, Wb + W_A, 1024, 512, Yb, 1024, nullptr, nullptr, nullptr, nullptr, nullptr);
            else if (GEMM_ON(K_E2) && kind == K_E2) RUN_GEMM(3, xb, Wb + W_IN + (size_t)3584 * 1024, 1024, 1024, Yb, 1024, nullptr, ssqA, nullptr, nullptr, nullptr);
            else if (GEMM_ON(K_E3) && kind == K_E3) RUN_GEMM(2, mout, Wb + W_M, 1024, 512, Zb, 1024, nullptr, nullptr, nullptr, nullptr, nullptr);
            else if (GEMM_ON(K_E4) && kind == K_E4) RUN_GEMM(4, xb, Wb + W_IN + (size_t)4608 * 1024, 1024, 1024, Yb, 1024, Zb, ssqA, nullptr, nullptr, nullptr);
            else if (GEMM_ON(K_F) && kind == K_F)  RUN_GEMM(5, Yb, Wb + W_O, 1024, 1024, xb, 1024, nullptr, nullptr, xres, xout, ssqF);
            else if (GEMM_ON(K_G) && kind == K_G)  RUN_GEMM(1, xb, Wb + W_UP, 4096, 1024, Hb, DFF, nullptr, ssqF, nullptr, nullptr, nullptr);
            else if (GEMM_ON(K_H)) RUN_GEMM(5, Hb, Wb + W_DN, 1024, 4096, xb, 1024, nullptr, nullptr, xout, xout, ssqN);
        } else if ((SEL == SEL_ALL || SEL == SEL_GATES) && kind == K_A2) {
                const float* bi = INP(5) + layer * 4; const float* bf_ = INP(6) + layer * 4;
                for (int m = gw; m < M; m += NGW) {
                    const f32x4* xr = (const f32x4*)(xres + (size_t)m * DM) + lane; f32x4 v[4]; float s = 0.f; float d[8];
#pragma unroll
                    for (int j = 0; j < 4; ++j) { v[j] = xr[64 * j]; s += (v[j].x * v[j].x + v[j].y * v[j].y) + (v[j].z * v[j].z + v[j].w * v[j].w); }
#pragma unroll
                    for (int q = 0; q < 8; ++q) { const f32x4* wr_ = (const f32x4*)(wg + q * 1024) + lane; float a = 0.f;
#pragma unroll
                        for (int j = 0; j < 4; ++j) { const f32x4 w = wr_[64 * j]; a += (v[j].x * w.x + v[j].y * w.y) + (v[j].z * w.z + v[j].w * w.w); }
                        d[q] = wave_sum(a); }
                    s = wave_sum(s); const float rs = rsqrtf(s * (1.0f / 1024.0f) + EPS);
                    float val = d[0];
#pragma unroll
                    for (int q = 1; q < 8; ++q) val = (lane == q) ? d[q] : val;
                    if (lane < 4) gates[(size_t)m * 8 + lane] = val * rs + bi[lane];
                    else if (lane < 8) { const float f = val * rs + bf_[lane - 4]; gates[(size_t)m * 8 + lane] = fminf(f, 0.f) - log1pf(__expf(-fabsf(f))); }
                }
        }
        const bool seam = !(kind == K_A || kind == K_E1 || kind == K_E2 || kind == K_E3);
        if (seam && step + 1 < args.ph_hi) { if (MK_ONE_LAUNCH) xcd_barrier(bar); }
#ifdef PROBE_REPEAT
        if ((PROBE_REPEAT_COND) && prep + 1 < PROBE_REPEAT) { ++prep; } else { prep = 0; ++step; }
#else
        ++step;
#endif
    }
}

extern "C" void kernel_launch(void* const* d_in, const int* in_sizes, int n_in, void* d_out, int out_size, void* d_ws, size_t ws_size, hipStream_t stream) {
    static int grid = 0;
    if (grid == 0) {
        if (n_in != 16 || in_sizes[0] != M * DM || out_size != M * DM || ws_size < WS_END) { fprintf(stderr, "kernel_launch: unexpected shapes (n_in %d, in0 %d, out %d, ws %zu)\n", n_in, n_in > 0 ? in_sizes[0] : -1, out_size, ws_size); grid = -1; return; }
        int dev = 0, cus = 0;
        if (hipGetDevice(&dev) != hipSuccess || hipDeviceGetAttribute(&cus, hipDeviceAttributeMultiprocessorCount, dev) != hipSuccess) { grid = -1; return; }
        bool ok = true;
#if MK_ONE_LAUNCH
        ok &= hipFuncSetAttribute((const void*)mk_fwd<SEL_ALL>, hipFuncAttributeMaxDynamicSharedMemorySize, LDS_BYTES) == hipSuccess;
#endif
#if !MK_ONE_LAUNCH
        ok &= hipFuncSetAttribute((const void*)mk_fwd<SEL_PRO>, hipFuncAttributeMaxDynamicSharedMemorySize, LDS_BYTES) == hipSuccess;
        ok &= hipFuncSetAttribute((const void*)mk_fwd<SEL_FIN>, hipFuncAttributeMaxDynamicSharedMemorySize, LDS_BYTES) == hipSuccess;
        ok &= hipFuncSetAttribute((const void*)mk_fwd<SEL_B>, hipFuncAttributeMaxDynamicSharedMemorySize, LDS_BYTES) == hipSuccess;
        ok &= hipFuncSetAttribute((const void*)mk_fwd<SEL_C>, hipFuncAttributeMaxDynamicSharedMemorySize, LDS_BYTES) == hipSuccess;
        ok &= hipFuncSetAttribute((const void*)mk_fwd<SEL_D>, hipFuncAttributeMaxDynamicSharedMemorySize, LDS_BYTES) == hipSuccess;
        ok &= hipFuncSetAttribute((const void*)mk_fwd<SEL_GATES>, hipFuncAttributeMaxDynamicSharedMemorySize, LDS_BYTES) == hipSuccess;
        ok &= hipFuncSetAttribute((const void*)mk_fwd<SEL_GEMM>, hipFuncAttributeMaxDynamicSharedMemorySize, LDS_BYTES) == hipSuccess;
#endif
        if (!ok) { fprintf(stderr, "kernel_launch: hipFuncSetAttribute failed\n"); grid = -1; return; }
        (void)hipGetLastError();
        grid = cus;
    }
    if (grid < 0) return;
    if (hipMemsetAsync((char*)d_ws + WS_CTL, 0, CTL_ZERO_BYTES, stream) != hipSuccess) return;
    Args a{};
    for (int i = 0; i < 16; ++i) a.in[i] = (const float*)d_in[i];
    a.out = (float*)d_out; a.ws = (unsigned char*)d_ws;
#if MK_ONE_LAUNCH
    {
        a.ph_lo = 0; a.ph_hi = N_STEPS;
        hipLaunchKernelGGL(mk_fwd<SEL_ALL>, dim3(grid), dim3(512), LDS_BYTES, stream, a);
    }
#else
    {
        int s = 0;
        while (s < N_STEPS) {
            int e = s + 1;
            const int k = (s == 0 || s == STEP_PRO1 || s == STEP_FIN) ? -1 : (s - 1) % KPL;
            if (k == K_E1) e = s + 4;
            a.ph_lo = s; a.ph_hi = e;
            if (k == -1 && s != STEP_FIN) hipLaunchKernelGGL(mk_fwd<SEL_PRO>, dim3(grid), dim3(512), LDS_BYTES, stream, a);
            else if (k == -1) hipLaunchKernelGGL(mk_fwd<SEL_FIN>, dim3(grid), dim3(512), LDS_BYTES, stream, a);
            else if (k == K_A2) hipLaunchKernelGGL(mk_fwd<SEL_GATES>, dim3(grid), dim3(512), LDS_BYTES, stream, a);
            else if (k == K_B) hipLaunchKernelGGL(mk_fwd<SEL_B>, dim3(grid), dim3(512), LDS_BYTES, stream, a);
            else if (k == K_C) hipLaunchKernelGGL(mk_fwd<SEL_C>, dim3(grid), dim3(512), LDS_BYTES, stream, a);
            else if (k == K_D) hipLaunchKernelGGL(mk_fwd<SEL_D>, dim3(grid), dim3(512), LDS_BYTES, stream, a);
            else hipLaunchKernelGGL(mk_fwd<SEL_GEMM>, dim3(grid), dim3(512), LDS_BYTES, stream, a);
            s = e;
        }
    }
#endif
}
```

```cpp
#include <hip/hip_runtime.h>
#include <cstdio>
#include <cstdint>

namespace pg8 {
#define PG8_LAS __attribute__((address_space(3)))
typedef unsigned short bf16_t;
typedef short bf16x8 __attribute__((ext_vector_type(8)));
typedef float f32x4 __attribute__((ext_vector_type(4)));
typedef unsigned u32x4 __attribute__((ext_vector_type(4)));
constexpr int BM = 256, BK = 64, HALF = 128, HTB = HALF * BK * 2  , STAGE_BYTES = 8 * HTB, NXCD = 8, WGM = 8;

__host__ __device__ __forceinline__ int lds_byte(int r, int c) { const int st = (r >> 4) * 2 + (c >> 5), rr = r & 15, cc = c & 31, ob = rr * 64 + cc * 2; return st * 1024 + (ob ^ (((ob >> 9) & 1) << 5)); }
__host__ __device__ __forceinline__ void stage_rc(int b, int& R, int& C) { const int st = b / 1024, sb = b % 1024, swz = sb ^ (((sb >> 9) & 1) << 5); R = (st >> 1) * 16 + swz / 64; C = (st & 1) * 32 + (swz % 64) / 2; }
__host__ __device__ __forceinline__ int perm32(int rho) { const int n = rho >> 4, i = rho & 15; return 8 * (i >> 2) + 4 * n + (i & 3); }

struct Unit { int pm, pn; };
struct Gemm { const bf16_t* A; const bf16_t* Bt; int M, N, K; };

struct StaticOrder {
    int nM, nN, nwg, G, c;
    __host__ __device__ void init(int M, int N, int G_, int c_) { nM = M / BM; nN = N / BM; nwg = nM * nN; G = G_; c = c_; }
    __host__ __device__ bool next(int i, Unit& u) const {
        const long L = (long)i * G + c; if (L >= nwg) return false;
        int wgid = (int)L; { const int q = nwg / NXCD, r = nwg % NXCD, xcd = wgid % NXCD, off = wgid / NXCD; wgid = (xcd < r ? xcd * (q + 1) : r * (q + 1) + (xcd - r) * q) + off; }
        const int nig = WGM * nN, gid = wgid / nig, fm = gid * WGM, gsz = (nM - fm) < WGM ? (nM - fm) : WGM;
        u.pm = fm + ((wgid % nig) % gsz); u.pn = (wgid % nig) / gsz; return true;
    }
    __device__ __forceinline__ void a_ready(const Unit&) const {}
    __device__ __forceinline__ void done(const Unit&) const {}
};

__device__ __forceinline__ unsigned cvt_pk_bf16(float lo, float hi) { unsigned r; asm volatile("v_cvt_pk_bf16_f32 %0, %1, %2" : "=v"(r) : "v"(lo), "v"(hi)); return r; }
__device__ __forceinline__ float bflo(unsigned w) { return __uint_as_float(w << 16); }
__device__ __forceinline__ float bfhi(unsigned w) { return __uint_as_float(w & 0xffff0000u); }
__device__ __forceinline__ float rstd_of(float ss) { return rsqrtf(ss * (1.0f / 1024.0f) + 1e-6f); }
__device__ __forceinline__ float sigm(float x) { return 1.0f / (1.0f + __expf(-x)); }
typedef unsigned u32x2 __attribute__((ext_vector_type(2)));

template <int mode> struct EpiAny {
    static constexpr bool PERM = true, AFTER_DRAIN = false;
    bf16_t* O; int ldc; const bf16_t* Z; const float* ssq_in; const float* base; float* outf; float* ssq_out; bf16_t* O2; int ldc2, split;
    __device__ __forceinline__ void operator()(const f32x4 (&acc)[2][2][4][2], const Unit& u, int wr, int wc, int fr, int fq) const {
        const int row0 = u.pm * BM + wr * 64 + fr, col0 = u.pn * BM + wc * 32 + 8 * fq;
        if (mode == 6) {
            float rs[2][8];
#pragma unroll
            for (int bj = 0; bj < 2; ++bj) { const f32x4 s0 = *(const f32x4*)(ssq_in + col0 + bj * HALF), s1 = *(const f32x4*)(ssq_in + col0 + bj * HALF + 4);
#pragma unroll
                for (int e = 0; e < 4; ++e) { rs[bj][e] = rstd_of(s0[e]); rs[bj][4 + e] = rstd_of(s1[e]); } }
#pragma unroll
            for (int ai = 0; ai < 2; ++ai)
#pragma unroll
                for (int m = 0; m < 4; ++m) {
                    const int row = row0 + ai * HALF + m * 16; bf16_t* rowp = O + (size_t)row * ldc + col0;
#pragma unroll
                    for (int bj = 0; bj < 2; ++bj) {
                        const f32x4 v0 = acc[ai][bj][m][0], v1 = acc[ai][bj][m][1];
                        u32x4 w; w.x = cvt_pk_bf16(v0[0] * rs[bj][0], v0[1] * rs[bj][1]); w.y = cvt_pk_bf16(v0[2] * rs[bj][2], v0[3] * rs[bj][3]);
                        w.z = cvt_pk_bf16(v1[0] * rs[bj][4], v1[1] * rs[bj][5]); w.w = cvt_pk_bf16(v1[2] * rs[bj][6], v1[3] * rs[bj][7]);
                        *(u32x4*)(rowp + bj * HALF) = w;
                    }
                }
        } else if (mode <= 1) {
            bf16_t* ob = O; int ld = ldc, cc = col0;
            if (mode == 0 && u.pn * BM >= split) { ob = O2; ld = ldc2; cc = col0 - split; }
#pragma unroll
            for (int ai = 0; ai < 2; ++ai)
#pragma unroll
                for (int m = 0; m < 4; ++m) {
                    const int row = row0 + ai * HALF + m * 16; const float rs = rstd_of(ssq_in[row]);
                    bf16_t* rowp = ob + (size_t)row * ld + cc;
#pragma unroll
                    for (int bj = 0; bj < 2; ++bj) {
                        f32x4 v0 = acc[ai][bj][m][0] * rs, v1 = acc[ai][bj][m][1] * rs;
                        if (mode == 1) {
#pragma unroll
                            for (int e = 0; e < 4; ++e) { const float a = fmaxf(v0[e], 0.f), b = fmaxf(v1[e], 0.f); v0[e] = a * a; v1[e] = b * b; }
                        }
                        u32x4 w; w.x = cvt_pk_bf16(v0[0], v0[1]); w.y = cvt_pk_bf16(v0[2], v0[3]); w.z = cvt_pk_bf16(v1[0], v1[1]); w.w = cvt_pk_bf16(v1[2], v1[3]);
                        *(u32x4*)(rowp + bj * HALF) = w;
                    }
                }
        } else if (mode == 2) {
#pragma unroll
            for (int ai = 0; ai < 2; ++ai)
#pragma unroll
                for (int m = 0; m < 4; ++m) {
                    const int row = row0 + ai * HALF + m * 16; bf16_t* rowp = O + (size_t)row * ldc + col0;
#pragma unroll
                    for (int bj = 0; bj < 2; ++bj) {
                        const f32x4 v0 = acc[ai][bj][m][0], v1 = acc[ai][bj][m][1];
                        u32x4 w; w.x = cvt_pk_bf16(v0[0], v0[1]); w.y = cvt_pk_bf16(v0[2], v0[3]); w.z = cvt_pk_bf16(v1[0], v1[1]); w.w = cvt_pk_bf16(v1[2], v1[3]);
                        *(u32x4*)(rowp + bj * HALF) = w;
                    }
                }
        } else if (mode <= 4) {
#pragma unroll
            for (int ai = 0; ai < 2; ++ai)
#pragma unroll
                for (int m = 0; m < 4; ++m) {
                    const int row = row0 + ai * HALF + m * 16; const float rs = rstd_of(ssq_in[row]);
                    bf16_t* rowp = O + (size_t)row * ldc + col0; const bf16_t* zp = Z + (size_t)row * ldc + col0;
#pragma unroll
                    for (int bj = 0; bj < 2; ++bj) {
                        const f32x4 a0 = acc[ai][bj][m][0] * rs, a1 = acc[ai][bj][m][1] * rs;
                        const u32x4 y = *(const u32x4*)(rowp + bj * HALF);
                        float yv[8] = {bflo(y.x), bfhi(y.x), bflo(y.y), bfhi(y.y), bflo(y.z), bfhi(y.z), bflo(y.w), bfhi(y.w)};
                        float gv[8] = {sigm(a0[0]), sigm(a0[1]), sigm(a0[2]), sigm(a0[3]), sigm(a1[0]), sigm(a1[1]), sigm(a1[2]), sigm(a1[3])};
                        float ov[8];
                        if (mode == 3) {
#pragma unroll
                            for (int e = 0; e < 8; ++e) ov[e] = gv[e] * yv[e];
                        } else {
                            const u32x4 z = *(const u32x4*)(zp + bj * HALF);
                            float zv[8] = {bflo(z.x), bfhi(z.x), bflo(z.y), bfhi(z.y), bflo(z.z), bfhi(z.z), bflo(z.w), bfhi(z.w)};
#pragma unroll
                            for (int e = 0; e < 8; ++e) ov[e] = yv[e] + gv[e] * zv[e];
                        }
                        u32x4 w; w.x = cvt_pk_bf16(ov[0], ov[1]); w.y = cvt_pk_bf16(ov[2], ov[3]); w.z = cvt_pk_bf16(ov[4], ov[5]); w.w = cvt_pk_bf16(ov[6], ov[7]);
                        *(u32x4*)(rowp + bj * HALF) = w;
                    }
                }
        } else {
#pragma unroll
            for (int ai = 0; ai < 2; ++ai)
#pragma unroll
                for (int m = 0; m < 4; ++m) {
                    const int row = row0 + ai * HALF + m * 16; const size_t off = (size_t)row * ldc + col0; float s = 0.f;
#pragma unroll
                    for (int bj = 0; bj < 2; ++bj) {
                        const f32x4 b0 = *(const f32x4*)(base + off + bj * HALF), b1 = *(const f32x4*)(base + off + bj * HALF + 4);
                        const f32x4 o0 = b0 + acc[ai][bj][m][0], o1 = b1 + acc[ai][bj][m][1];
                        *(f32x4*)(outf + off + bj * HALF) = o0; *(f32x4*)(outf + off + bj * HALF + 4) = o1;
                        u32x4 w; w.x = cvt_pk_bf16(o0[0], o0[1]); w.y = cvt_pk_bf16(o0[2], o0[3]); w.z = cvt_pk_bf16(o1[0], o1[1]); w.w = cvt_pk_bf16(o1[2], o1[3]);
                        *(u32x4*)(O + off + bj * HALF) = w;
                        s += (o0[0] * o0[0] + o0[1] * o0[1]) + (o0[2] * o0[2] + o0[3] * o0[3]) + (o1[0] * o1[0] + o1[1] * o1[1]) + (o1[2] * o1[2] + o1[3] * o1[3]);
                    }
                    s += __shfl_xor(s, 16); s += __shfl_xor(s, 32);
                    if (fq == 0) atomicAdd(ssq_out + row, s);
                }
        }
    }
};

template <class Epi, class Sched, bool ALIGN_EPI = false, bool SP2 = false>
__device__ __forceinline__ void gemm_phase(PG8_LAS unsigned char* lds, const Gemm g, const Sched& S, const Epi& E) {
    int tid_ = threadIdx.x; asm volatile("" : "+v"(tid_));
    const int tid = tid_, wid = __builtin_amdgcn_readfirstlane(tid >> 6), lane = tid & 63, wr = wid >> 2, wc = wid & 3, fr = lane & 15, fq = lane >> 4;
    const int K = g.K, nt = K / BK;
    unsigned voffA[2], voffB[2];
#pragma unroll
    for (int i = 0; i < 2; ++i) { int R, C; stage_rc(tid * 16 + i * 8192, R, C); const int Rb = Epi::PERM ? ((R & ~31) + perm32(R & 31)) : R;
        voffA[i] = (unsigned)(R * K + C) * 2u; voffB[i] = (unsigned)(Rb * K + C) * 2u; }
    const size_t kstep = (size_t)(BK * 2);
    const size_t hstep = (size_t)HALF * K * 2;
    const size_t tstep = 2 * hstep;
    const unsigned ldsw = (unsigned)wid * 1024u;
    const int aoff = lds_byte(wr * 64 + fr, fq * 8), boff = lds_byte(wc * 32 + fr, fq * 8);
#define PG8_SA(b, h) (((b) * 2 + (h)) * HTB)
#define PG8_SB(b, h) ((4 + (b) * 2 + (h)) * HTB)
#define PG8_STAGE(bufoff, gbase, voff) do { _Pragma("unroll") for (int _i = 0; _i < 2; ++_i) \
        __builtin_amdgcn_global_load_lds((const unsigned*)((const char*)(gbase) + (voff)[_i]), (PG8_LAS unsigned*)(lds + (bufoff) + ldsw + _i * 8192), 16, 0, 0); } while (0)
#define PG8_LDA(dst, b, h) do { _Pragma("unroll") for (int m = 0; m < 4; ++m) _Pragma("unroll") for (int k = 0; k < 2; ++k) dst[m][k] = *(const PG8_LAS bf16x8*)(lds + PG8_SA(b, h) + aoff + m * 2048 + k * 1024); } while (0)
#define PG8_LDB(dst, b, h) do { _Pragma("unroll") for (int n = 0; n < 2; ++n) _Pragma("unroll") for (int k = 0; k < 2; ++k) dst[n][k] = *(const PG8_LAS bf16x8*)(lds + PG8_SB(b, h) + boff + n * 2048 + k * 1024); } while (0)
#define PG8_MMA(ai, bj, At, Bt) do { __builtin_amdgcn_s_setprio(1); _Pragma("unroll") for (int m = 0; m < 4; ++m) _Pragma("unroll") for (int n = 0; n < 2; ++n) _Pragma("unroll") for (int k = 0; k < 2; ++k) \
        acc[ai][bj][m][n] = __builtin_amdgcn_mfma_f32_16x16x32_bf16(Bt[n][k], At[m][k], acc[ai][bj][m][n], 0, 0, 0); __builtin_amdgcn_s_setprio(0); } while (0)
#define PG8_WAIT_V(n) asm volatile("s_waitcnt vmcnt(" #n ")" ::: "memory")
#define PG8_WAIT_L(n) asm volatile("s_waitcnt lgkmcnt(" #n ")" ::: "memory")
#define PG8_BAR __builtin_amdgcn_s_barrier()
#define PG8_SCHED __builtin_amdgcn_sched_barrier(0)
    Unit cur, nxt; int ui = 0;
    if (!S.next(0, cur)) return;
    f32x4 acc[2][2][4][2];
#pragma unroll
    for (int a = 0; a < 2; ++a)
#pragma unroll
        for (int b = 0; b < 2; ++b)
#pragma unroll
            for (int m = 0; m < 4; ++m)
#pragma unroll
                for (int n = 0; n < 2; ++n) acc[a][b][m][n] = (f32x4){0.f, 0.f, 0.f, 0.f};
    bf16x8 At[4][2], B0[2][2], B1[2][2];
    const char* cA = (const char*)g.A + (size_t)cur.pm * tstep; const char* cB = (const char*)g.Bt + (size_t)cur.pn * tstep;
    S.a_ready(cur);
    if constexpr (SP2) {
        PG8_STAGE(PG8_SB(0, 0), cB, voffB); PG8_STAGE(PG8_SB(0, 1), cB + hstep, voffB); PG8_STAGE(PG8_SA(0, 0), cA, voffA); PG8_STAGE(PG8_SA(0, 1), cA + hstep, voffA);
        if (wr == 1) PG8_BAR;
        PG8_WAIT_V(2); PG8_BAR;
        PG8_STAGE(PG8_SB(1, 0), cB + kstep, voffB); PG8_STAGE(PG8_SA(1, 0), cA + kstep, voffA); PG8_STAGE(PG8_SB(1, 1), cB + hstep + kstep, voffB);
        PG8_WAIT_V(6); PG8_BAR;
    } else {
        PG8_STAGE(PG8_SB(0, 0), cB, voffB); PG8_STAGE(PG8_SA(0, 0), cA, voffA); PG8_STAGE(PG8_SB(0, 1), cB + hstep, voffB); PG8_STAGE(PG8_SA(0, 1), cA + hstep, voffA);
        if (wr == 1) PG8_BAR;
        PG8_WAIT_V(4); PG8_BAR;
        PG8_STAGE(PG8_SB(1, 0), cB + kstep, voffB); PG8_STAGE(PG8_SA(1, 0), cA + kstep, voffA); PG8_STAGE(PG8_SB(1, 1), cB + hstep + kstep, voffB);
        PG8_WAIT_V(6); PG8_BAR;
    }
    for (;;) {
        const bool has_next = S.next(ui + 1, nxt);
        const char* nA = has_next ? (const char*)g.A + (size_t)nxt.pm * tstep : cA; const char* nB = has_next ? (const char*)g.Bt + (size_t)nxt.pn * tstep : cB;
        for (int t = 0; t < nt; t += 2) {
            const bool last = (t == nt - 2);
            const char* a1 = cA + (size_t)(t + 1) * kstep;
            const char* a2 = last ? nA : cA + (size_t)(t + 2) * kstep; const char* b2 = last ? nB : cB + (size_t)(t + 2) * kstep;
            const char* a3 = a2 + kstep; const char* b3 = b2 + kstep;
            if (last && has_next) S.a_ready(nxt);
            if constexpr (SP2) {
            PG8_LDB(B0, 0, 0); PG8_LDB(B1, 0, 1); PG8_SCHED; PG8_LDA(At, 0, 0); PG8_STAGE(PG8_SA(1, 1), a1 + hstep, voffA);
            PG8_WAIT_V(8); PG8_WAIT_L(0); PG8_BAR; PG8_MMA(0, 0, At, B0); PG8_MMA(0, 1, At, B1); PG8_BAR; PG8_SCHED;
            PG8_LDA(At, 0, 1); PG8_STAGE(PG8_SB(0, 0), b2, voffB); PG8_STAGE(PG8_SB(0, 1), b2 + hstep, voffB); PG8_STAGE(PG8_SA(0, 0), a2, voffA);
            PG8_WAIT_V(8); PG8_WAIT_L(0); PG8_BAR; PG8_MMA(1, 0, At, B0); PG8_MMA(1, 1, At, B1); PG8_BAR; PG8_SCHED;
            PG8_LDB(B0, 1, 0); PG8_LDB(B1, 1, 1); PG8_SCHED; PG8_LDA(At, 1, 0); PG8_STAGE(PG8_SA(0, 1), a2 + hstep, voffA);
            PG8_WAIT_V(8); PG8_WAIT_L(0); PG8_BAR; PG8_MMA(0, 0, At, B0); PG8_MMA(0, 1, At, B1); PG8_BAR; PG8_SCHED;
            PG8_LDA(At, 1, 1); PG8_STAGE(PG8_SB(1, 0), b3, voffB); PG8_STAGE(PG8_SB(1, 1), b3 + hstep, voffB); PG8_STAGE(PG8_SA(1, 0), a3, voffA);
            PG8_WAIT_V(8); PG8_WAIT_L(0); PG8_BAR; PG8_MMA(1, 0, At, B0); PG8_MMA(1, 1, At, B1); PG8_BAR; PG8_SCHED;
            } else {
            PG8_LDB(B0, 0, 0); PG8_SCHED; PG8_LDA(At, 0, 0); PG8_STAGE(PG8_SA(1, 1), a1 + hstep, voffA);
            PG8_WAIT_L(8); PG8_BAR; PG8_WAIT_L(0); PG8_MMA(0, 0, At, B0); PG8_BAR; PG8_SCHED;
            PG8_LDB(B1, 0, 1); PG8_STAGE(PG8_SB(0, 0), b2, voffB);
            PG8_BAR; PG8_WAIT_L(0); PG8_MMA(0, 1, At, B1); PG8_BAR;
            PG8_LDA(At, 0, 1); PG8_STAGE(PG8_SA(0, 0), a2, voffA);
            PG8_BAR; PG8_WAIT_L(0); PG8_MMA(1, 0, At, B0); PG8_BAR; PG8_SCHED;
            PG8_STAGE(PG8_SB(0, 1), b2 + hstep, voffB);
            PG8_WAIT_V(6); PG8_BAR; PG8_MMA(1, 1, At, B1); PG8_BAR;
            PG8_LDB(B0, 1, 0); PG8_SCHED; PG8_LDA(At, 1, 0); PG8_STAGE(PG8_SA(0, 1), a2 + hstep, voffA);
            PG8_WAIT_L(8); PG8_BAR; PG8_WAIT_L(0); PG8_MMA(0, 0, At, B0); PG8_BAR; PG8_SCHED;
            PG8_LDB(B1, 1, 1); PG8_STAGE(PG8_SB(1, 0), b3, voffB);
            PG8_BAR; PG8_WAIT_L(0); PG8_MMA(0, 1, At, B1); PG8_BAR;
            PG8_LDA(At, 1, 1); PG8_STAGE(PG8_SA(1, 0), a3, voffA);
            PG8_BAR; PG8_WAIT_L(0); PG8_MMA(1, 0, At, B0); PG8_BAR; PG8_SCHED;
            PG8_STAGE(PG8_SB(1, 1), b3 + hstep, voffB);
            PG8_WAIT_V(6); PG8_BAR; PG8_MMA(1, 1, At, B1); PG8_BAR;
            }
        }
        if constexpr (ALIGN_EPI) { if (wr == 0) PG8_BAR; }
        if constexpr (!Epi::AFTER_DRAIN) { E(acc, cur, wr, wc, fr, fq); S.done(cur); }
        if (!has_next) break;
#pragma unroll
        for (int a = 0; a < 2; ++a)
#pragma unroll
            for (int b = 0; b < 2; ++b)
#pragma unroll
                for (int m = 0; m < 4; ++m)
#pragma unroll
                    for (int n = 0; n < 2; ++n) acc[a][b][m][n] = (f32x4){0.f, 0.f, 0.f, 0.f};
        cur = nxt; cA = nA; cB = nB; ++ui;
        if constexpr (ALIGN_EPI) { if (wr == 1) PG8_BAR; }
    }
    PG8_WAIT_V(0);
    if constexpr (!ALIGN_EPI) { if (wr == 0) PG8_BAR; }
    PG8_BAR;
    if constexpr (Epi::AFTER_DRAIN) { E.fused(acc, cur, wr, wc, fr, fq, lds, wid, lane); S.done(cur); }
#undef PG8_SA
#undef PG8_SB
#undef PG8_STAGE
#undef PG8_LDA
#undef PG8_LDB
#undef PG8_MMA
#undef PG8_WAIT_V
#undef PG8_WAIT_L
#undef PG8_BAR
#undef PG8_SCHED
}
}
#define GAS __attribute__((address_space(1)))
#define LAS __attribute__((address_space(3)))
typedef unsigned short bf16;
typedef unsigned v4u __attribute__((ext_vector_type(4)));
typedef float f32x4 __attribute__((ext_vector_type(4)));
#define LDS_WAIT() asm volatile("s_waitcnt lgkmcnt(0)" ::: "memory")

#ifndef FAST_ATTN
#define FAST_ATTN 1
#endif
#ifndef FAST_LOCAL
#define FAST_LOCAL 1
#endif
#ifndef FAST_OUT
#define FAST_OUT 1
#endif
#ifndef MK_ONE_LAUNCH
#define MK_ONE_LAUNCH 1
#endif

constexpr int M = 16384, DM = 1024, SEQ = 4096, NCHK = 64, CHK = 64, DFF = 4096, DIN_SRC = 5640;
constexpr int LD1 = 1024, LD2 = 1536, N2_MQ = 0, N2_MO = 512, N2_MK = 1024, T_MK = 0, T_AV = 512, T_MV = 1024;
constexpr int NUNIT = 1024;
constexpr float EPS = 1e-6f;

constexpr size_t MiB = 1u << 20;
constexpr size_t WS_CTL = 0, CTL_ZERO_BYTES = 1 * MiB;
constexpr size_t WS_SSQ = 1 * MiB;
constexpr size_t WS_WG = 1 * MiB + 320 * 1024;
constexpr size_t WS_GATES = 1 * MiB + 512 * 1024;
constexpr size_t WS_NLOC = 2 * MiB;
constexpr size_t WS_MLOC = 2 * MiB + 512 * 1024;
constexpr size_t WS_BLAST = WS_MLOC + 4096, WS_MST = WS_BLAST + 4096;
constexpr size_t WS_W = 3 * MiB;
constexpr size_t W_IN = 0, W_A = (size_t)5632 * 1024, W_M = W_A + 512 * 1024, W_O = W_M + 512 * 1024, W_UP = W_O + 1024 * 1024, W_DN = W_UP + (size_t)4096 * 1024, W_END = W_DN + (size_t)4096 * 1024;
static_assert(WS_W + W_END * 2 <= 34 * MiB, "weights");
constexpr size_t WS_XB = 34 * MiB;
constexpr size_t WS_N1 = 66 * MiB;
constexpr size_t WS_N2 = 98 * MiB;
constexpr size_t WS_T = 146 * MiB;
constexpr size_t WS_MOUT = 146 * MiB;
constexpr size_t WS_Y = 162 * MiB;
constexpr size_t WS_Z = 66 * MiB;
constexpr size_t WS_ATT = 194 * MiB;
constexpr size_t WS_CLOC = 210 * MiB;
constexpr size_t WS_H = 66 * MiB;
constexpr size_t WS_END = 242 * MiB;

constexpr int RING_BYTES = 131072, LDSCTL_OFF = RING_BYTES, MISC_OFF = LDSCTL_OFF + 320, LDS_BYTES = 147456;
constexpr int CW_BAR = 4096;

__device__ __forceinline__ unsigned f2bf(float f) { unsigned u = __builtin_bit_cast(unsigned, f); return (u + 0x7fffu + ((u >> 16) & 1u)) >> 16; }
__device__ __forceinline__ unsigned pk2(float lo, float hi) { return f2bf(lo) | (f2bf(hi) << 16); }
__device__ __forceinline__ float bf2f(bf16 v) { return __uint_as_float(((unsigned)v) << 16); }
__device__ __forceinline__ float blo(unsigned w) { return __uint_as_float(w << 16); }
__device__ __forceinline__ float bhi(unsigned w) { return __uint_as_float(w & 0xffff0000u); }
__device__ __forceinline__ float sigmf(float x) { return 1.0f / (1.0f + __expf(-x)); }
__device__ __forceinline__ float wave_sum(float v) {
#pragma unroll
    for (int o = 1; o < 64; o <<= 1) v += __shfl_xor(v, o);
    return v;
}

__device__ __forceinline__ int win_src_col(int n0) {
    if (n0 >= 3584) return n0 + 8;
    const int blk = n0 >> 9; const int st = blk == 0 ? 0 : blk == 1 ? 512 : blk == 2 ? 1536 : blk == 3 ? 3072 : blk == 4 ? 2048 : blk == 5 ? 1024 : 2560;
    return st + (n0 & 511);
}
__device__ __forceinline__ void transpose_item(const float* W, int ldw, int is_win, const float* g, bf16* WT, int K, int nblk, LAS float* scr, int item, int lane) {
    const int kb = item / nblk, nb = item % nblk, k0 = 64 * kb, n0 = 32 * nb, sc0 = is_win ? win_src_col(n0) : n0;
#pragma unroll 8
    for (int i = 0; i < 32; ++i) { const int kk = 2 * i + (lane >> 5); const float gv = g ? g[k0 + kk] : 1.0f; scr[kk * 33 + (lane & 31)] = W[(size_t)(k0 + kk) * ldw + sc0 + (lane & 31)] * gv; }
    LDS_WAIT(); asm volatile("" ::: "memory");
    const int c = lane & 7;
#pragma unroll
    for (int j = 0; j < 4; ++j) { const int n = (lane >> 3) + 8 * j; const LAS float* s = scr + (8 * c) * 33 + n;
        v4u o; o.x = pk2(s[0 * 33], s[1 * 33]); o.y = pk2(s[2 * 33], s[3 * 33]); o.z = pk2(s[4 * 33], s[5 * 33]); o.w = pk2(s[6 * 33], s[7 * 33]);
        *(v4u*)(WT + (size_t)(n0 + n) * K + k0 + 8 * c) = o; }
    LDS_WAIT(); asm volatile("" ::: "memory");
}

__device__ __forceinline__ void attn_naive(const bf16* n1, const bf16* tT, const float* relb, bf16* att, int bid, int G, int wave, int lane) {
    for (int unit = bid; unit < 256; unit += G) {
        const int b = unit >> 6, c = unit & 63, h = wave, t = lane;
        const size_t tok = (size_t)b * SEQ + c * CHK + t;
        float q[64], acc[64];
        { const v4u* qp = (const v4u*)(n1 + tok * LD1 + h * 64);
#pragma unroll
          for (int i = 0; i < 8; ++i) { const v4u w = qp[i]; q[8 * i + 0] = blo(w.x) * 0.125f; q[8 * i + 1] = bhi(w.x) * 0.125f; q[8 * i + 2] = blo(w.y) * 0.125f; q[8 * i + 3] = bhi(w.y) * 0.125f;
              q[8 * i + 4] = blo(w.z) * 0.125f; q[8 * i + 5] = bhi(w.z) * 0.125f; q[8 * i + 6] = blo(w.w) * 0.125f; q[8 * i + 7] = bhi(w.w) * 0.125f; } }
#pragma unroll
        for (int d = 0; d < 64; ++d) acc[d] = 0.f;
        float mx = -1e30f, l = 0.f;
        const float* bh = relb + h * 513;
        for (int j = (c >= 8 ? 0 : 8 - c); j <= 8; ++j) {
            const size_t ktok0 = (size_t)b * SEQ + (size_t)(c - 8 + j) * CHK;
            for (int u = 0; u < 64; ++u) {
                int uo = u; asm volatile("" : "+v"(uo));
                const bf16* rowp = n1 + (ktok0 + uo) * LD1 + h * 64;
                const v4u* kp = (const v4u*)(rowp + 512); float s = 0.f;
#pragma unroll
                for (int i = 0; i < 8; ++i) { const v4u w = kp[i];
                    s += q[8 * i + 0] * blo(w.x) + q[8 * i + 1] * bhi(w.x) + q[8 * i + 2] * blo(w.y) + q[8 * i + 3] * bhi(w.y) + q[8 * i + 4] * blo(w.z) + q[8 * i + 5] * bhi(w.z) + q[8 * i + 6] * blo(w.w) + q[8 * i + 7] * bhi(w.w); }
                int rel = t - u + 64 * (8 - j); rel = rel < -256 ? -256 : (rel > 256 ? 256 : rel);
                s += bh[rel + 256];
                if (s > mx) { const float corr = __expf(mx - s); l *= corr;
#pragma unroll
                    for (int d = 0; d < 64; ++d) acc[d] *= corr;
                    mx = s; }
                const float p = __expf(s - mx); l += p;
                const bf16* vp = tT + (size_t)(T_AV + h * 64) * M + (ktok0 + uo);
#pragma unroll
                for (int d = 0; d < 64; ++d) acc[d] += p * bf2f(vp[(size_t)d * M]);
            }
        }
        const float inv = 1.0f / l;
        v4u* op = (v4u*)(att + tok * 512 + h * 64);
#pragma unroll
        for (int i = 0; i < 8; ++i) { v4u o; o.x = pk2(acc[8 * i + 0] * inv, acc[8 * i + 1] * inv); o.y = pk2(acc[8 * i + 2] * inv, acc[8 * i + 3] * inv); o.z = pk2(acc[8 * i + 4] * inv, acc[8 * i + 5] * inv); o.w = pk2(acc[8 * i + 6] * inv, acc[8 * i + 7] * inv); op[i] = o; }
    }
}

typedef short bf16x8_t __attribute__((ext_vector_type(8)));
typedef float f32x16_t __attribute__((ext_vector_type(16)));
typedef float f32x2_t __attribute__((ext_vector_type(2))); typedef __bf16 bf16x2_t __attribute__((ext_vector_type(2)));
__device__ __forceinline__ unsigned cvtpk(float lo, float hi) { f32x2_t v = {lo, hi}; bf16x2_t b = __builtin_convertvector(v, bf16x2_t); return __builtin_bit_cast(unsigned, b); }
__device__ __forceinline__ void attn_mfma(const bf16* n1, const bf16* tT, const float* relb, bf16* att, LAS float* ldsf, int bid, int G, int wave, int lane) {
    constexpr float LOG2E = 1.4426950408889634f, SC = 0.125f * LOG2E;
    const int h = wave, r32 = lane & 31, hi = lane >> 5;
    LAS float* ext = ldsf + wave * 384;
    for (int r = lane; r < 384; r += 64) { const int rel = r - 63; const int idx = (rel > 256 ? 256 : rel) + 256; ext[r] = relb[h * 513 + idx] * LOG2E; }
    const float bconst = relb[h * 513 + 512] * LOG2E;
    LDS_WAIT();
    const int pir = (r32 & ~12) | ((r32 & 4) << 1) | ((r32 & 8) >> 1);
    for (int unit = bid; unit < 256; unit += G) {
        const int b = unit >> 6, c = unit & 63; const size_t tq0 = (size_t)b * SEQ + c * CHK;
        bf16x8_t qf[2][4];
#pragma unroll
        for (int qb = 0; qb < 2; ++qb)
#pragma unroll
            for (int s = 0; s < 4; ++s) qf[qb][s] = *(const bf16x8_t*)(n1 + (tq0 + qb * 32 + r32) * LD1 + h * 64 + 32 * hi + 8 * s);
        f32x16_t o[2][2];
#pragma unroll
        for (int qb = 0; qb < 2; ++qb)
#pragma unroll
            for (int db = 0; db < 2; ++db)
#pragma unroll
                for (int i = 0; i < 16; ++i) o[qb][db][i] = 0.f;
        float mrun[2] = {-1e30f, -1e30f}, lrun[2] = {0.f, 0.f};
        const int kb0 = (c >= 8 ? 0 : 8 - c) * 2;
        bf16x8_t kf[4], vf[2][2];
        { const size_t ktok = (size_t)b * SEQ + (size_t)(c - 8) * CHK + (size_t)kb0 * 32;
#pragma unroll
          for (int s = 0; s < 4; ++s) kf[s] = *(const bf16x8_t*)(n1 + (ktok + pir) * LD1 + 512 + h * 64 + 32 * hi + 8 * s);
#pragma unroll
          for (int db = 0; db < 2; ++db)
#pragma unroll
              for (int s2 = 0; s2 < 2; ++s2) vf[db][s2] = *(const bf16x8_t*)(tT + (size_t)(T_AV + h * 64 + db * 32 + r32) * M + ktok + 16 * s2 + 8 * hi); }
        for (int kbI = kb0; kbI < 18; ++kbI) {
            const int j = kbI >> 1, kb = kbI & 1;
            bf16x8_t kn[4], vn[2][2];
            { const int nx = kbI + 1 < 18 ? kbI + 1 : 17; const size_t ktok = (size_t)b * SEQ + (size_t)(c - 8) * CHK + (size_t)nx * 32;
#pragma unroll
              for (int s = 0; s < 4; ++s) kn[s] = *(const bf16x8_t*)(n1 + (ktok + pir) * LD1 + 512 + h * 64 + 32 * hi + 8 * s);
#pragma unroll
              for (int db = 0; db < 2; ++db)
#pragma unroll
                  for (int s2 = 0; s2 < 2; ++s2) vn[db][s2] = *(const bf16x8_t*)(tT + (size_t)(T_AV + h * 64 + db * 32 + r32) * M + ktok + 16 * s2 + 8 * hi); }
#pragma unroll
            for (int qb = 0; qb < 2; ++qb) {
                f32x16_t sa;
#pragma unroll
                for (int i = 0; i < 16; ++i) sa[i] = 0.f;
#pragma unroll
                for (int s = 0; s < 4; ++s) sa = __builtin_amdgcn_mfma_f32_32x32x16_bf16(kf[s], qf[qb][s], sa, 0, 0, 0);
                float sv[16];
                if (j >= 4) {
                    const int rbase = (qb * 32 + r32) - (kb * 32 + 8 * hi) + 64 * (8 - j) + 63;
#pragma unroll
                    for (int i = 0; i < 16; ++i) sv[i] = sa[i] * SC + ext[rbase - (i & 7) - 16 * (i >> 3)];
                } else {
#pragma unroll
                    for (int i = 0; i < 16; ++i) sv[i] = sa[i] * SC + bconst;
                }
                float mx = sv[0];
#pragma unroll
                for (int i = 1; i < 16; ++i) mx = fmaxf(mx, sv[i]);
                mx = fmaxf(mx, __shfl_xor(mx, 32));
                const float mnew = fmaxf(mrun[qb], mx), alpha = __builtin_amdgcn_exp2f(mrun[qb] - mnew); mrun[qb] = mnew;
                float ps = 0.f;
#pragma unroll
                for (int i = 0; i < 16; ++i) { sv[i] = __builtin_amdgcn_exp2f(sv[i] - mnew); ps += sv[i]; }
                lrun[qb] = lrun[qb] * alpha + ps;
#pragma unroll
                for (int db = 0; db < 2; ++db)
#pragma unroll
                    for (int i = 0; i < 16; ++i) o[qb][db][i] *= alpha;
                bf16x8_t pf[2];
#pragma unroll
                for (int s2 = 0; s2 < 2; ++s2) { v4u w; w.x = cvtpk(sv[8 * s2 + 0], sv[8 * s2 + 1]); w.y = cvtpk(sv[8 * s2 + 2], sv[8 * s2 + 3]); w.z = cvtpk(sv[8 * s2 + 4], sv[8 * s2 + 5]); w.w = cvtpk(sv[8 * s2 + 6], sv[8 * s2 + 7]);
                    pf[s2] = __builtin_bit_cast(bf16x8_t, w); }
#pragma unroll
                for (int db = 0; db < 2; ++db)
#pragma unroll
                    for (int s2 = 0; s2 < 2; ++s2) o[qb][db] = __builtin_amdgcn_mfma_f32_32x32x16_bf16(vf[db][s2], pf[s2], o[qb][db], 0, 0, 0);
            }
#pragma unroll
            for (int s = 0; s < 4; ++s) kf[s] = kn[s];
#pragma unroll
            for (int db = 0; db < 2; ++db)
#pragma unroll
                for (int s2 = 0; s2 < 2; ++s2) vf[db][s2] = vn[db][s2];
        }
#pragma unroll
        for (int qb = 0; qb < 2; ++qb) {
            const float lt = lrun[qb] + __shfl_xor(lrun[qb], 32), inv = 1.0f / lt;
            bf16* op = att + (tq0 + qb * 32 + r32) * 512 + h * 64 + 4 * hi;
#pragma unroll
            for (int db = 0; db < 2; ++db)
#pragma unroll
                for (int g4 = 0; g4 < 4; ++g4) { unsigned long long w = (unsigned long long)cvtpk(o[qb][db][4 * g4 + 0] * inv, o[qb][db][4 * g4 + 1] * inv) | ((unsigned long long)cvtpk(o[qb][db][4 * g4 + 2] * inv, o[qb][db][4 * g4 + 3] * inv) << 32);
                    *(unsigned long long*)(op + db * 32 + 8 * g4) = w; }
        }
    }
}

__device__ __forceinline__ float wave_max(float v) {
#pragma unroll
    for (int o = 1; o < 64; o <<= 1) v = fmaxf(v, __shfl_xor(v, o));
    return v;
}
__device__ __forceinline__ float scan_add(float v, int lane) {
#pragma unroll
    for (int o = 1; o < 64; o <<= 1) { const float t = __shfl_up(v, o); if (lane >= o) v += t; }
    return v;
}
__device__ __forceinline__ float scan_max(float v, int lane) {
#pragma unroll
    for (int o = 1; o < 64; o <<= 1) { const float t = __shfl_up(v, o); if (lane >= o) v = fmaxf(v, t); }
    return v;
}
__device__ __forceinline__ bf16x8_t pack8(const float* v) { v4u w; w.x = cvtpk(v[0], v[1]); w.y = cvtpk(v[2], v[3]); w.z = cvtpk(v[4], v[5]); w.w = cvtpk(v[6], v[7]); return __builtin_bit_cast(bf16x8_t, w); }

__device__ __forceinline__ void mlstm_local_mfma(const bf16* tT, const float* gates, const float* cw, const float* cb, bf16* cloc, float* nloc, float* mloc, float* blast, LAS float* ldsf, int bid, int G, int wave, int lane) {
    LAS float* wsm = ldsf + wave * 64;
    const int r32 = lane & 31, hi = lane >> 5;
    for (int task = bid * 8 + wave; task < 2 * NUNIT; task += G * 8) {
        const int unit = task >> 1, kh = task & 1, b = unit >> 8, c = (unit >> 2) & 63, h = unit & 3; const size_t tok0 = (size_t)b * SEQ + c * CHK;
        const float lf = gates[(tok0 + lane) * 8 + 4 + h], ig = gates[(tok0 + lane) * 8 + h];
        const float cum = scan_add(lf, lane), bl = __shfl(cum, 63), a = bl - cum + ig, mxa = wave_max(a);
        wsm[lane] = __expf(a - mxa);
        LDS_WAIT();
        if (kh == 0 && lane == 0) { mloc[unit] = mxa; blast[unit] = bl; }
        f32x16_t acc[2][4];
#pragma unroll
        for (int kb2 = 0; kb2 < 2; ++kb2)
#pragma unroll
            for (int vb = 0; vb < 4; ++vb)
#pragma unroll
                for (int i = 0; i < 16; ++i) acc[kb2][vb][i] = 0.f;
        float nsum[2] = {0.f, 0.f};
        float cwr[2][4], cbr[2];
#pragma unroll
        for (int kb2 = 0; kb2 < 2; ++kb2) { const int ch = 512 + h * 128 + kh * 64 + kb2 * 32 + r32; cbr[kb2] = cb[ch];
#pragma unroll
            for (int j = 0; j < 4; ++j) cwr[kb2][j] = cw[j * 1024 + ch]; }
#pragma unroll
        for (int s = 0; s < 4; ++s) {
            const int l0 = 16 * s + 8 * hi;
            float wv[8];
            { const f32x4 w0 = *(const LAS f32x4*)(wsm + l0), w1 = *(const LAS f32x4*)(wsm + l0 + 4); wv[0] = w0.x; wv[1] = w0.y; wv[2] = w0.z; wv[3] = w0.w; wv[4] = w1.x; wv[5] = w1.y; wv[6] = w1.z; wv[7] = w1.w; }
            bf16x8_t af[2];
#pragma unroll
            for (int kb2 = 0; kb2 < 2; ++kb2) {
                const bf16* rp = tT + (size_t)(T_MK + h * 128 + kh * 64 + kb2 * 32 + r32) * M + tok0 + l0;
                const v4u cur = *(const v4u*)rp; unsigned long long prev = *(const unsigned long long*)(rp - 4);
                if (c == 0 && l0 == 0) prev = 0ull;
                float x[11];
                x[0] = bhi((unsigned)prev); x[1] = blo((unsigned)(prev >> 32)); x[2] = bhi((unsigned)(prev >> 32));
                x[3] = blo(cur.x); x[4] = bhi(cur.x); x[5] = blo(cur.y); x[6] = bhi(cur.y); x[7] = blo(cur.z); x[8] = bhi(cur.z); x[9] = blo(cur.w); x[10] = bhi(cur.w);
                float kv[8];
#pragma unroll
                for (int j = 0; j < 8; ++j) { const float av = cbr[kb2] + cwr[kb2][0] * x[j] + cwr[kb2][1] * x[j + 1] + cwr[kb2][2] * x[j + 2] + cwr[kb2][3] * x[j + 3];
                    const float kw = av * sigmf(av) * 0.08838834764831845f * wv[j]; kv[j] = kw; nsum[kb2] += kw; }
                af[kb2] = pack8(kv);
            }
#pragma unroll
            for (int vb = 0; vb < 4; ++vb) {
                const bf16x8_t vfr = *(const bf16x8_t*)(tT + (size_t)(T_MV + h * 128 + vb * 32 + r32) * M + tok0 + l0);
#pragma unroll
                for (int kb2 = 0; kb2 < 2; ++kb2) acc[kb2][vb] = __builtin_amdgcn_mfma_f32_32x32x16_bf16(af[kb2], vfr, acc[kb2][vb], 0, 0, 0);
            }
        }
#pragma unroll
        for (int kb2 = 0; kb2 < 2; ++kb2) { const float ns = nsum[kb2] + __shfl_xor(nsum[kb2], 32); if (hi == 0) nloc[unit * 128 + kh * 64 + kb2 * 32 + r32] = ns; }
#pragma unroll
        for (int kb2 = 0; kb2 < 2; ++kb2)
#pragma unroll
            for (int vb = 0; vb < 4; ++vb) { bf16* cp = cloc + (size_t)unit * 16384 + (size_t)(vb * 32 + r32) * 128 + kh * 64 + kb2 * 32 + 4 * hi;
#pragma unroll
                for (int g4 = 0; g4 < 4; ++g4) *(unsigned long long*)(cp + 8 * g4) = (unsigned long long)cvtpk(acc[kb2][vb][4 * g4 + 0], acc[kb2][vb][4 * g4 + 1]) | ((unsigned long long)cvtpk(acc[kb2][vb][4 * g4 + 2], acc[kb2][vb][4 * g4 + 3]) << 32); }
    }
}

__device__ __forceinline__ void conv_prepass(const bf16* n2, const float* cw, const float* cb, bf16* qk, int bid, int G, int tid) {
    for (int it = bid * 512 + tid; it < (M / 16) * 128; it += G * 512) {
        const int cg = it & 127, tr = it >> 7, ch0 = 8 * cg; const size_t t0 = (size_t)tr * 16;
        const bf16* src = n2 + (ch0 < 512 ? N2_MQ + ch0 : N2_MK + (ch0 - 512));
        const float sc = ch0 < 512 ? 1.0f : 0.08838834764831845f;
        float w[4][8], bb[8];
#pragma unroll
        for (int e = 0; e < 8; ++e) { bb[e] = cb[ch0 + e];
#pragma unroll
            for (int j = 0; j < 4; ++j) w[j][e] = cw[j * 1024 + ch0 + e]; }
        float x0[8], x1[8], x2[8];
        const bool first = (t0 & (SEQ - 1)) == 0;
#pragma unroll
        for (int r = 0; r < 3; ++r) { v4u v = {0u, 0u, 0u, 0u}; if (!first) v = *(const v4u*)(src + (t0 - 3 + r) * LD2);
            float* d = r == 0 ? x0 : (r == 1 ? x1 : x2);
            d[0] = blo(v.x); d[1] = bhi(v.x); d[2] = blo(v.y); d[3] = bhi(v.y); d[4] = blo(v.z); d[5] = bhi(v.z); d[6] = blo(v.w); d[7] = bhi(v.w); }
#pragma unroll 4
        for (int i = 0; i < 16; ++i) {
            const v4u v = *(const v4u*)(src + (t0 + i) * LD2); float x3[8] = {blo(v.x), bhi(v.x), blo(v.y), bhi(v.y), blo(v.z), bhi(v.z), blo(v.w), bhi(v.w)}; float o[8];
#pragma unroll
            for (int e = 0; e < 8; ++e) { const float a = bb[e] + w[0][e] * x0[e] + w[1][e] * x1[e] + w[2][e] * x2[e] + w[3][e] * x3[e]; o[e] = a * sigmf(a) * sc; x0[e] = x1[e]; x1[e] = x2[e]; x2[e] = x3[e]; }
            v4u ov; ov.x = cvtpk(o[0], o[1]); ov.y = cvtpk(o[2], o[3]); ov.z = cvtpk(o[4], o[5]); ov.w = cvtpk(o[6], o[7]);
            *(v4u*)(qk + (t0 + i) * 1024 + ch0) = ov;
        }
    }
}

__device__ __forceinline__ void mlstm_out_mfma(const bf16* qk, const bf16* n2, const bf16* tT, const float* gates, const bf16* cst, const float* nst, const float* mst, const float* mhg, bf16* mout, LAS float* ldsf, int bid, int G, int wave, int lane) {
    LAS float* sm = ldsf + wave * 256;
    const int r32 = lane & 31, hi = lane >> 5;
    const int pir = (r32 & ~12) | ((r32 & 4) << 1) | ((r32 & 8) >> 1);
    for (int task = bid * 8 + wave; task < 2 * NUNIT; task += G * 8) {
        const int unit = task >> 1, tb = task & 1, b = unit >> 8, c = (unit >> 2) & 63, h = unit & 3; const size_t tok0 = (size_t)b * SEQ + c * CHK;
        { const float lf = gates[(tok0 + lane) * 8 + 4 + h], ig = gates[(tok0 + lane) * 8 + h];
          const float cum = scan_add(lf, lane), e = ig - cum, pm = scan_max(e, lane), g = cum + mst[unit], mt = fmaxf(g, cum + pm);
          sm[lane] = e; sm[64 + lane] = cum; sm[128 + lane] = mt; sm[192 + lane] = __expf(g - mt); }
        LDS_WAIT();
        const int t = tb * 32 + r32; const float bc_t = sm[64 + t], mt_t = sm[128 + t], in_t = sm[192 + t];
        bf16x8_t qf[8];
#pragma unroll
        for (int s = 0; s < 8; ++s) qf[s] = *(const bf16x8_t*)(qk + (tok0 + t) * 1024 + h * 128 + 64 * hi + 8 * s);
        float nq = 0.f;
#pragma unroll
        for (int s = 0; s < 8; ++s) { const f32x4 n0 = *(const f32x4*)(nst + unit * 128 + 64 * hi + 8 * s), n1 = *(const f32x4*)(nst + unit * 128 + 64 * hi + 8 * s + 4); const v4u q = __builtin_bit_cast(v4u, qf[s]);
            nq += n0.x * blo(q.x) + n0.y * bhi(q.x) + n0.z * blo(q.y) + n0.w * bhi(q.y) + n1.x * blo(q.z) + n1.y * bhi(q.z) + n1.z * blo(q.w) + n1.w * bhi(q.w); }
        nq += __shfl_xor(nq, 32);
        f32x16_t num[4];
#pragma unroll
        for (int vb = 0; vb < 4; ++vb) {
#pragma unroll
            for (int i = 0; i < 16; ++i) num[vb][i] = 0.f;
#pragma unroll
            for (int s = 0; s < 8; ++s) { const bf16x8_t cf = *(const bf16x8_t*)(cst + (size_t)unit * 16384 + (size_t)(vb * 32 + r32) * 128 + 64 * hi + 8 * s);
                num[vb] = __builtin_amdgcn_mfma_f32_32x32x16_bf16(cf, qf[s], num[vb], 0, 0, 0); }
#pragma unroll
            for (int i = 0; i < 16; ++i) num[vb][i] *= in_t;
        }
        float dsum = 0.f;
        for (int sb = 0; sb <= tb; ++sb) {
            f32x16_t sa;
#pragma unroll
            for (int i = 0; i < 16; ++i) sa[i] = 0.f;
#pragma unroll
            for (int s = 0; s < 8; ++s) { const bf16x8_t kf = *(const bf16x8_t*)(qk + (tok0 + sb * 32 + pir) * 1024 + 512 + h * 128 + 64 * hi + 8 * s);
                sa = __builtin_amdgcn_mfma_f32_32x32x16_bf16(kf, qf[s], sa, 0, 0, 0); }
            float dv[16];
#pragma unroll
            for (int hf = 0; hf < 2; ++hf) { const int sbase = sb * 32 + 16 * hf + 8 * hi;
                const f32x4 e0 = *(const LAS f32x4*)(sm + sbase), e1 = *(const LAS f32x4*)(sm + sbase + 4); const float ev[8] = {e0.x, e0.y, e0.z, e0.w, e1.x, e1.y, e1.z, e1.w};
#pragma unroll
                for (int j = 0; j < 8; ++j) { float val = sa[8 * hf + j] * __expf(bc_t - mt_t + ev[j]); val = (sbase + j > t) ? 0.f : val; dv[8 * hf + j] = val; dsum += val; } }
            bf16x8_t pf[2] = {pack8(dv), pack8(dv + 8)};
#pragma unroll
            for (int vb = 0; vb < 4; ++vb)
#pragma unroll
                for (int s2 = 0; s2 < 2; ++s2) { const bf16x8_t vfr = *(const bf16x8_t*)(tT + (size_t)(T_MV + h * 128 + vb * 32 + r32) * M + tok0 + sb * 32 + 16 * s2 + 8 * hi);
                    num[vb] = __builtin_amdgcn_mfma_f32_32x32x16_bf16(vfr, pf[s2], num[vb], 0, 0, 0); }
        }
        dsum += __shfl_xor(dsum, 32);
        const float den = in_t * nq + dsum, inv = 1.0f / fmaxf(fabsf(den), __expf(-mt_t));
        float ss = 0.f;
#pragma unroll
        for (int vb = 0; vb < 4; ++vb)
#pragma unroll
            for (int i = 0; i < 16; ++i) { const float hv = num[vb][i] * inv; num[vb][i] = hv; ss += hv * hv; }
        ss += __shfl_xor(ss, 32);
        const float rms = rsqrtf(ss * (1.0f / 128.0f) + EPS);
#pragma unroll
        for (int vb = 0; vb < 4; ++vb)
#pragma unroll
            for (int g4 = 0; g4 < 4; ++g4) { const int v0 = vb * 32 + 8 * g4 + 4 * hi;
                const unsigned long long mo = *(const unsigned long long*)(n2 + (tok0 + t) * LD2 + N2_MO + h * 128 + v0); const f32x4 gg = *(const f32x4*)(mhg + h * 128 + v0);
                const float o0 = sigmf(blo((unsigned)mo)) * num[vb][4 * g4 + 0] * rms * gg.x, o1 = sigmf(bhi((unsigned)mo)) * num[vb][4 * g4 + 1] * rms * gg.y;
                const float o2 = sigmf(blo((unsigned)(mo >> 32))) * num[vb][4 * g4 + 2] * rms * gg.z, o3 = sigmf(bhi((unsigned)(mo >> 32))) * num[vb][4 * g4 + 3] * rms * gg.w;
                *(unsigned long long*)(mout + (tok0 + t) * 512 + h * 128 + v0) = (unsigned long long)cvtpk(o0, o1) | ((unsigned long long)cvtpk(o2, o3) << 32); }
    }
}

__device__ __forceinline__ void mlstm_local_naive(const bf16* n2, const bf16* tT, const float* gates, const float* cw, const float* cb, bf16* cloc, float* nloc, float* mloc, float* blast, float* lds, int bid, int G, int tid) {
    float* KS = lds; float* WV = lds + 8192; float* sm = lds + 16384;
    for (int unit = bid; unit < NUNIT; unit += G) {
        const int b = unit >> 8, c = (unit >> 2) & 63, h = unit & 3; const size_t tok0 = (size_t)b * SEQ + c * CHK;
        if (tid < 64) { sm[tid] = gates[(tok0 + tid) * 8 + 4 + h]; sm[64 + tid] = gates[(tok0 + tid) * 8 + h]; }
        __syncthreads();
        if (tid == 0) { float cum = 0.f; for (int l = 0; l < 64; ++l) { cum += sm[l]; sm[128 + l] = cum; }
            float mxa = -INFINITY; for (int l = 0; l < 64; ++l) { const float a = cum - sm[128 + l] + sm[64 + l]; sm[192 + l] = a; mxa = fmaxf(mxa, a); }
            for (int l = 0; l < 64; ++l) sm[192 + l] = __expf(sm[192 + l] - mxa);
            sm[256] = mxa; sm[257] = cum; }
        __syncthreads();
        for (int e = tid; e < 8192; e += 512) { const int l = e >> 7, d = e & 127, pos = c * CHK + l, ch = 512 + h * 128 + d;
            float a = cb[ch];
#pragma unroll
            for (int j = 0; j < 4; ++j) { const int p = pos - 3 + j; if (p >= 0) a += cw[j * 1024 + ch] * bf2f(n2[((size_t)b * SEQ + p) * LD2 + N2_MK + h * 128 + d]); }
            KS[e] = a * sigmf(a) * 0.08838834764831845f;
            WV[e] = sm[192 + l] * bf2f(tT[(size_t)(T_MV + h * 128 + d) * M + tok0 + l]); }
        __syncthreads();
        { const int k = tid & 127, vg = tid >> 7; float a[32];
#pragma unroll
          for (int i = 0; i < 32; ++i) a[i] = 0.f;
          for (int l = 0; l < 64; ++l) { const float kk = KS[l * 128 + k];
#pragma unroll
              for (int i = 0; i < 32; ++i) a[i] += WV[l * 128 + vg * 32 + i] * kk; }
          bf16* cp = cloc + (size_t)unit * 16384 + (size_t)(vg * 32) * 128 + k;
#pragma unroll
          for (int i = 0; i < 32; ++i) cp[i * 128] = (bf16)f2bf(a[i]); }
        if (tid < 128) { float s = 0.f; for (int l = 0; l < 64; ++l) s += sm[192 + l] * KS[l * 128 + tid]; nloc[unit * 128 + tid] = s; }
        if (tid == 0) { mloc[unit] = sm[256]; blast[unit] = sm[257]; }
        __syncthreads();
    }
}

__device__ __forceinline__ void mlstm_scan(bf16* cloc, float* nloc, const float* mloc, const float* blast, float* mst, int bid, int G, int tid) {
    const int gt = bid * 512 + tid, NT = G * 512;
    for (int it = gt; it < 16 * 8192; it += NT) {
        const int bh = it >> 13, e2 = it & 8191, b = bh >> 2, h = bh & 3; float C0 = 0.f, C1 = 0.f, m = 0.f;
        unsigned* base = (unsigned*)cloc + e2; const int u0 = b * NCHK * 4 + h;
        unsigned w[8]; float ml[8], bl[8];
#pragma unroll
        for (int i = 0; i < 8; ++i) { const int unit = u0 + 4 * i; w[i] = base[(size_t)unit * 8192]; ml[i] = mloc[unit]; bl[i] = blast[unit]; }
        for (int c0 = 0; c0 < NCHK; c0 += 8) {
#pragma unroll
            for (int i = 0; i < 8; ++i) {
                const int unit = u0 + 4 * (c0 + i); const unsigned wc = w[i]; const float mlc = ml[i], blc = bl[i];
                if (c0 + 8 < NCHK) { const int un = unit + 32; w[i] = base[(size_t)un * 8192]; ml[i] = mloc[un]; bl[i] = blast[un]; }
                base[(size_t)unit * 8192] = pk2(C0, C1);
                if (e2 == 0) mst[unit] = m;
                const float mn = fmaxf(blc + m, mlc), sp = __expf(blc + m - mn), sl = __expf(mlc - mn);
                C0 = sp * C0 + sl * blo(wc); C1 = sp * C1 + sl * bhi(wc); m = mn;
            }
        }
    }
    for (int it = gt; it < 16 * 128; it += NT) {
        const int bh = it >> 7, k = it & 127, b = bh >> 2, h = bh & 3; float n = 0.f, m = 0.f;
        for (int c = 0; c < NCHK; ++c) { const int unit = (b * NCHK + c) * 4 + h; const float ml = mloc[unit], bl = blast[unit];
            const float nl = nloc[unit * 128 + k]; nloc[unit * 128 + k] = n;
            const float mn = fmaxf(bl + m, ml), sp = __expf(bl + m - mn), sl = __expf(ml - mn);
            n = sp * n + sl * nl; m = mn; }
    }
}

__device__ __forceinline__ void mlstm_out_naive(const bf16* n2, const bf16* tT, const float* gates, const float* cw, const float* cb, const bf16* cst, const float* nst, const float* mst, const float* mhg, bf16* mout, float* lds, int bid, int G, int tid) {
    constexpr int QP = 129, DP = 65;
    float* QS = lds; float* KS = lds + 64 * QP; float* VS = lds + 2 * 64 * QP; float* DS = VS + 8192; float* sm = DS + 64 * DP;
    for (int unit = bid; unit < NUNIT; unit += G) {
        const int b = unit >> 8, c = (unit >> 2) & 63, h = unit & 3; const size_t tok0 = (size_t)b * SEQ + c * CHK;
        for (int e = tid; e < 8192; e += 512) { const int l = e >> 7, d = e & 127, pos = c * CHK + l, chq = h * 128 + d, chk = 512 + chq;
            float aq = cb[chq], ak = cb[chk];
#pragma unroll
            for (int j = 0; j < 4; ++j) { const int p = pos - 3 + j; if (p >= 0) { const bf16* rp = n2 + ((size_t)b * SEQ + p) * LD2; aq += cw[j * 1024 + chq] * bf2f(rp[N2_MQ + chq]); ak += cw[j * 1024 + chk] * bf2f(rp[N2_MK + chq]); } }
            QS[l * QP + d] = aq * sigmf(aq); KS[l * QP + d] = ak * sigmf(ak) * 0.08838834764831845f;
            VS[e] = bf2f(tT[(size_t)(T_MV + chq) * M + tok0 + l]); }
        if (tid < 64) { sm[tid] = gates[(tok0 + tid) * 8 + 4 + h]; sm[64 + tid] = gates[(tok0 + tid) * 8 + h]; }
        __syncthreads();
        if (tid == 0) { float cum = 0.f, pm = -INFINITY; const float ms = mst[unit];
            for (int t = 0; t < 64; ++t) { cum += sm[t]; sm[128 + t] = cum; pm = fmaxf(pm, sm[64 + t] - cum); const float g = cum + ms, mt = fmaxf(g, cum + pm); sm[192 + t] = mt; sm[256 + t] = __expf(g - mt); } }
        __syncthreads();
        for (int e = tid; e < 4096; e += 512) { const int t = e >> 6, s = e & 63; float val = 0.f;
            if (s <= t) { float dot = 0.f;
#pragma unroll 8
                for (int d = 0; d < 128; ++d) dot += QS[t * QP + d] * KS[s * QP + d];
                val = dot * __expf(sm[128 + t] - sm[128 + s] + sm[64 + s] - sm[192 + t]); }
            DS[t * DP + s] = val; }
        __syncthreads();
        if (tid < 64) { const int t = tid; float sq = 0.f, sd = 0.f;
            for (int k = 0; k < 128; ++k) sq += nst[unit * 128 + k] * QS[t * QP + k];
            for (int s = 0; s < 64; ++s) sd += DS[t * DP + s];
            const float den = sm[256 + t] * sq + sd; sm[320 + t] = fmaxf(fabsf(den), __expf(-sm[192 + t])); }
        const int v = tid & 127, tg = tid >> 7; float a[16];
#pragma unroll
        for (int i = 0; i < 16; ++i) a[i] = 0.f;
        { const bf16* crow = cst + (size_t)unit * 16384 + (size_t)v * 128;
          for (int k = 0; k < 128; ++k) { const float cv = bf2f(crow[k]);
#pragma unroll
              for (int i = 0; i < 16; ++i) a[i] += cv * QS[(tg * 16 + i) * QP + k]; } }
#pragma unroll
        for (int i = 0; i < 16; ++i) a[i] *= sm[256 + tg * 16 + i];
        for (int s = 0; s < 64; ++s) { const float vv = VS[s * 128 + v];
#pragma unroll
            for (int i = 0; i < 16; ++i) a[i] += DS[(tg * 16 + i) * DP + s] * vv; }
        __syncthreads();
        float* HS = KS;
#pragma unroll
        for (int i = 0; i < 16; ++i) HS[(tg * 16 + i) * QP + v] = a[i] / sm[320 + tg * 16 + i];
        __syncthreads();
        if (tid < 64) { float s = 0.f; for (int k = 0; k < 128; ++k) { const float x = HS[tid * QP + k]; s += x * x; } sm[384 + tid] = rsqrtf(s * (1.0f / 128.0f) + EPS); }
        __syncthreads();
        for (int e = tid; e < 8192; e += 512) { const int t = e >> 7, vv = e & 127;
            const float mo = bf2f(n2[(tok0 + t) * LD2 + N2_MO + h * 128 + vv]);
            mout[(tok0 + t) * 512 + h * 128 + vv] = (bf16)f2bf(sigmf(mo) * HS[t * QP + vv] * sm[384 + t] * mhg[h * 128 + vv]); }
        __syncthreads();
    }
}

#define XB_TMO      128
#define XB_XCNT(j)  (256  + 64 * (j))
#define XB_XSUB(j)  (1280 + 64 * (j))
#define XB_XGEN(j)  (2304 + 64 * (j))
#define XB_TOP      3328
#define XB_TOPGEN   3392
#define XCD_BAR_WORDS 3456
#define XB_SPIN_CAP (1u << 18)

__device__ __forceinline__ unsigned xb_ld(unsigned* p)              { return __hip_atomic_load(p, __ATOMIC_RELAXED, __HIP_MEMORY_SCOPE_AGENT); }
__device__ __forceinline__ unsigned xb_add(unsigned* p, unsigned v) { return __hip_atomic_fetch_add(p, v, __ATOMIC_RELAXED, __HIP_MEMORY_SCOPE_AGENT); }
__device__ __forceinline__ unsigned xb_xcc_id() { return (unsigned)__builtin_amdgcn_s_getreg((3 << 11) | 20) & 0xFu; }
#define XB_SPIN(cond, bar) do { unsigned _sp = 0; while (cond) { __builtin_amdgcn_s_sleep(1); \
    if ((++_sp & 255u) == 0u) { if (xb_ld(&(bar)[XB_TMO])) break; if (_sp > XB_SPIN_CAP) { atomicAdd(&(bar)[XB_TMO], 1u); break; } } } } while (0)

struct XcdBarrier {
    unsigned* bar; unsigned x;
    volatile LAS unsigned* st;
};

__device__ __forceinline__ XcdBarrier xcd_barrier_post(unsigned* bar, volatile LAS unsigned* st) {
    XcdBarrier b; b.bar = bar; b.x = xb_xcc_id(); b.st = st;
    if (threadIdx.x == 0) (void)xb_add(&bar[XB_XCNT(b.x)], 1u);
    return b;
}
__device__ __forceinline__ void xcd_barrier_complete(unsigned* bar, unsigned x, unsigned& nloc, unsigned& nx) {
    const unsigned G = gridDim.x * gridDim.y * gridDim.z;
    unsigned sum, cnt, mine, sp = 0u;
    for (;;) {
        sum = 0u; cnt = 0u; mine = 0u;
#pragma unroll
        for (unsigned j = 0; j < 16; ++j) { const unsigned c = xb_ld(&bar[XB_XCNT(j)]); sum += c; cnt += (c > 0u) ? 1u : 0u; mine = (j == x) ? c : mine; }
        if (sum == G) break;
        __builtin_amdgcn_s_sleep(1);
        if ((++sp & 255u) == 0u) { if (xb_ld(&bar[XB_TMO])) break; if (sp > XB_SPIN_CAP) { atomicAdd(&bar[XB_TMO], 1u); break; } }
    }
    nloc = mine > 0u ? mine : 1u; nx = cnt > 0u ? cnt : 1u;
}

__device__ __forceinline__ void xcd_barrier(const XcdBarrier& b) {
    asm volatile("s_waitcnt vmcnt(0)" ::: "memory");
    __syncthreads();
    if (threadIdx.x == 0) {
        unsigned* bar = b.bar;
        __builtin_amdgcn_s_waitcnt(0);
        unsigned nloc = b.st[0], nx = b.st[1];
        if (nloc == 0u) { xcd_barrier_complete(bar, b.x, nloc, nx); b.st[0] = nloc; b.st[1] = nx; }
        const unsigned old = xb_add(&bar[XB_XSUB(b.x)], 1u);
        const unsigned gen = old / nloc;
        if (old + 1u == (gen + 1u) * nloc) {
            __builtin_amdgcn_fence(__ATOMIC_RELEASE, "agent");
            asm volatile("s_waitcnt vmcnt(0)" ::: "memory");
            const unsigned og = xb_add(&bar[XB_TOP], 1u);
            const unsigned tg = og / nx;
            if (og + 1u == (tg + 1u) * nx) xb_add(&bar[XB_TOPGEN], 1u);
            else XB_SPIN(xb_ld(&bar[XB_TOPGEN]) == tg, bar);
            __builtin_amdgcn_fence(__ATOMIC_ACQUIRE, "agent");
            xb_add(&bar[XB_XGEN(b.x)], 1u);
            asm volatile("s_waitcnt vmcnt(0)" ::: "memory");
        } else {
            XB_SPIN(xb_ld(&bar[XB_XGEN(b.x)]) == gen, bar);
            __builtin_amdgcn_fence(__ATOMIC_ACQUIRE, "agent");
            asm volatile("s_waitcnt vmcnt(0)" ::: "memory");
        }
    }
    __syncthreads();
}
constexpr int N_STEPS = 27, STEP_PRO1 = 13, STEP_FIN = 26, KPL = 13;
enum { K_PRO = 100, K_FIN = 101, K_A = 0, K_A2 = 1, K_B = 2, K_C = 3, K_D = 4, K_E1 = 5, K_E2 = 6, K_E3 = 7, K_E4 = 8, K_F = 9, K_G = 10, K_H = 11 };
struct Args { const float* in[16]; float* out; unsigned char* ws; int ph_lo, ph_hi; };

enum { SEL_ALL = 0, SEL_PRO = 1, SEL_FIN = 2, SEL_B = 3, SEL_C = 4, SEL_D = 5, SEL_GEMM = 6, SEL_GATES = 7 };
template <int SEL> __global__ void __launch_bounds__(512, 2) mk_fwd(Args args) {
    extern __shared__ __attribute__((aligned(16))) unsigned char lds[];
    constexpr int G = 256; const int bid = blockIdx.x;
    {
        LAS unsigned char* ldsl0 = (LAS unsigned char*)lds;
        for (int u = threadIdx.x; u < (LDS_BYTES - LDSCTL_OFF) / 4; u += 512) ((LAS unsigned*)(ldsl0 + LDSCTL_OFF))[u] = 0u;
        __syncthreads();
    }
    XcdBarrier bar; bar.bar = (unsigned*)(args.ws + WS_CTL) + CW_BAR; bar.x = 0; bar.st = nullptr;
    if (MK_ONE_LAUNCH) bar = xcd_barrier_post((unsigned*)(args.ws + WS_CTL) + CW_BAR, (volatile LAS unsigned*)((LAS unsigned char*)lds + MISC_OFF) + 8);

    int prep = 0;
    for (int step = args.ph_lo; step < args.ph_hi;) {
        int tid = threadIdx.x; asm volatile("" : "+v"(tid));
        const int lane = tid & 63, wave = __builtin_amdgcn_readfirstlane(tid >> 6), gw = bid * 8 + wave, NGW = G * 8;
        unsigned char* ws = args.ws; asm volatile("" : "+s"(ws));
        int zi = 0; asm volatile("" : "+s"(zi));
#define INP(k) (args.in[(k) + zi])
        LAS unsigned char* ldsl = (LAS unsigned char*)lds;
        const float* x_in = INP(0); float* xout = args.out; asm volatile("" : "+s"(xout));
        float* ssq = (float*)(ws + WS_SSQ); float* wg = (float*)(ws + WS_WG); float* gates = (float*)(ws + WS_GATES);
        float* nloc = (float*)(ws + WS_NLOC); float* mloc = (float*)(ws + WS_MLOC); float* blast = (float*)(ws + WS_BLAST); float* mst = (float*)(ws + WS_MST);
        bf16* Wb = (bf16*)(ws + WS_W); bf16* xb = (bf16*)(ws + WS_XB); bf16* n1 = (bf16*)(ws + WS_N1); bf16* n2 = (bf16*)(ws + WS_N2); bf16* tT = (bf16*)(ws + WS_T); bf16* att = (bf16*)(ws + WS_ATT);
        bf16* cloc = (bf16*)(ws + WS_CLOC); bf16* mout = (bf16*)(ws + WS_MOUT); bf16* Yb = (bf16*)(ws + WS_Y); bf16* Zb = (bf16*)(ws + WS_Z); bf16* Hb = (bf16*)(ws + WS_H);
        const int layer = step >= STEP_PRO1 ? 1 : 0;
        const int kind = (step == 0 || step == STEP_PRO1) ? K_PRO : (step == STEP_FIN ? K_FIN : (step - 1) % KPL);
        float* ssqA = ssq + (size_t)(2 * layer) * M; float* ssqF = ssq + (size_t)(2 * layer + 1) * M; float* ssqN = ssq + (size_t)(2 * layer + 2) * M;
        const float* xres = layer == 0 ? x_in : xout;

        if ((SEL == SEL_ALL || SEL == SEL_PRO) && kind == K_PRO) {
            LAS float* scr = (LAS float*)(ldsl + wave * 16384);
            const float* w_in = INP(2) + (size_t)layer * DM * DIN_SRC; const float* g_mix = INP(1) + layer * DM;
            const float* w_a = INP(9) + (size_t)layer * 512 * DM; const float* w_m = INP(10) + (size_t)layer * 512 * DM;
            const float* w_o = INP(11) + (size_t)layer * DM * DM; const float* g_ffn = INP(12) + layer * DM;
            const float* w_up = INP(13) + (size_t)layer * DM * DFF; const float* w_dn = INP(14) + (size_t)layer * DFF * DM;
            constexpr int I_IN = 16 * 176, I_A = 8 * 32, I_M = 8 * 32, I_O = 16 * 32, I_UP = 16 * 128, I_DN = 64 * 32, NITEMS = I_IN + I_A + I_M + I_O + I_UP + I_DN;
            for (int it = gw; it < NITEMS; it += NGW) {
                int r = it;
                if (r < I_IN) { transpose_item(w_in, DIN_SRC, 1, g_mix, Wb + W_IN, 1024, 176, scr, r, lane); continue; } r -= I_IN;
                if (r < I_A) { transpose_item(w_a, DM, 0, nullptr, Wb + W_A, 512, 32, scr, r, lane); continue; } r -= I_A;
                if (r < I_M) { transpose_item(w_m, DM, 0, nullptr, Wb + W_M, 512, 32, scr, r, lane); continue; } r -= I_M;
                if (r < I_O) { transpose_item(w_o, DM, 0, nullptr, Wb + W_O, 1024, 32, scr, r, lane); continue; } r -= I_O;
                if (r < I_UP) { transpose_item(w_up, DFF, 0, g_ffn, Wb + W_UP, 1024, 128, scr, r, lane); continue; } r -= I_UP;
                transpose_item(w_dn, DM, 0, nullptr, Wb + W_DN, 4096, 32, scr, r, lane);
            }
            for (int i = bid * 512 + tid; i < 8 * 1024; i += G * 512) { const int j = i >> 10, k = i & 1023; wg[i] = g_mix[k] * w_in[(size_t)k * DIN_SRC + 3584 + j]; }
            if (layer == 0) {
                for (int i = bid * 512 + tid; i < 4 * M; i += G * 512) ssq[M + i] = 0.f;
                for (int m = gw; m < M; m += NGW) {
                    const f32x4* xr = (const f32x4*)(x_in + (size_t)m * DM) + lane; f32x4 v[4]; float s = 0.f;
#pragma unroll
                    for (int j = 0; j < 4; ++j) { v[j] = xr[64 * j]; s += (v[j].x * v[j].x + v[j].y * v[j].y) + (v[j].z * v[j].z + v[j].w * v[j].w); }
                    s = wave_sum(s); if (lane == 0) ssq[m] = s;
                    unsigned long long* o8 = (unsigned long long*)(xb + (size_t)m * DM) + lane;
#pragma unroll
                    for (int j = 0; j < 4; ++j) o8[64 * j] = (unsigned long long)pk2(v[j].x, v[j].y) | ((unsigned long long)pk2(v[j].z, v[j].w) << 32);
                }
            }
        } else if ((SEL == SEL_ALL || SEL == SEL_FIN) && kind == K_FIN) {
            const float* gf = INP(15);
            for (int m = gw; m < M; m += NGW) {
                const float rs = rsqrtf(ssqN[m] * (1.0f / 1024.0f) + EPS);
                f32x4* xr = (f32x4*)(xout + (size_t)m * DM) + lane; const f32x4* gr = (const f32x4*)gf + lane;
#pragma unroll
                for (int j = 0; j < 4; ++j) { const f32x4 v = xr[64 * j], g = gr[64 * j]; xr[64 * j] = v * rs * g; }
            }
        } else if ((SEL == SEL_ALL || SEL == SEL_B) && kind == K_B) {
#if FAST_ATTN
            attn_mfma(n1, tT, INP(7) + (size_t)layer * 8 * 513, att, (LAS float*)ldsl, bid, G, wave, lane);
            __syncthreads();
#else
            attn_naive(n1, tT, INP(7) + (size_t)layer * 8 * 513, att, bid, G, wave, lane);
#endif
#if FAST_LOCAL
            mlstm_local_mfma(tT, gates, INP(3) + (size_t)layer * 4096, INP(4) + (size_t)layer * 1024, cloc, nloc, mloc, blast, (LAS float*)ldsl, bid, G, wave, lane);
#else
            mlstm_local_naive(n2, tT, gates, INP(3) + (size_t)layer * 4096, INP(4) + (size_t)layer * 1024, cloc, nloc, mloc, blast, (float*)lds, bid, G, tid);
#endif
        } else if ((SEL == SEL_ALL || SEL == SEL_C) && kind == K_C) {
            mlstm_scan(cloc, nloc, mloc, blast, mst, bid, G, tid);
#if FAST_OUT
            conv_prepass(n2, INP(3) + (size_t)layer * 4096, INP(4) + (size_t)layer * 1024, n1, bid, G, tid);
#endif
        } else if ((SEL == SEL_ALL || SEL == SEL_D) && kind == K_D) {
#if FAST_OUT
            mlstm_out_mfma(n1, n2, tT, gates, cloc, nloc, mst, INP(8) + (size_t)layer * 512, mout, (LAS float*)ldsl, bid, G, wave, lane);
#else
            mlstm_out_naive(n2, tT, gates, INP(3) + (size_t)layer * 4096, INP(4) + (size_t)layer * 1024, cloc, nloc, mst, INP(8) + (size_t)layer * 512, mout, (float*)lds, bid, G, tid);
#endif
        } else if ((SEL == SEL_ALL || SEL == SEL_GEMM) && kind <= K_H && kind != K_A2) {
#ifndef GATES_ON
#define GATES_ON 1
#endif
#ifdef GEMM_ONLY
#define GEMM_ON(k) ((k) == GEMM_ONLY)
#else
#define GEMM_ON(k) true
#endif
            pg8::StaticOrder S;
#define RUN_GEMM_X(MODE, MR_, CU_, A_, BT_, N_, K_, O_, LDC_, Z_, SSQI_, BASE_, OUTF_, SSQO_, O2_, LDC2_, SPLIT_) do { pg8::Gemm g; g.A = (A_); g.Bt = (BT_); g.M = (MR_); g.N = (N_); g.K = (K_); \
                pg8::EpiAny<MODE> E; E.O = (O_); E.ldc = (LDC_); E.Z = (Z_); E.ssq_in = (SSQI_); E.base = (BASE_); E.outf = (OUTF_); E.ssq_out = (SSQO_); E.O2 = (O2_); E.ldc2 = (LDC2_); E.split = (SPLIT_); \
                S.init((MR_), (N_), G, (CU_)); pg8::gemm_phase<pg8::EpiAny<MODE>, pg8::StaticOrder, true, true>(ldsl, g, S, E); } while (0)
#define RUN_GEMM(MODE, A_, BT_, N_, K_, O_, LDC_, Z_, SSQI_, BASE_, OUTF_, SSQO_) RUN_GEMM_X(MODE, M, bid, A_, BT_, N_, K_, O_, LDC_, Z_, SSQI_, BASE_, OUTF_, SSQO_, nullptr, 0, 0)
            if (GEMM_ON(K_A) && kind == K_A) {
                RUN_GEMM_X(0, M, bid, xb, Wb + W_IN, 2560, 1024, n1, LD1, nullptr, ssqA, nullptr, nullptr, nullptr, n2, LD2, 1024);
                RUN_GEMM_X(6, 1536, (bid + G / 2) % G, Wb + W_IN + (size_t)2048 * 1024, xb, M, 1024, tT, M, nullptr, ssqA, nullptr, nullptr, nullptr, nullptr, 0, 0);
            }
            else if (GEMM_ON(K_E1) && kind == K_E1) RUN_GEMM(2, att, Wb + W_A, 1024, 512, Yb, 1024, nullptr, nullptr, nullptr, nullptr, nullptr);
            else if (GEMM_ON(K_E2) && kind == K_E2) RUN_GEMM(3, xb, Wb + W_IN + (size_t)3584 * 1024, 1024, 1024, Yb, 1024, nullptr, ssqA, nullptr, nullptr, nullptr);
            else if (GEMM_ON(K_E3) && kind == K_E3) RUN_GEMM(2, mout, Wb + W_M, 1024, 512, Zb, 1024, nullptr, nullptr, nullptr, nullptr, nullptr);
            else if (GEMM_ON(K_E4) && kind == K_E4) RUN_GEMM(4, xb, Wb + W_IN + (size_t)4608 * 1024, 1024, 1024, Yb, 1024, Zb, ssqA, nullptr, nullptr, nullptr);
            else if (GEMM_ON(K_F) && kind == K_F)  RUN_GEMM(5, Yb, Wb + W_O, 1024, 1024, xb, 1024, nullptr, nullptr, xres, xout, ssqF);
            else if (GEMM_ON(K_G) && kind == K_G)  RUN_GEMM(1, xb, Wb + W_UP, 4096, 1024, Hb, DFF, nullptr, ssqF, nullptr, nullptr, nullptr);
            else if (GEMM_ON(K_H)) RUN_GEMM(5, Hb, Wb + W_DN, 1024, 4096, xb, 1024, nullptr, nullptr, xout, xout, ssqN);
        } else if ((SEL == SEL_ALL || SEL == SEL_GATES) && kind == K_A2) {
                const float* bi = INP(5) + layer * 4; const float* bf_ = INP(6) + layer * 4;
                for (int m = gw; m < M; m += NGW) {
                    const f32x4* xr = (const f32x4*)(xres + (size_t)m * DM) + lane; f32x4 v[4]; float s = 0.f; float d[8];
#pragma unroll
                    for (int j = 0; j < 4; ++j) { v[j] = xr[64 * j]; s += (v[j].x * v[j].x + v[j].y * v[j].y) + (v[j].z * v[j].z + v[j].w * v[j].w); }
#pragma unroll
                    for (int q = 0; q < 8; ++q) { const f32x4* wr_ = (const f32x4*)(wg + q * 1024) + lane; float a = 0.f;
#pragma unroll
                        for (int j = 0; j < 4; ++j) { const f32x4 w = wr_[64 * j]; a += (v[j].x * w.x + v[j].y * w.y) + (v[j].z * w.z + v[j].w * w.w); }
                        d[q] = wave_sum(a); }
                    s = wave_sum(s); const float rs = rsqrtf(s * (1.0f / 1024.0f) + EPS);
                    float val = d[0];
#pragma unroll
                    for (int q = 1; q < 8; ++q) val = (lane == q) ? d[q] : val;
                    if (lane < 4) gates[(size_t)m * 8 + lane] = val * rs + bi[lane];
                    else if (lane < 8) { const float f = val * rs + bf_[lane - 4]; gates[(size_t)m * 8 + lane] = fminf(f, 0.f) - log1pf(__expf(-fabsf(f))); }
                }
        }
        const bool seam = !(kind == K_A || kind == K_E1 || kind == K_E2 || kind == K_E3);
        if (seam && step + 1 < args.ph_hi) { if (MK_ONE_LAUNCH) xcd_barrier(bar); }
#ifdef PROBE_REPEAT
        if ((PROBE_REPEAT_COND) && prep + 1 < PROBE_REPEAT) { ++prep; } else { prep = 0; ++step; }
#else
        ++step;
#endif
    }
}

extern "C" void kernel_launch(void* const* d_in, const int* in_sizes, int n_in, void* d_out, int out_size, void* d_ws, size_t ws_size, hipStream_t stream) {
    static int grid = 0;
    if (grid == 0) {
        if (n_in != 16 || in_sizes[0] != M * DM || out_size != M * DM || ws_size < WS_END) { fprintf(stderr, "kernel_launch: unexpected shapes (n_in %d, in0 %d, out %d, ws %zu)\n", n_in, n_in > 0 ? in_sizes[0] : -1, out_size, ws_size); grid = -1; return; }
        int dev = 0, cus = 0;
        if (hipGetDevice(&dev) != hipSuccess || hipDeviceGetAttribute(&cus, hipDeviceAttributeMultiprocessorCount, dev) != hipSuccess) { grid = -1; return; }
        bool ok = true;
#if MK_ONE_LAUNCH
        ok &= hipFuncSetAttribute((const void*)mk_fwd<SEL_ALL>, hipFuncAttributeMaxDynamicSharedMemorySize, LDS_BYTES) == hipSuccess;
#endif
#if !MK_ONE_LAUNCH
        ok &= hipFuncSetAttribute((const void*)mk_fwd<SEL_PRO>, hipFuncAttributeMaxDynamicSharedMemorySize, LDS_BYTES) == hipSuccess;
        ok &= hipFuncSetAttribute((const void*)mk_fwd<SEL_FIN>, hipFuncAttributeMaxDynamicSharedMemorySize, LDS_BYTES) == hipSuccess;
        ok &= hipFuncSetAttribute((const void*)mk_fwd<SEL_B>, hipFuncAttributeMaxDynamicSharedMemorySize, LDS_BYTES) == hipSuccess;
        ok &= hipFuncSetAttribute((const void*)mk_fwd<SEL_C>, hipFuncAttributeMaxDynamicSharedMemorySize, LDS_BYTES) == hipSuccess;
        ok &= hipFuncSetAttribute((const void*)mk_fwd<SEL_D>, hipFuncAttributeMaxDynamicSharedMemorySize, LDS_BYTES) == hipSuccess;
        ok &= hipFuncSetAttribute((const void*)mk_fwd<SEL_GATES>, hipFuncAttributeMaxDynamicSharedMemorySize, LDS_BYTES) == hipSuccess;
        ok &= hipFuncSetAttribute((const void*)mk_fwd<SEL_GEMM>, hipFuncAttributeMaxDynamicSharedMemorySize, LDS_BYTES) == hipSuccess;
#endif
        if (!ok) { fprintf(stderr, "kernel_launch: hipFuncSetAttribute failed\n"); grid = -1; return; }
        (void)hipGetLastError();
        if (cus < 256) { fprintf(stderr, "kernel_launch: needs 256 CUs, device has %d\n", cus); grid = -1; return; }
        grid = 256;
    }
    if (grid < 0) return;
    if (hipMemsetAsync((char*)d_ws + WS_CTL, 0, CTL_ZERO_BYTES, stream) != hipSuccess) return;
    Args a{};
    for (int i = 0; i < 16; ++i) a.in[i] = (const float*)d_in[i];
    a.out = (float*)d_out; a.ws = (unsigned char*)d_ws;
#if MK_ONE_LAUNCH
    {
        a.ph_lo = 0; a.ph_hi = N_STEPS;
        hipLaunchKernelGGL(mk_fwd<SEL_ALL>, dim3(grid), dim3(512), LDS_BYTES, stream, a);
    }
#else
    {
        int s = 0;
        while (s < N_STEPS) {
            int e = s + 1;
            const int k = (s == 0 || s == STEP_PRO1 || s == STEP_FIN) ? -1 : (s - 1) % KPL;
            if (k == K_E1) e = s + 4;
            a.ph_lo = s; a.ph_hi = e;
            if (k == -1 && s != STEP_FIN) hipLaunchKernelGGL(mk_fwd<SEL_PRO>, dim3(grid), dim3(512), LDS_BYTES, stream, a);
            else if (k == -1) hipLaunchKernelGGL(mk_fwd<SEL_FIN>, dim3(grid), dim3(512), LDS_BYTES, stream, a);
            else if (k == K_A2) hipLaunchKernelGGL(mk_fwd<SEL_GATES>, dim3(grid), dim3(512), LDS_BYTES, stream, a);
            else if (k == K_B) hipLaunchKernelGGL(mk_fwd<SEL_B>, dim3(grid), dim3(512), LDS_BYTES, stream, a);
            else if (k == K_C) hipLaunchKernelGGL(mk_fwd<SEL_C>, dim3(grid), dim3(512), LDS_BYTES, stream, a);
            else if (k == K_D) hipLaunchKernelGGL(mk_fwd<SEL_D>, dim3(grid), dim3(512), LDS_BYTES, stream, a);
            else hipLaunchKernelGGL(mk_fwd<SEL_GEMM>, dim3(grid), dim3(512), LDS_BYTES, stream, a);
            s = e;
        }
    }
#endif
}
```

```cpp
#include <hip/hip_runtime.h>
#include <cstdio>
#include <cstdint>

namespace pg8 {
#define PG8_LAS __attribute__((address_space(3)))
typedef unsigned short bf16_t;
typedef short bf16x8 __attribute__((ext_vector_type(8)));
typedef float f32x4 __attribute__((ext_vector_type(4)));
typedef unsigned u32x4 __attribute__((ext_vector_type(4)));
constexpr int BM = 256, BK = 64, HALF = 128, HTB = HALF * BK * 2  , STAGE_BYTES = 8 * HTB, NXCD = 8, WGM = 8;

__host__ __device__ __forceinline__ int lds_byte(int r, int c) { const int st = (r >> 4) * 2 + (c >> 5), rr = r & 15, cc = c & 31, ob = rr * 64 + cc * 2; return st * 1024 + (ob ^ (((ob >> 9) & 1) << 5)); }
__host__ __device__ __forceinline__ void stage_rc(int b, int& R, int& C) { const int st = b / 1024, sb = b % 1024, swz = sb ^ (((sb >> 9) & 1) << 5); R = (st >> 1) * 16 + swz / 64; C = (st & 1) * 32 + (swz % 64) / 2; }
__host__ __device__ __forceinline__ int perm32(int rho) { const int n = rho >> 4, i = rho & 15; return 8 * (i >> 2) + 4 * n + (i & 3); }

struct Unit { int pm, pn; };
struct Gemm { const bf16_t* A; const bf16_t* Bt; int M, N, K; };

struct StaticOrder {
    int nM, nN, nwg, G, c;
    __host__ __device__ void init(int M, int N, int G_, int c_) { nM = M / BM; nN = N / BM; nwg = nM * nN; G = G_; c = c_; }
    __host__ __device__ bool next(int i, Unit& u) const {
        const long L = (long)i * G + c; if (L >= nwg) return false;
        int wgid = (int)L; { const int q = nwg / NXCD, r = nwg % NXCD, xcd = wgid % NXCD, off = wgid / NXCD; wgid = (xcd < r ? xcd * (q + 1) : r * (q + 1) + (xcd - r) * q) + off; }
        const int nig = WGM * nN, gid = wgid / nig, fm = gid * WGM, gsz = (nM - fm) < WGM ? (nM - fm) : WGM;
        u.pm = fm + ((wgid % nig) % gsz); u.pn = (wgid % nig) / gsz; return true;
    }
    __device__ __forceinline__ void a_ready(const Unit&) const {}
    __device__ __forceinline__ void done(const Unit&) const {}
};

__device__ __forceinline__ unsigned cvt_pk_bf16(float lo, float hi) { unsigned r; asm volatile("v_cvt_pk_bf16_f32 %0, %1, %2" : "=v"(r) : "v"(lo), "v"(hi)); return r; }
__device__ __forceinline__ float bflo(unsigned w) { return __uint_as_float(w << 16); }
__device__ __forceinline__ float bfhi(unsigned w) { return __uint_as_float(w & 0xffff0000u); }
__device__ __forceinline__ float rstd_of(float ss) { return rsqrtf(ss * (1.0f / 1024.0f) + 1e-6f); }
__device__ __forceinline__ float sigm(float x) { return 1.0f / (1.0f + __expf(-x)); }
typedef unsigned u32x2 __attribute__((ext_vector_type(2)));

template <int mode> struct EpiAny {
    static constexpr bool PERM = true, AFTER_DRAIN = false;
    bf16_t* O; int ldc; const bf16_t* Z; const float* ssq_in; const float* base; float* outf; float* ssq_out; bf16_t* O2; int ldc2, split; int dry;
    __device__ __forceinline__ void operator()(const f32x4 (&acc)[2][2][4][2], const Unit& u, int wr, int wc, int fr, int fq) const {
        const int row0 = u.pm * BM + wr * 64 + fr, col0 = u.pn * BM + wc * 32 + 8 * fq;
#ifdef PROBE_REPEAT
        if (dry) { asm volatile("" :: "v"(acc[0][0][0][0][0]), "v"(acc[1][1][3][1][3])); return; }
#endif
        if (mode == 6) {
            float rs[2][8];
#pragma unroll
            for (int bj = 0; bj < 2; ++bj) { const f32x4 s0 = *(const f32x4*)(ssq_in + col0 + bj * HALF), s1 = *(const f32x4*)(ssq_in + col0 + bj * HALF + 4);
#pragma unroll
                for (int e = 0; e < 4; ++e) { rs[bj][e] = rstd_of(s0[e]); rs[bj][4 + e] = rstd_of(s1[e]); } }
#pragma unroll
            for (int ai = 0; ai < 2; ++ai)
#pragma unroll
                for (int m = 0; m < 4; ++m) {
                    const int row = row0 + ai * HALF + m * 16; bf16_t* rowp = O + (size_t)row * ldc + col0;
#pragma unroll
                    for (int bj = 0; bj < 2; ++bj) {
                        const f32x4 v0 = acc[ai][bj][m][0], v1 = acc[ai][bj][m][1];
                        u32x4 w; w.x = cvt_pk_bf16(v0[0] * rs[bj][0], v0[1] * rs[bj][1]); w.y = cvt_pk_bf16(v0[2] * rs[bj][2], v0[3] * rs[bj][3]);
                        w.z = cvt_pk_bf16(v1[0] * rs[bj][4], v1[1] * rs[bj][5]); w.w = cvt_pk_bf16(v1[2] * rs[bj][6], v1[3] * rs[bj][7]);
                        *(u32x4*)(rowp + bj * HALF) = w;
                    }
                }
        } else if (mode <= 1) {
            bf16_t* ob = O; int ld = ldc, cc = col0;
            if (mode == 0 && u.pn * BM >= split) { ob = O2; ld = ldc2; cc = col0 - split; }
#pragma unroll
            for (int ai = 0; ai < 2; ++ai)
#pragma unroll
                for (int m = 0; m < 4; ++m) {
                    const int row = row0 + ai * HALF + m * 16; const float rs = rstd_of(ssq_in[row]);
                    bf16_t* rowp = ob + (size_t)row * ld + cc;
#pragma unroll
                    for (int bj = 0; bj < 2; ++bj) {
                        f32x4 v0 = acc[ai][bj][m][0] * rs, v1 = acc[ai][bj][m][1] * rs;
                        if (mode == 1) {
#pragma unroll
                            for (int e = 0; e < 4; ++e) { const float a = fmaxf(v0[e], 0.f), b = fmaxf(v1[e], 0.f); v0[e] = a * a; v1[e] = b * b; }
                        }
                        u32x4 w; w.x = cvt_pk_bf16(v0[0], v0[1]); w.y = cvt_pk_bf16(v0[2], v0[3]); w.z = cvt_pk_bf16(v1[0], v1[1]); w.w = cvt_pk_bf16(v1[2], v1[3]);
                        *(u32x4*)(rowp + bj * HALF) = w;
                    }
                }
        } else if (mode == 2) {
#pragma unroll
            for (int ai = 0; ai < 2; ++ai)
#pragma unroll
                for (int m = 0; m < 4; ++m) {
                    const int row = row0 + ai * HALF + m * 16; bf16_t* rowp = O + (size_t)row * ldc + col0;
#pragma unroll
                    for (int bj = 0; bj < 2; ++bj) {
                        const f32x4 v0 = acc[ai][bj][m][0], v1 = acc[ai][bj][m][1];
                        u32x4 w; w.x = cvt_pk_bf16(v0[0], v0[1]); w.y = cvt_pk_bf16(v0[2], v0[3]); w.z = cvt_pk_bf16(v1[0], v1[1]); w.w = cvt_pk_bf16(v1[2], v1[3]);
                        *(u32x4*)(rowp + bj * HALF) = w;
                    }
                }
        } else if (mode <= 4) {
#pragma unroll
            for (int ai = 0; ai < 2; ++ai)
#pragma unroll
                for (int m = 0; m < 4; ++m) {
                    const int row = row0 + ai * HALF + m * 16; const float rs = rstd_of(ssq_in[row]);
                    bf16_t* rowp = O + (size_t)row * ldc + col0; const bf16_t* zp = Z + (size_t)row * ldc + col0;
#pragma unroll
                    for (int bj = 0; bj < 2; ++bj) {
                        const f32x4 a0 = acc[ai][bj][m][0] * rs, a1 = acc[ai][bj][m][1] * rs;
                        const u32x4 y = *(const u32x4*)(rowp + bj * HALF);
                        float yv[8] = {bflo(y.x), bfhi(y.x), bflo(y.y), bfhi(y.y), bflo(y.z), bfhi(y.z), bflo(y.w), bfhi(y.w)};
                        float gv[8] = {sigm(a0[0]), sigm(a0[1]), sigm(a0[2]), sigm(a0[3]), sigm(a1[0]), sigm(a1[1]), sigm(a1[2]), sigm(a1[3])};
                        float ov[8];
                        if (mode == 3) {
#pragma unroll
                            for (int e = 0; e < 8; ++e) ov[e] = gv[e] * yv[e];
                        } else {
                            const u32x4 z = *(const u32x4*)(zp + bj * HALF);
                            float zv[8] = {bflo(z.x), bfhi(z.x), bflo(z.y), bfhi(z.y), bflo(z.z), bfhi(z.z), bflo(z.w), bfhi(z.w)};
#pragma unroll
                            for (int e = 0; e < 8; ++e) ov[e] = yv[e] + gv[e] * zv[e];
                        }
                        u32x4 w; w.x = cvt_pk_bf16(ov[0], ov[1]); w.y = cvt_pk_bf16(ov[2], ov[3]); w.z = cvt_pk_bf16(ov[4], ov[5]); w.w = cvt_pk_bf16(ov[6], ov[7]);
                        *(u32x4*)(rowp + bj * HALF) = w;
                    }
                }
        } else {
#pragma unroll
            for (int ai = 0; ai < 2; ++ai)
#pragma unroll
                for (int m = 0; m < 4; ++m) {
                    const int row = row0 + ai * HALF + m * 16; const size_t off = (size_t)row * ldc + col0; float s = 0.f;
#pragma unroll
                    for (int bj = 0; bj < 2; ++bj) {
                        const f32x4 b0 = *(const f32x4*)(base + off + bj * HALF), b1 = *(const f32x4*)(base + off + bj * HALF + 4);
                        const f32x4 o0 = b0 + acc[ai][bj][m][0], o1 = b1 + acc[ai][bj][m][1];
                        *(f32x4*)(outf + off + bj * HALF) = o0; *(f32x4*)(outf + off + bj * HALF + 4) = o1;
                        u32x4 w; w.x = cvt_pk_bf16(o0[0], o0[1]); w.y = cvt_pk_bf16(o0[2], o0[3]); w.z = cvt_pk_bf16(o1[0], o1[1]); w.w = cvt_pk_bf16(o1[2], o1[3]);
                        *(u32x4*)(O + off + bj * HALF) = w;
                        s += (o0[0] * o0[0] + o0[1] * o0[1]) + (o0[2] * o0[2] + o0[3] * o0[3]) + (o1[0] * o1[0] + o1[1] * o1[1]) + (o1[2] * o1[2] + o1[3] * o1[3]);
                    }
                    s += __shfl_xor(s, 16); s += __shfl_xor(s, 32);
                    if (fq == 0) atomicAdd(ssq_out + row, s);
                }
        }
    }
};

template <class Epi, class Sched, bool ALIGN_EPI = false, bool SP2 = false>
__device__ __forceinline__ void gemm_phase(PG8_LAS unsigned char* lds, const Gemm g, const Sched& S, const Epi& E) {
    int tid_ = threadIdx.x; asm volatile("" : "+v"(tid_));
    const int tid = tid_, wid = __builtin_amdgcn_readfirstlane(tid >> 6), lane = tid & 63, wr = wid >> 2, wc = wid & 3, fr = lane & 15, fq = lane >> 4;
    const int K = g.K, nt = K / BK;
    unsigned voffA[2], voffB[2];
#pragma unroll
    for (int i = 0; i < 2; ++i) { int R, C; stage_rc(tid * 16 + i * 8192, R, C); const int Rb = Epi::PERM ? ((R & ~31) + perm32(R & 31)) : R;
        voffA[i] = (unsigned)(R * K + C) * 2u; voffB[i] = (unsigned)(Rb * K + C) * 2u; }
    const size_t kstep = (size_t)(BK * 2);
    const size_t hstep = (size_t)HALF * K * 2;
    const size_t tstep = 2 * hstep;
    const unsigned ldsw = (unsigned)wid * 1024u;
    const int aoff = lds_byte(wr * 64 + fr, fq * 8), boff = lds_byte(wc * 32 + fr, fq * 8);
#define PG8_SA(b, h) (((b) * 2 + (h)) * HTB)
#define PG8_SB(b, h) ((4 + (b) * 2 + (h)) * HTB)
#define PG8_STAGE(bufoff, gbase, voff) do { _Pragma("unroll") for (int _i = 0; _i < 2; ++_i) \
        __builtin_amdgcn_global_load_lds((const unsigned*)((const char*)(gbase) + (voff)[_i]), (PG8_LAS unsigned*)(lds + (bufoff) + ldsw + _i * 8192), 16, 0, 0); } while (0)
#define PG8_LDA(dst, b, h) do { _Pragma("unroll") for (int m = 0; m < 4; ++m) _Pragma("unroll") for (int k = 0; k < 2; ++k) dst[m][k] = *(const PG8_LAS bf16x8*)(lds + PG8_SA(b, h) + aoff + m * 2048 + k * 1024); } while (0)
#define PG8_LDB(dst, b, h) do { _Pragma("unroll") for (int n = 0; n < 2; ++n) _Pragma("unroll") for (int k = 0; k < 2; ++k) dst[n][k] = *(const PG8_LAS bf16x8*)(lds + PG8_SB(b, h) + boff + n * 2048 + k * 1024); } while (0)
#define PG8_MMA(ai, bj, At, Bt) do { __builtin_amdgcn_s_setprio(1); _Pragma("unroll") for (int m = 0; m < 4; ++m) _Pragma("unroll") for (int n = 0; n < 2; ++n) _Pragma("unroll") for (int k = 0; k < 2; ++k) \
        acc[ai][bj][m][n] = __builtin_amdgcn_mfma_f32_16x16x32_bf16(Bt[n][k], At[m][k], acc[ai][bj][m][n], 0, 0, 0); __builtin_amdgcn_s_setprio(0); } while (0)
#define PG8_WAIT_V(n) asm volatile("s_waitcnt vmcnt(" #n ")" ::: "memory")
#define PG8_WAIT_L(n) asm volatile("s_waitcnt lgkmcnt(" #n ")" ::: "memory")
#define PG8_BAR __builtin_amdgcn_s_barrier()
#define PG8_SCHED __builtin_amdgcn_sched_barrier(0)
    Unit cur, nxt; int ui = 0;
    if (!S.next(0, cur)) return;
    f32x4 acc[2][2][4][2];
#pragma unroll
    for (int a = 0; a < 2; ++a)
#pragma unroll
        for (int b = 0; b < 2; ++b)
#pragma unroll
            for (int m = 0; m < 4; ++m)
#pragma unroll
                for (int n = 0; n < 2; ++n) acc[a][b][m][n] = (f32x4){0.f, 0.f, 0.f, 0.f};
    bf16x8 At[4][2], B0[2][2], B1[2][2];
    const char* cA = (const char*)g.A + (size_t)cur.pm * tstep; const char* cB = (const char*)g.Bt + (size_t)cur.pn * tstep;
    S.a_ready(cur);
    if constexpr (SP2) {
        PG8_STAGE(PG8_SB(0, 0), cB, voffB); PG8_STAGE(PG8_SB(0, 1), cB + hstep, voffB); PG8_STAGE(PG8_SA(0, 0), cA, voffA); PG8_STAGE(PG8_SA(0, 1), cA + hstep, voffA);
        if (wr == 1) PG8_BAR;
        PG8_WAIT_V(2); PG8_BAR;
        PG8_STAGE(PG8_SB(1, 0), cB + kstep, voffB); PG8_STAGE(PG8_SA(1, 0), cA + kstep, voffA); PG8_STAGE(PG8_SB(1, 1), cB + hstep + kstep, voffB);
        PG8_WAIT_V(6); PG8_BAR;
    } else {
        PG8_STAGE(PG8_SB(0, 0), cB, voffB); PG8_STAGE(PG8_SA(0, 0), cA, voffA); PG8_STAGE(PG8_SB(0, 1), cB + hstep, voffB); PG8_STAGE(PG8_SA(0, 1), cA + hstep, voffA);
        if (wr == 1) PG8_BAR;
        PG8_WAIT_V(4); PG8_BAR;
        PG8_STAGE(PG8_SB(1, 0), cB + kstep, voffB); PG8_STAGE(PG8_SA(1, 0), cA + kstep, voffA); PG8_STAGE(PG8_SB(1, 1), cB + hstep + kstep, voffB);
        PG8_WAIT_V(6); PG8_BAR;
    }
    for (;;) {
        const bool has_next = S.next(ui + 1, nxt);
        const char* nA = has_next ? (const char*)g.A + (size_t)nxt.pm * tstep : cA; const char* nB = has_next ? (const char*)g.Bt + (size_t)nxt.pn * tstep : cB;
        for (int t = 0; t < nt; t += 2) {
            const bool last = (t == nt - 2);
            const char* a1 = cA + (size_t)(t + 1) * kstep;
            const char* a2 = last ? nA : cA + (size_t)(t + 2) * kstep; const char* b2 = last ? nB : cB + (size_t)(t + 2) * kstep;
            const char* a3 = a2 + kstep; const char* b3 = b2 + kstep;
            if (last && has_next) S.a_ready(nxt);
            if constexpr (SP2) {
            PG8_LDB(B0, 0, 0); PG8_LDB(B1, 0, 1); PG8_SCHED; PG8_LDA(At, 0, 0); PG8_STAGE(PG8_SA(1, 1), a1 + hstep, voffA);
            PG8_WAIT_V(8); PG8_WAIT_L(0); PG8_BAR; PG8_MMA(0, 0, At, B0); PG8_MMA(0, 1, At, B1); PG8_BAR; PG8_SCHED;
            PG8_LDA(At, 0, 1); PG8_STAGE(PG8_SB(0, 0), b2, voffB); PG8_STAGE(PG8_SB(0, 1), b2 + hstep, voffB); PG8_STAGE(PG8_SA(0, 0), a2, voffA);
            PG8_WAIT_V(8); PG8_WAIT_L(0); PG8_BAR; PG8_MMA(1, 0, At, B0); PG8_MMA(1, 1, At, B1); PG8_BAR; PG8_SCHED;
            PG8_LDB(B0, 1, 0); PG8_LDB(B1, 1, 1); PG8_SCHED; PG8_LDA(At, 1, 0); PG8_STAGE(PG8_SA(0, 1), a2 + hstep, voffA);
            PG8_WAIT_V(8); PG8_WAIT_L(0); PG8_BAR; PG8_MMA(0, 0, At, B0); PG8_MMA(0, 1, At, B1); PG8_BAR; PG8_SCHED;
            PG8_LDA(At, 1, 1); PG8_STAGE(PG8_SB(1, 0), b3, voffB); PG8_STAGE(PG8_SB(1, 1), b3 + hstep, voffB); PG8_STAGE(PG8_SA(1, 0), a3, voffA);
            PG8_WAIT_V(8); PG8_WAIT_L(0); PG8_BAR; PG8_MMA(1, 0, At, B0); PG8_MMA(1, 1, At, B1); PG8_BAR; PG8_SCHED;
            } else {
            PG8_LDB(B0, 0, 0); PG8_SCHED; PG8_LDA(At, 0, 0); PG8_STAGE(PG8_SA(1, 1), a1 + hstep, voffA);
            PG8_WAIT_L(8); PG8_BAR; PG8_WAIT_L(0); PG8_MMA(0, 0, At, B0); PG8_BAR; PG8_SCHED;
            PG8_LDB(B1, 0, 1); PG8_STAGE(PG8_SB(0, 0), b2, voffB);
            PG8_BAR; PG8_WAIT_L(0); PG8_MMA(0, 1, At, B1); PG8_BAR;
            PG8_LDA(At, 0, 1); PG8_STAGE(PG8_SA(0, 0), a2, voffA);
            PG8_BAR; PG8_WAIT_L(0); PG8_MMA(1, 0, At, B0); PG8_BAR; PG8_SCHED;
            PG8_STAGE(PG8_SB(0, 1), b2 + hstep, voffB);
            PG8_WAIT_V(6); PG8_BAR; PG8_MMA(1, 1, At, B1); PG8_BAR;
            PG8_LDB(B0, 1, 0); PG8_SCHED; PG8_LDA(At, 1, 0); PG8_STAGE(PG8_SA(0, 1), a2 + hstep, voffA);
            PG8_WAIT_L(8); PG8_BAR; PG8_WAIT_L(0); PG8_MMA(0, 0, At, B0); PG8_BAR; PG8_SCHED;
            PG8_LDB(B1, 1, 1); PG8_STAGE(PG8_SB(1, 0), b3, voffB);
            PG8_BAR; PG8_WAIT_L(0); PG8_MMA(0, 1, At, B1); PG8_BAR;
            PG8_LDA(At, 1, 1); PG8_STAGE(PG8_SA(1, 0), a3, voffA);
            PG8_BAR; PG8_WAIT_L(0); PG8_MMA(1, 0, At, B0); PG8_BAR; PG8_SCHED;
            PG8_STAGE(PG8_SB(1, 1), b3 + hstep, voffB);
            PG8_WAIT_V(6); PG8_BAR; PG8_MMA(1, 1, At, B1); PG8_BAR;
            }
        }
        if constexpr (ALIGN_EPI) { if (wr == 0) PG8_BAR; }
        if constexpr (!Epi::AFTER_DRAIN) { E(acc, cur, wr, wc, fr, fq); S.done(cur); }
        if (!has_next) break;
#pragma unroll
        for (int a = 0; a < 2; ++a)
#pragma unroll
            for (int b = 0; b < 2; ++b)
#pragma unroll
                for (int m = 0; m < 4; ++m)
#pragma unroll
                    for (int n = 0; n < 2; ++n) acc[a][b][m][n] = (f32x4){0.f, 0.f, 0.f, 0.f};
        cur = nxt; cA = nA; cB = nB; ++ui;
        if constexpr (ALIGN_EPI) { if (wr == 1) PG8_BAR; }
    }
    PG8_WAIT_V(0);
    if constexpr (!ALIGN_EPI) { if (wr == 0) PG8_BAR; }
    PG8_BAR;
    if constexpr (Epi::AFTER_DRAIN) { E.fused(acc, cur, wr, wc, fr, fq, lds, wid, lane); S.done(cur); }
#undef PG8_SA
#undef PG8_SB
#undef PG8_STAGE
#undef PG8_LDA
#undef PG8_LDB
#undef PG8_MMA
#undef PG8_WAIT_V
#undef PG8_WAIT_L
#undef PG8_BAR
#undef PG8_SCHED
}
}
#define GAS __attribute__((address_space(1)))
#define LAS __attribute__((address_space(3)))
typedef unsigned short bf16;
typedef unsigned v4u __attribute__((ext_vector_type(4)));
typedef float f32x4 __attribute__((ext_vector_type(4)));
#define LDS_WAIT() asm volatile("s_waitcnt lgkmcnt(0)" ::: "memory")

#ifndef FAST_ATTN
#define FAST_ATTN 1
#endif
#ifndef FAST_LOCAL
#define FAST_LOCAL 1
#endif
#ifndef FAST_OUT
#define FAST_OUT 1
#endif
#ifndef MK_ONE_LAUNCH
#define MK_ONE_LAUNCH 1
#endif

constexpr int M = 16384, DM = 1024, SEQ = 4096, NCHK = 64, CHK = 64, DFF = 4096, DIN_SRC = 5640;
constexpr int LD1 = 1024, LD2 = 1536, N2_MQ = 0, N2_MO = 512, N2_MK = 1024, T_MK = 0, T_AV = 512, T_MV = 1024;
constexpr int NUNIT = 1024;
constexpr float EPS = 1e-6f;

constexpr size_t MiB = 1u << 20;
constexpr size_t WS_CTL = 0, CTL_ZERO_BYTES = 1 * MiB;
constexpr size_t WS_SSQ = 1 * MiB;
constexpr size_t WS_WG = 1 * MiB + 320 * 1024;
constexpr size_t WS_GATES = 1 * MiB + 512 * 1024;
constexpr size_t WS_NLOC = 2 * MiB;
constexpr size_t WS_MLOC = 2 * MiB + 512 * 1024;
constexpr size_t WS_BLAST = WS_MLOC + 4096, WS_MST = WS_BLAST + 4096;
constexpr size_t WS_W = 3 * MiB;
constexpr size_t W_IN = 0, W_A = (size_t)5632 * 1024, W_M = W_A + 512 * 1024, W_O = W_M + 512 * 1024, W_UP = W_O + 1024 * 1024, W_DN = W_UP + (size_t)4096 * 1024, W_END = W_DN + (size_t)4096 * 1024;
static_assert(WS_W + W_END * 2 <= 34 * MiB, "weights");
constexpr size_t WS_XB = 34 * MiB;
constexpr size_t WS_N1 = 66 * MiB;
constexpr size_t WS_N2 = 98 * MiB;
constexpr size_t WS_T = 146 * MiB;
constexpr size_t WS_MOUT = 146 * MiB;
constexpr size_t WS_Y = 162 * MiB;
constexpr size_t WS_Z = 66 * MiB;
constexpr size_t WS_ATT = 194 * MiB;
constexpr size_t WS_CLOC = 210 * MiB;
constexpr size_t WS_H = 66 * MiB;
constexpr size_t WS_END = 242 * MiB;

constexpr int RING_BYTES = 131072, LDSCTL_OFF = RING_BYTES, MISC_OFF = LDSCTL_OFF + 320, LDS_BYTES = 147456;
constexpr int CW_BAR = 4096;

__device__ __forceinline__ unsigned f2bf(float f) { unsigned u = __builtin_bit_cast(unsigned, f); return (u + 0x7fffu + ((u >> 16) & 1u)) >> 16; }
__device__ __forceinline__ unsigned pk2(float lo, float hi) { return f2bf(lo) | (f2bf(hi) << 16); }
__device__ __forceinline__ float bf2f(bf16 v) { return __uint_as_float(((unsigned)v) << 16); }
__device__ __forceinline__ float blo(unsigned w) { return __uint_as_float(w << 16); }
__device__ __forceinline__ float bhi(unsigned w) { return __uint_as_float(w & 0xffff0000u); }
__device__ __forceinline__ float sigmf(float x) { return 1.0f / (1.0f + __expf(-x)); }
__device__ __forceinline__ float wave_sum(float v) {
#pragma unroll
    for (int o = 1; o < 64; o <<= 1) v += __shfl_xor(v, o);
    return v;
}

__device__ __forceinline__ int win_src_col(int n0) {
    if (n0 >= 3584) return n0 + 8;
    const int blk = n0 >> 9; const int st = blk == 0 ? 0 : blk == 1 ? 512 : blk == 2 ? 1536 : blk == 3 ? 3072 : blk == 4 ? 2048 : blk == 5 ? 1024 : 2560;
    return st + (n0 & 511);
}
__device__ __forceinline__ void transpose_item(const float* W, int ldw, int is_win, const float* g, bf16* WT, int K, int nblk, LAS float* scr, int item, int lane) {
    const int kb = item / nblk, nb = item % nblk, k0 = 64 * kb, n0 = 32 * nb, sc0 = is_win ? win_src_col(n0) : n0;
    float tv[32];
#pragma unroll
    for (int i = 0; i < 32; ++i) { const int kk = 2 * i + (lane >> 5); tv[i] = W[(size_t)(k0 + kk) * ldw + sc0 + (lane & 31)]; }
#pragma unroll
    for (int i = 0; i < 32; ++i) { const int kk = 2 * i + (lane >> 5); const float gv = g ? g[k0 + kk] : 1.0f; scr[kk * 33 + (lane & 31)] = tv[i] * gv; }
    LDS_WAIT(); asm volatile("" ::: "memory");
    const int c = lane & 7;
#pragma unroll
    for (int j = 0; j < 4; ++j) { const int n = (lane >> 3) + 8 * j; const LAS float* s = scr + (8 * c) * 33 + n;
        v4u o; o.x = pk2(s[0 * 33], s[1 * 33]); o.y = pk2(s[2 * 33], s[3 * 33]); o.z = pk2(s[4 * 33], s[5 * 33]); o.w = pk2(s[6 * 33], s[7 * 33]);
        *(v4u*)(WT + (size_t)(n0 + n) * K + k0 + 8 * c) = o; }
    LDS_WAIT(); asm volatile("" ::: "memory");
}

__device__ __forceinline__ void gates_phase(const float* x, const float* wg, const float* bi, const float* bf_, float* gates, LAS float* ldsf, int bid, int tid) {
    constexpr int XP = 132, WP = 1028;
    LAS float* WS = ldsf; LAS float* XS = ldsf + 8 * WP;
    for (int i = tid; i < 8 * 256; i += 512) { const int g = i >> 8, k4 = i & 255; *(LAS f32x4*)(WS + g * WP + 4 * k4) = *(const f32x4*)(wg + g * 1024 + 4 * k4); }
    const int lr = tid >> 5, lc = tid & 31, row = tid >> 3, gate = tid & 7, lane = tid & 63;
    for (int rb = bid; rb < M / 64; rb += 256) {
        const float* xb0 = x + (size_t)rb * 64 * DM;
        f32x4 pre[4];
#pragma unroll
        for (int i = 0; i < 4; ++i) pre[i] = *(const f32x4*)(xb0 + (size_t)(lr + 16 * i) * DM + 4 * lc);
        float acc = 0.f, ss = 0.f;
        for (int kc = 0; kc < 8; ++kc) {
            __syncthreads();
#pragma unroll
            for (int i = 0; i < 4; ++i) *(LAS f32x4*)(XS + (lr + 16 * i) * XP + 4 * lc) = pre[i];
            if (kc + 1 < 8) {
#pragma unroll
                for (int i = 0; i < 4; ++i) pre[i] = *(const f32x4*)(xb0 + (size_t)(lr + 16 * i) * DM + (kc + 1) * 128 + 4 * lc);
            }
            __syncthreads();
            const LAS float* xr = XS + row * XP; const LAS float* wr = WS + gate * WP + kc * 128;
#pragma unroll 8
            for (int k4 = 0; k4 < 32; ++k4) { const f32x4 xv = *(const LAS f32x4*)(xr + 4 * k4), wv = *(const LAS f32x4*)(wr + 4 * k4);
                acc += (xv.x * wv.x + xv.y * wv.y) + (xv.z * wv.z + xv.w * wv.w); ss += (xv.x * xv.x + xv.y * xv.y) + (xv.z * xv.z + xv.w * xv.w); }
        }
        const float rs = rsqrtf(ss * (1.0f / 1024.0f) + EPS);
        float val = acc * rs + (gate < 4 ? bi[gate] : bf_[gate - 4]);
        if (gate >= 4) val = fminf(val, 0.f) - log1pf(__expf(-fabsf(val)));
        gates[((size_t)rb * 64 + row) * 8 + gate] = val;
    }
    __syncthreads();
}

__device__ __forceinline__ void attn_naive(const bf16* n1, const bf16* tT, const float* relb, bf16* att, int bid, int G, int wave, int lane) {
    for (int unit = bid; unit < 256; unit += G) {
        const int b = unit >> 6, c = unit & 63, h = wave, t = lane;
        const size_t tok = (size_t)b * SEQ + c * CHK + t;
        float q[64], acc[64];
        { const v4u* qp = (const v4u*)(n1 + tok * LD1 + h * 64);
#pragma unroll
          for (int i = 0; i < 8; ++i) { const v4u w = qp[i]; q[8 * i + 0] = blo(w.x) * 0.125f; q[8 * i + 1] = bhi(w.x) * 0.125f; q[8 * i + 2] = blo(w.y) * 0.125f; q[8 * i + 3] = bhi(w.y) * 0.125f;
              q[8 * i + 4] = blo(w.z) * 0.125f; q[8 * i + 5] = bhi(w.z) * 0.125f; q[8 * i + 6] = blo(w.w) * 0.125f; q[8 * i + 7] = bhi(w.w) * 0.125f; } }
#pragma unroll
        for (int d = 0; d < 64; ++d) acc[d] = 0.f;
        float mx = -1e30f, l = 0.f;
        const float* bh = relb + h * 513;
        for (int j = (c >= 8 ? 0 : 8 - c); j <= 8; ++j) {
            const size_t ktok0 = (size_t)b * SEQ + (size_t)(c - 8 + j) * CHK;
            for (int u = 0; u < 64; ++u) {
                int uo = u; asm volatile("" : "+v"(uo));
                const bf16* rowp = n1 + (ktok0 + uo) * LD1 + h * 64;
                const v4u* kp = (const v4u*)(rowp + 512); float s = 0.f;
#pragma unroll
                for (int i = 0; i < 8; ++i) { const v4u w = kp[i];
                    s += q[8 * i + 0] * blo(w.x) + q[8 * i + 1] * bhi(w.x) + q[8 * i + 2] * blo(w.y) + q[8 * i + 3] * bhi(w.y) + q[8 * i + 4] * blo(w.z) + q[8 * i + 5] * bhi(w.z) + q[8 * i + 6] * blo(w.w) + q[8 * i + 7] * bhi(w.w); }
                int rel = t - u + 64 * (8 - j); rel = rel < -256 ? -256 : (rel > 256 ? 256 : rel);
                s += bh[rel + 256];
                if (s > mx) { const float corr = __expf(mx - s); l *= corr;
#pragma unroll
                    for (int d = 0; d < 64; ++d) acc[d] *= corr;
                    mx = s; }
                const float p = __expf(s - mx); l += p;
                const bf16* vp = tT + (size_t)(T_AV + h * 64) * M + (ktok0 + uo);
#pragma unroll
                for (int d = 0; d < 64; ++d) acc[d] += p * bf2f(vp[(size_t)d * M]);
            }
        }
        const float inv = 1.0f / l;
        v4u* op = (v4u*)(att + tok * 512 + h * 64);
#pragma unroll
        for (int i = 0; i < 8; ++i) { v4u o; o.x = pk2(acc[8 * i + 0] * inv, acc[8 * i + 1] * inv); o.y = pk2(acc[8 * i + 2] * inv, acc[8 * i + 3] * inv); o.z = pk2(acc[8 * i + 4] * inv, acc[8 * i + 5] * inv); o.w = pk2(acc[8 * i + 6] * inv, acc[8 * i + 7] * inv); op[i] = o; }
    }
}

typedef short bf16x8_t __attribute__((ext_vector_type(8)));
typedef float f32x16_t __attribute__((ext_vector_type(16)));
typedef float f32x2_t __attribute__((ext_vector_type(2))); typedef __bf16 bf16x2_t __attribute__((ext_vector_type(2)));
__device__ __forceinline__ unsigned cvtpk(float lo, float hi) { f32x2_t v = {lo, hi}; bf16x2_t b = __builtin_convertvector(v, bf16x2_t); return __builtin_bit_cast(unsigned, b); }
__device__ __forceinline__ void attn_mfma(const bf16* n1, const bf16* tT, const float* relb, bf16* att, LAS float* ldsf, int bid, int G, int wave, int lane) {
    constexpr float LOG2E = 1.4426950408889634f, SC = 0.125f * LOG2E;
    const int h = wave, r32 = lane & 31, hi = lane >> 5;
    LAS float* ext = ldsf + wave * 384;
    for (int r = lane; r < 384; r += 64) { const int rel = r - 63; const int idx = (rel > 256 ? 256 : rel) + 256; ext[r] = relb[h * 513 + idx] * LOG2E; }
    const float bconst = relb[h * 513 + 512] * LOG2E;
    LDS_WAIT();
    const int pir = (r32 & ~12) | ((r32 & 4) << 1) | ((r32 & 8) >> 1);
    for (int unit = bid; unit < 256; unit += G) {
        const int b = unit >> 6, c = unit & 63; const size_t tq0 = (size_t)b * SEQ + c * CHK;
        bf16x8_t qf[2][4];
#pragma unroll
        for (int qb = 0; qb < 2; ++qb)
#pragma unroll
            for (int s = 0; s < 4; ++s) qf[qb][s] = *(const bf16x8_t*)(n1 + (tq0 + qb * 32 + r32) * LD1 + h * 64 + 32 * hi + 8 * s);
        f32x16_t o[2][2];
#pragma unroll
        for (int qb = 0; qb < 2; ++qb)
#pragma unroll
            for (int db = 0; db < 2; ++db)
#pragma unroll
                for (int i = 0; i < 16; ++i) o[qb][db][i] = 0.f;
        float mrun[2] = {-1e30f, -1e30f}, lrun[2] = {0.f, 0.f};
        const int kb0 = (c >= 8 ? 0 : 8 - c) * 2;
        bf16x8_t kf[4], vf[2][2];
        { const size_t ktok = (size_t)b * SEQ + (size_t)(c - 8) * CHK + (size_t)kb0 * 32;
#pragma unroll
          for (int s = 0; s < 4; ++s) kf[s] = *(const bf16x8_t*)(n1 + (ktok + pir) * LD1 + 512 + h * 64 + 32 * hi + 8 * s);
#pragma unroll
          for (int db = 0; db < 2; ++db)
#pragma unroll
              for (int s2 = 0; s2 < 2; ++s2) vf[db][s2] = *(const bf16x8_t*)(tT + (size_t)(T_AV + h * 64 + db * 32 + r32) * M + ktok + 16 * s2 + 8 * hi); }
        for (int kbI = kb0; kbI < 18; ++kbI) {
            const int j = kbI >> 1, kb = kbI & 1;
            bf16x8_t kn[4], vn[2][2];
            { const int nx = kbI + 1 < 18 ? kbI + 1 : 17; const size_t ktok = (size_t)b * SEQ + (size_t)(c - 8) * CHK + (size_t)nx * 32;
#pragma unroll
              for (int s = 0; s < 4; ++s) kn[s] = *(const bf16x8_t*)(n1 + (ktok + pir) * LD1 + 512 + h * 64 + 32 * hi + 8 * s);
#pragma unroll
              for (int db = 0; db < 2; ++db)
#pragma unroll
                  for (int s2 = 0; s2 < 2; ++s2) vn[db][s2] = *(const bf16x8_t*)(tT + (size_t)(T_AV + h * 64 + db * 32 + r32) * M + ktok + 16 * s2 + 8 * hi); }
#pragma unroll
            for (int qb = 0; qb < 2; ++qb) {
                f32x16_t sa;
#pragma unroll
                for (int i = 0; i < 16; ++i) sa[i] = 0.f;
#pragma unroll
                for (int s = 0; s < 4; ++s) sa = __builtin_amdgcn_mfma_f32_32x32x16_bf16(kf[s], qf[qb][s], sa, 0, 0, 0);
                float sv[16];
                if (j >= 4) {
                    const int rbase = (qb * 32 + r32) - (kb * 32 + 8 * hi) + 64 * (8 - j) + 63;
#pragma unroll
                    for (int i = 0; i < 16; ++i) sv[i] = sa[i] * SC + ext[rbase - (i & 7) - 16 * (i >> 3)];
                } else {
#pragma unroll
                    for (int i = 0; i < 16; ++i) sv[i] = sa[i] * SC + bconst;
                }
                float mx = sv[0];
#pragma unroll
                for (int i = 1; i < 16; ++i) mx = fmaxf(mx, sv[i]);
                mx = fmaxf(mx, __shfl_xor(mx, 32));
                const float mnew = fmaxf(mrun[qb], mx), alpha = __builtin_amdgcn_exp2f(mrun[qb] - mnew); mrun[qb] = mnew;
                float ps = 0.f;
#pragma unroll
                for (int i = 0; i < 16; ++i) { sv[i] = __builtin_amdgcn_exp2f(sv[i] - mnew); ps += sv[i]; }
                lrun[qb] = lrun[qb] * alpha + ps;
#pragma unroll
                for (int db = 0; db < 2; ++db)
#pragma unroll
                    for (int i = 0; i < 16; ++i) o[qb][db][i] *= alpha;
                bf16x8_t pf[2];
#pragma unroll
                for (int s2 = 0; s2 < 2; ++s2) { v4u w; w.x = cvtpk(sv[8 * s2 + 0], sv[8 * s2 + 1]); w.y = cvtpk(sv[8 * s2 + 2], sv[8 * s2 + 3]); w.z = cvtpk(sv[8 * s2 + 4], sv[8 * s2 + 5]); w.w = cvtpk(sv[8 * s2 + 6], sv[8 * s2 + 7]);
                    pf[s2] = __builtin_bit_cast(bf16x8_t, w); }
#pragma unroll
                for (int db = 0; db < 2; ++db)
#pragma unroll
                    for (int s2 = 0; s2 < 2; ++s2) o[qb][db] = __builtin_amdgcn_mfma_f32_32x32x16_bf16(vf[db][s2], pf[s2], o[qb][db], 0, 0, 0);
            }
#pragma unroll
            for (int s = 0; s < 4; ++s) kf[s] = kn[s];
#pragma unroll
            for (int db = 0; db < 2; ++db)
#pragma unroll
                for (int s2 = 0; s2 < 2; ++s2) vf[db][s2] = vn[db][s2];
        }
#pragma unroll
        for (int qb = 0; qb < 2; ++qb) {
            const float lt = lrun[qb] + __shfl_xor(lrun[qb], 32), inv = 1.0f / lt;
            bf16* op = att + (tq0 + qb * 32 + r32) * 512 + h * 64 + 4 * hi;
#pragma unroll
            for (int db = 0; db < 2; ++db)
#pragma unroll
                for (int g4 = 0; g4 < 4; ++g4) { unsigned long long w = (unsigned long long)cvtpk(o[qb][db][4 * g4 + 0] * inv, o[qb][db][4 * g4 + 1] * inv) | ((unsigned long long)cvtpk(o[qb][db][4 * g4 + 2] * inv, o[qb][db][4 * g4 + 3] * inv) << 32);
                    *(unsigned long long*)(op + db * 32 + 8 * g4) = w; }
        }
    }
}

__device__ __forceinline__ float wave_max(float v) {
#pragma unroll
    for (int o = 1; o < 64; o <<= 1) v = fmaxf(v, __shfl_xor(v, o));
    return v;
}
__device__ __forceinline__ float scan_add(float v, int lane) {
#pragma unroll
    for (int o = 1; o < 64; o <<= 1) { const float t = __shfl_up(v, o); if (lane >= o) v += t; }
    return v;
}
__device__ __forceinline__ float scan_max(float v, int lane) {
#pragma unroll
    for (int o = 1; o < 64; o <<= 1) { const float t = __shfl_up(v, o); if (lane >= o) v = fmaxf(v, t); }
    return v;
}
__device__ __forceinline__ bf16x8_t pack8(const float* v) { v4u w; w.x = cvtpk(v[0], v[1]); w.y = cvtpk(v[2], v[3]); w.z = cvtpk(v[4], v[5]); w.w = cvtpk(v[6], v[7]); return __builtin_bit_cast(bf16x8_t, w); }

__device__ __forceinline__ void mlstm_local_mfma(const bf16* tT, const float* gates, const float* cw, const float* cb, bf16* cloc, float* nloc, float* mloc, float* blast, LAS float* ldsf, int bid, int G, int wave, int lane) {
    LAS float* wsm = ldsf + wave * 64;
    const int r32 = lane & 31, hi = lane >> 5;
    for (int task = bid * 8 + wave; task < 2 * NUNIT; task += G * 8) {
        const int unit = task >> 1, kh = task & 1, b = unit >> 8, c = (unit >> 2) & 63, h = unit & 3; const size_t tok0 = (size_t)b * SEQ + c * CHK;
        const float lf = gates[(tok0 + lane) * 8 + 4 + h], ig = gates[(tok0 + lane) * 8 + h];
        const float cum = scan_add(lf, lane), bl = __shfl(cum, 63), a = bl - cum + ig, mxa = wave_max(a);
        wsm[lane] = __expf(a - mxa);
        LDS_WAIT();
        if (kh == 0 && lane == 0) { mloc[unit] = mxa; blast[unit] = bl; }
        f32x16_t acc[2][4];
#pragma unroll
        for (int kb2 = 0; kb2 < 2; ++kb2)
#pragma unroll
            for (int vb = 0; vb < 4; ++vb)
#pragma unroll
                for (int i = 0; i < 16; ++i) acc[kb2][vb][i] = 0.f;
        float nsum[2] = {0.f, 0.f};
        float cwr[2][4], cbr[2];
#pragma unroll
        for (int kb2 = 0; kb2 < 2; ++kb2) { const int ch = 512 + h * 128 + kh * 64 + kb2 * 32 + r32; cbr[kb2] = cb[ch];
#pragma unroll
            for (int j = 0; j < 4; ++j) cwr[kb2][j] = cw[j * 1024 + ch]; }
#pragma unroll
        for (int s = 0; s < 4; ++s) {
            const int l0 = 16 * s + 8 * hi;
            float wv[8];
            { const f32x4 w0 = *(const LAS f32x4*)(wsm + l0), w1 = *(const LAS f32x4*)(wsm + l0 + 4); wv[0] = w0.x; wv[1] = w0.y; wv[2] = w0.z; wv[3] = w0.w; wv[4] = w1.x; wv[5] = w1.y; wv[6] = w1.z; wv[7] = w1.w; }
            bf16x8_t af[2];
#pragma unroll
            for (int kb2 = 0; kb2 < 2; ++kb2) {
                const bf16* rp = tT + (size_t)(T_MK + h * 128 + kh * 64 + kb2 * 32 + r32) * M + tok0 + l0;
                const v4u cur = *(const v4u*)rp; unsigned long long prev = *(const unsigned long long*)(rp - 4);
                if (c == 0 && l0 == 0) prev = 0ull;
                float x[11];
                x[0] = bhi((unsigned)prev); x[1] = blo((unsigned)(prev >> 32)); x[2] = bhi((unsigned)(prev >> 32));
                x[3] = blo(cur.x); x[4] = bhi(cur.x); x[5] = blo(cur.y); x[6] = bhi(cur.y); x[7] = blo(cur.z); x[8] = bhi(cur.z); x[9] = blo(cur.w); x[10] = bhi(cur.w);
                float kv[8];
#pragma unroll
                for (int j = 0; j < 8; ++j) { const float av = cbr[kb2] + cwr[kb2][0] * x[j] + cwr[kb2][1] * x[j + 1] + cwr[kb2][2] * x[j + 2] + cwr[kb2][3] * x[j + 3];
                    const float kw = av * sigmf(av) * 0.08838834764831845f * wv[j]; kv[j] = kw; nsum[kb2] += kw; }
                af[kb2] = pack8(kv);
            }
#pragma unroll
            for (int vb = 0; vb < 4; ++vb) {
                const bf16x8_t vfr = *(const bf16x8_t*)(tT + (size_t)(T_MV + h * 128 + vb * 32 + r32) * M + tok0 + l0);
#pragma unroll
                for (int kb2 = 0; kb2 < 2; ++kb2) acc[kb2][vb] = __builtin_amdgcn_mfma_f32_32x32x16_bf16(af[kb2], vfr, acc[kb2][vb], 0, 0, 0);
            }
        }
#pragma unroll
        for (int kb2 = 0; kb2 < 2; ++kb2) { const float ns = nsum[kb2] + __shfl_xor(nsum[kb2], 32); if (hi == 0) nloc[unit * 128 + kh * 64 + kb2 * 32 + r32] = ns; }
#pragma unroll
        for (int kb2 = 0; kb2 < 2; ++kb2)
#pragma unroll
            for (int vb = 0; vb < 4; ++vb) { bf16* cp = cloc + (size_t)unit * 16384 + (size_t)(vb * 32 + r32) * 128 + kh * 64 + kb2 * 32 + 4 * hi;
#pragma unroll
                for (int g4 = 0; g4 < 4; ++g4) *(unsigned long long*)(cp + 8 * g4) = (unsigned long long)cvtpk(acc[kb2][vb][4 * g4 + 0], acc[kb2][vb][4 * g4 + 1]) | ((unsigned long long)cvtpk(acc[kb2][vb][4 * g4 + 2], acc[kb2][vb][4 * g4 + 3]) << 32); }
    }
}

__device__ __forceinline__ void conv_prepass(const bf16* n2, const float* cw, const float* cb, bf16* qk, int bid, int G, int tid) {
    for (int it = bid * 512 + tid; it < (M / 16) * 128; it += G * 512) {
        const int cg = it & 127, tr = it >> 7, ch0 = 8 * cg; const size_t t0 = (size_t)tr * 16;
        const bf16* src = n2 + (ch0 < 512 ? N2_MQ + ch0 : N2_MK + (ch0 - 512));
        const float sc = ch0 < 512 ? 1.0f : 0.08838834764831845f;
        float w[4][8], bb[8];
#pragma unroll
        for (int e = 0; e < 8; ++e) { bb[e] = cb[ch0 + e];
#pragma unroll
            for (int j = 0; j < 4; ++j) w[j][e] = cw[j * 1024 + ch0 + e]; }
        float x0[8], x1[8], x2[8];
        const bool first = (t0 & (SEQ - 1)) == 0;
#pragma unroll
        for (int r = 0; r < 3; ++r) { v4u v = {0u, 0u, 0u, 0u}; if (!first) v = *(const v4u*)(src + (t0 - 3 + r) * LD2);
            float* d = r == 0 ? x0 : (r == 1 ? x1 : x2);
            d[0] = blo(v.x); d[1] = bhi(v.x); d[2] = blo(v.y); d[3] = bhi(v.y); d[4] = blo(v.z); d[5] = bhi(v.z); d[6] = blo(v.w); d[7] = bhi(v.w); }
#pragma unroll 4
        for (int i = 0; i < 16; ++i) {
            const v4u v = *(const v4u*)(src + (t0 + i) * LD2); float x3[8] = {blo(v.x), bhi(v.x), blo(v.y), bhi(v.y), blo(v.z), bhi(v.z), blo(v.w), bhi(v.w)}; float o[8];
#pragma unroll
            for (int e = 0; e < 8; ++e) { const float a = bb[e] + w[0][e] * x0[e] + w[1][e] * x1[e] + w[2][e] * x2[e] + w[3][e] * x3[e]; o[e] = a * sigmf(a) * sc; x0[e] = x1[e]; x1[e] = x2[e]; x2[e] = x3[e]; }
            v4u ov; ov.x = cvtpk(o[0], o[1]); ov.y = cvtpk(o[2], o[3]); ov.z = cvtpk(o[4], o[5]); ov.w = cvtpk(o[6], o[7]);
            *(v4u*)(qk + (t0 + i) * 1024 + ch0) = ov;
        }
    }
}

__device__ __forceinline__ void mlstm_out_mfma(const bf16* qk, const bf16* n2, const bf16* tT, const float* gates, const bf16* cst, const float* nst, const float* mst, const float* mhg, bf16* mout, LAS float* ldsf, int bid, int G, int wave, int lane) {
    LAS float* sm = ldsf + wave * 256;
    const int r32 = lane & 31, hi = lane >> 5;
    const int pir = (r32 & ~12) | ((r32 & 4) << 1) | ((r32 & 8) >> 1);
    for (int task = bid * 8 + wave; task < 2 * NUNIT; task += G * 8) {
        const int unit = task >> 1, tb = task & 1, b = unit >> 8, c = (unit >> 2) & 63, h = unit & 3; const size_t tok0 = (size_t)b * SEQ + c * CHK;
        { const float lf = gates[(tok0 + lane) * 8 + 4 + h], ig = gates[(tok0 + lane) * 8 + h];
          const float cum = scan_add(lf, lane), e = ig - cum, pm = scan_max(e, lane), g = cum + mst[unit], mt = fmaxf(g, cum + pm);
          sm[lane] = e; sm[64 + lane] = cum; sm[128 + lane] = mt; sm[192 + lane] = __expf(g - mt); }
        LDS_WAIT();
        const int t = tb * 32 + r32; const float bc_t = sm[64 + t], mt_t = sm[128 + t], in_t = sm[192 + t];
        bf16x8_t qf[8];
#pragma unroll
        for (int s = 0; s < 8; ++s) qf[s] = *(const bf16x8_t*)(qk + (tok0 + t) * 1024 + h * 128 + 64 * hi + 8 * s);
        float nq = 0.f;
#pragma unroll
        for (int s = 0; s < 8; ++s) { const f32x4 n0 = *(const f32x4*)(nst + unit * 128 + 64 * hi + 8 * s), n1 = *(const f32x4*)(nst + unit * 128 + 64 * hi + 8 * s + 4); const v4u q = __builtin_bit_cast(v4u, qf[s]);
            nq += n0.x * blo(q.x) + n0.y * bhi(q.x) + n0.z * blo(q.y) + n0.w * bhi(q.y) + n1.x * blo(q.z) + n1.y * bhi(q.z) + n1.z * blo(q.w) + n1.w * bhi(q.w); }
        nq += __shfl_xor(nq, 32);
        f32x16_t num[4];
#pragma unroll
        for (int vb = 0; vb < 4; ++vb) {
#pragma unroll
            for (int i = 0; i < 16; ++i) num[vb][i] = 0.f;
#pragma unroll
            for (int s = 0; s < 8; ++s) { const bf16x8_t cf = *(const bf16x8_t*)(cst + (size_t)unit * 16384 + (size_t)(vb * 32 + r32) * 128 + 64 * hi + 8 * s);
                num[vb] = __builtin_amdgcn_mfma_f32_32x32x16_bf16(cf, qf[s], num[vb], 0, 0, 0); }
#pragma unroll
            for (int i = 0; i < 16; ++i) num[vb][i] *= in_t;
        }
        float dsum = 0.f;
        for (int sb = 0; sb <= tb; ++sb) {
            f32x16_t sa;
#pragma unroll
            for (int i = 0; i < 16; ++i) sa[i] = 0.f;
#pragma unroll
            for (int s = 0; s < 8; ++s) { const bf16x8_t kf = *(const bf16x8_t*)(qk + (tok0 + sb * 32 + pir) * 1024 + 512 + h * 128 + 64 * hi + 8 * s);
                sa = __builtin_amdgcn_mfma_f32_32x32x16_bf16(kf, qf[s], sa, 0, 0, 0); }
            float dv[16];
#pragma unroll
            for (int hf = 0; hf < 2; ++hf) { const int sbase = sb * 32 + 16 * hf + 8 * hi;
                const f32x4 e0 = *(const LAS f32x4*)(sm + sbase), e1 = *(const LAS f32x4*)(sm + sbase + 4); const float ev[8] = {e0.x, e0.y, e0.z, e0.w, e1.x, e1.y, e1.z, e1.w};
#pragma unroll
                for (int j = 0; j < 8; ++j) { float val = sa[8 * hf + j] * __expf(bc_t - mt_t + ev[j]); val = (sbase + j > t) ? 0.f : val; dv[8 * hf + j] = val; dsum += val; } }
            bf16x8_t pf[2] = {pack8(dv), pack8(dv + 8)};
#pragma unroll
            for (int vb = 0; vb < 4; ++vb)
#pragma unroll
                for (int s2 = 0; s2 < 2; ++s2) { const bf16x8_t vfr = *(const bf16x8_t*)(tT + (size_t)(T_MV + h * 128 + vb * 32 + r32) * M + tok0 + sb * 32 + 16 * s2 + 8 * hi);
                    num[vb] = __builtin_amdgcn_mfma_f32_32x32x16_bf16(vfr, pf[s2], num[vb], 0, 0, 0); }
        }
        dsum += __shfl_xor(dsum, 32);
        const float den = in_t * nq + dsum, inv = 1.0f / fmaxf(fabsf(den), __expf(-mt_t));
        float ss = 0.f;
#pragma unroll
        for (int vb = 0; vb < 4; ++vb)
#pragma unroll
            for (int i = 0; i < 16; ++i) { const float hv = num[vb][i] * inv; num[vb][i] = hv; ss += hv * hv; }
        ss += __shfl_xor(ss, 32);
        const float rms = rsqrtf(ss * (1.0f / 128.0f) + EPS);
#pragma unroll
        for (int vb = 0; vb < 4; ++vb)
#pragma unroll
            for (int g4 = 0; g4 < 4; ++g4) { const int v0 = vb * 32 + 8 * g4 + 4 * hi;
                const unsigned long long mo = *(const unsigned long long*)(n2 + (tok0 + t) * LD2 + N2_MO + h * 128 + v0); const f32x4 gg = *(const f32x4*)(mhg + h * 128 + v0);
                const float o0 = sigmf(blo((unsigned)mo)) * num[vb][4 * g4 + 0] * rms * gg.x, o1 = sigmf(bhi((unsigned)mo)) * num[vb][4 * g4 + 1] * rms * gg.y;
                const float o2 = sigmf(blo((unsigned)(mo >> 32))) * num[vb][4 * g4 + 2] * rms * gg.z, o3 = sigmf(bhi((unsigned)(mo >> 32))) * num[vb][4 * g4 + 3] * rms * gg.w;
                *(unsigned long long*)(mout + (tok0 + t) * 512 + h * 128 + v0) = (unsigned long long)cvtpk(o0, o1) | ((unsigned long long)cvtpk(o2, o3) << 32); }
    }
}

__device__ __forceinline__ void mlstm_local_naive(const bf16* n2, const bf16* tT, const float* gates, const float* cw, const float* cb, bf16* cloc, float* nloc, float* mloc, float* blast, float* lds, int bid, int G, int tid) {
    float* KS = lds; float* WV = lds + 8192; float* sm = lds + 16384;
    for (int unit = bid; unit < NUNIT; unit += G) {
        const int b = unit >> 8, c = (unit >> 2) & 63, h = unit & 3; const size_t tok0 = (size_t)b * SEQ + c * CHK;
        if (tid < 64) { sm[tid] = gates[(tok0 + tid) * 8 + 4 + h]; sm[64 + tid] = gates[(tok0 + tid) * 8 + h]; }
        __syncthreads();
        if (tid == 0) { float cum = 0.f; for (int l = 0; l < 64; ++l) { cum += sm[l]; sm[128 + l] = cum; }
            float mxa = -INFINITY; for (int l = 0; l < 64; ++l) { const float a = cum - sm[128 + l] + sm[64 + l]; sm[192 + l] = a; mxa = fmaxf(mxa, a); }
            for (int l = 0; l < 64; ++l) sm[192 + l] = __expf(sm[192 + l] - mxa);
            sm[256] = mxa; sm[257] = cum; }
        __syncthreads();
        for (int e = tid; e < 8192; e += 512) { const int l = e >> 7, d = e & 127, pos = c * CHK + l, ch = 512 + h * 128 + d;
            float a = cb[ch];
#pragma unroll
            for (int j = 0; j < 4; ++j) { const int p = pos - 3 + j; if (p >= 0) a += cw[j * 1024 + ch] * bf2f(n2[((size_t)b * SEQ + p) * LD2 + N2_MK + h * 128 + d]); }
            KS[e] = a * sigmf(a) * 0.08838834764831845f;
            WV[e] = sm[192 + l] * bf2f(tT[(size_t)(T_MV + h * 128 + d) * M + tok0 + l]); }
        __syncthreads();
        { const int k = tid & 127, vg = tid >> 7; float a[32];
#pragma unroll
          for (int i = 0; i < 32; ++i) a[i] = 0.f;
          for (int l = 0; l < 64; ++l) { const float kk = KS[l * 128 + k];
#pragma unroll
              for (int i = 0; i < 32; ++i) a[i] += WV[l * 128 + vg * 32 + i] * kk; }
          bf16* cp = cloc + (size_t)unit * 16384 + (size_t)(vg * 32) * 128 + k;
#pragma unroll
          for (int i = 0; i < 32; ++i) cp[i * 128] = (bf16)f2bf(a[i]); }
        if (tid < 128) { float s = 0.f; for (int l = 0; l < 64; ++l) s += sm[192 + l] * KS[l * 128 + tid]; nloc[unit * 128 + tid] = s; }
        if (tid == 0) { mloc[unit] = sm[256]; blast[unit] = sm[257]; }
        __syncthreads();
    }
}

__device__ __forceinline__ void mlstm_scan(bf16* cloc, float* nloc, const float* mloc, const float* blast, float* mst, int bid, int G, int tid, int dry) {
    const int gt = bid * 512 + tid, NT = G * 512;
    for (int it = gt; it < 16 * 8192; it += NT) {
        const int bh = it >> 13, e2 = it & 8191, b = bh >> 2, h = bh & 3; float C0 = 0.f, C1 = 0.f, m = 0.f;
        unsigned* base = (unsigned*)cloc + e2; const int u0 = b * NCHK * 4 + h;
        constexpr int PD = 16;
        unsigned w[PD]; float ml[PD], bl[PD];
#pragma unroll
        for (int i = 0; i < PD; ++i) { const int unit = u0 + 4 * i; w[i] = base[(size_t)unit * 8192]; ml[i] = mloc[unit]; bl[i] = blast[unit]; }
        for (int c0 = 0; c0 < NCHK; c0 += PD) {
#pragma unroll
            for (int i = 0; i < PD; ++i) {
                const int unit = u0 + 4 * (c0 + i); const unsigned wc = w[i]; const float mlc = ml[i], blc = bl[i];
                if (c0 + PD < NCHK) { const int un = unit + 4 * PD; w[i] = base[(size_t)un * 8192]; ml[i] = mloc[un]; bl[i] = blast[un]; }
                if (!dry) base[(size_t)unit * 8192] = pk2(C0, C1);
                if (e2 == 0 && !dry) mst[unit] = m;
                const float mn = fmaxf(blc + m, mlc), sp = __expf(blc + m - mn), sl = __expf(mlc - mn);
                C0 = sp * C0 + sl * blo(wc); C1 = sp * C1 + sl * bhi(wc); m = mn;
            }
        }
    }
    for (int it = gt; it < 16 * 128; it += NT) {
        const int bh = it >> 7, k = it & 127, b = bh >> 2, h = bh & 3; float n = 0.f, m = 0.f;
        for (int c = 0; c < NCHK; ++c) { const int unit = (b * NCHK + c) * 4 + h; const float ml = mloc[unit], bl = blast[unit];
            const float nl = nloc[unit * 128 + k]; if (!dry) nloc[unit * 128 + k] = n;
            const float mn = fmaxf(bl + m, ml), sp = __expf(bl + m - mn), sl = __expf(ml - mn);
            n = sp * n + sl * nl; m = mn; }
    }
}

__device__ __forceinline__ void mlstm_out_naive(const bf16* n2, const bf16* tT, const float* gates, const float* cw, const float* cb, const bf16* cst, const float* nst, const float* mst, const float* mhg, bf16* mout, float* lds, int bid, int G, int tid) {
    constexpr int QP = 129, DP = 65;
    float* QS = lds; float* KS = lds + 64 * QP; float* VS = lds + 2 * 64 * QP; float* DS = VS + 8192; float* sm = DS + 64 * DP;
    for (int unit = bid; unit < NUNIT; unit += G) {
        const int b = unit >> 8, c = (unit >> 2) & 63, h = unit & 3; const size_t tok0 = (size_t)b * SEQ + c * CHK;
        for (int e = tid; e < 8192; e += 512) { const int l = e >> 7, d = e & 127, pos = c * CHK + l, chq = h * 128 + d, chk = 512 + chq;
            float aq = cb[chq], ak = cb[chk];
#pragma unroll
            for (int j = 0; j < 4; ++j) { const int p = pos - 3 + j; if (p >= 0) { const bf16* rp = n2 + ((size_t)b * SEQ + p) * LD2; aq += cw[j * 1024 + chq] * bf2f(rp[N2_MQ + chq]); ak += cw[j * 1024 + chk] * bf2f(rp[N2_MK + chq]); } }
            QS[l * QP + d] = aq * sigmf(aq); KS[l * QP + d] = ak * sigmf(ak) * 0.08838834764831845f;
            VS[e] = bf2f(tT[(size_t)(T_MV + chq) * M + tok0 + l]); }
        if (tid < 64) { sm[tid] = gates[(tok0 + tid) * 8 + 4 + h]; sm[64 + tid] = gates[(tok0 + tid) * 8 + h]; }
        __syncthreads();
        if (tid == 0) { float cum = 0.f, pm = -INFINITY; const float ms = mst[unit];
            for (int t = 0; t < 64; ++t) { cum += sm[t]; sm[128 + t] = cum; pm = fmaxf(pm, sm[64 + t] - cum); const float g = cum + ms, mt = fmaxf(g, cum + pm); sm[192 + t] = mt; sm[256 + t] = __expf(g - mt); } }
        __syncthreads();
        for (int e = tid; e < 4096; e += 512) { const int t = e >> 6, s = e & 63; float val = 0.f;
            if (s <= t) { float dot = 0.f;
#pragma unroll 8
                for (int d = 0; d < 128; ++d) dot += QS[t * QP + d] * KS[s * QP + d];
                val = dot * __expf(sm[128 + t] - sm[128 + s] + sm[64 + s] - sm[192 + t]); }
            DS[t * DP + s] = val; }
        __syncthreads();
        if (tid < 64) { const int t = tid; float sq = 0.f, sd = 0.f;
            for (int k = 0; k < 128; ++k) sq += nst[unit * 128 + k] * QS[t * QP + k];
            for (int s = 0; s < 64; ++s) sd += DS[t * DP + s];
            const float den = sm[256 + t] * sq + sd; sm[320 + t] = fmaxf(fabsf(den), __expf(-sm[192 + t])); }
        const int v = tid & 127, tg = tid >> 7; float a[16];
#pragma unroll
        for (int i = 0; i < 16; ++i) a[i] = 0.f;
        { const bf16* crow = cst + (size_t)unit * 16384 + (size_t)v * 128;
          for (int k = 0; k < 128; ++k) { const float cv = bf2f(crow[k]);
#pragma unroll
              for (int i = 0; i < 16; ++i) a[i] += cv * QS[(tg * 16 + i) * QP + k]; } }
#pragma unroll
        for (int i = 0; i < 16; ++i) a[i] *= sm[256 + tg * 16 + i];
        for (int s = 0; s < 64; ++s) { const float vv = VS[s * 128 + v];
#pragma unroll
            for (int i = 0; i < 16; ++i) a[i] += DS[(tg * 16 + i) * DP + s] * vv; }
        __syncthreads();
        float* HS = KS;
#pragma unroll
        for (int i = 0; i < 16; ++i) HS[(tg * 16 + i) * QP + v] = a[i] / sm[320 + tg * 16 + i];
        __syncthreads();
        if (tid < 64) { float s = 0.f; for (int k = 0; k < 128; ++k) { const float x = HS[tid * QP + k]; s += x * x; } sm[384 + tid] = rsqrtf(s * (1.0f / 128.0f) + EPS); }
        __syncthreads();
        for (int e = tid; e < 8192; e += 512) { const int t = e >> 7, vv = e & 127;
            const float mo = bf2f(n2[(tok0 + t) * LD2 + N2_MO + h * 128 + vv]);
            mout[(tok0 + t) * 512 + h * 128 + vv] = (bf16)f2bf(sigmf(mo) * HS[t * QP + vv] * sm[384 + t] * mhg[h * 128 + vv]); }
        __syncthreads();
    }
}

#define XB_TMO      128
#define XB_XCNT(j)  (256  + 64 * (j))
#define XB_XSUB(j)  (1280 + 64 * (j))
#define XB_XGEN(j)  (2304 + 64 * (j))
#define XB_TOP      3328
#define XB_TOPGEN   3392
#define XCD_BAR_WORDS 3456
#define XB_SPIN_CAP (1u << 18)

__device__ __forceinline__ unsigned xb_ld(unsigned* p)              { return __hip_atomic_load(p, __ATOMIC_RELAXED, __HIP_MEMORY_SCOPE_AGENT); }
__device__ __forceinline__ unsigned xb_add(unsigned* p, unsigned v) { return __hip_atomic_fetch_add(p, v, __ATOMIC_RELAXED, __HIP_MEMORY_SCOPE_AGENT); }
__device__ __forceinline__ unsigned xb_xcc_id() { return (unsigned)__builtin_amdgcn_s_getreg((3 << 11) | 20) & 0xFu; }
#define XB_SPIN(cond, bar) do { unsigned _sp = 0; while (cond) { __builtin_amdgcn_s_sleep(1); \
    if ((++_sp & 255u) == 0u) { if (xb_ld(&(bar)[XB_TMO])) break; if (_sp > XB_SPIN_CAP) { atomicAdd(&(bar)[XB_TMO], 1u); break; } } } } while (0)

struct XcdBarrier {
    unsigned* bar; unsigned x;
    volatile LAS unsigned* st;
};

__device__ __forceinline__ XcdBarrier xcd_barrier_post(unsigned* bar, volatile LAS unsigned* st) {
    XcdBarrier b; b.bar = bar; b.x = xb_xcc_id(); b.st = st;
    if (threadIdx.x == 0) (void)xb_add(&bar[XB_XCNT(b.x)], 1u);
    return b;
}
__device__ __forceinline__ void xcd_barrier_complete(unsigned* bar, unsigned x, unsigned& nloc, unsigned& nx) {
    const unsigned G = gridDim.x * gridDim.y * gridDim.z;
    unsigned sum, cnt, mine, sp = 0u;
    for (;;) {
        sum = 0u; cnt = 0u; mine = 0u;
#pragma unroll
        for (unsigned j = 0; j < 16; ++j) { const unsigned c = xb_ld(&bar[XB_XCNT(j)]); sum += c; cnt += (c > 0u) ? 1u : 0u; mine = (j == x) ? c : mine; }
        if (sum == G) break;
        __builtin_amdgcn_s_sleep(1);
        if ((++sp & 255u) == 0u) { if (xb_ld(&bar[XB_TMO])) break; if (sp > XB_SPIN_CAP) { atomicAdd(&bar[XB_TMO], 1u); break; } }
    }
    nloc = mine > 0u ? mine : 1u; nx = cnt > 0u ? cnt : 1u;
}

__device__ __forceinline__ void xcd_barrier(const XcdBarrier& b) {
    asm volatile("s_waitcnt vmcnt(0)" ::: "memory");
    __syncthreads();
    if (threadIdx.x == 0) {
        unsigned* bar = b.bar;
        __builtin_amdgcn_s_waitcnt(0);
        unsigned nloc = b.st[0], nx = b.st[1];
        if (nloc == 0u) { xcd_barrier_complete(bar, b.x, nloc, nx); b.st[0] = nloc; b.st[1] = nx; }
        const unsigned old = xb_add(&bar[XB_XSUB(b.x)], 1u);
        const unsigned gen = old / nloc;
        if (old + 1u == (gen + 1u) * nloc) {
            __builtin_amdgcn_fence(__ATOMIC_RELEASE, "agent");
            asm volatile("s_waitcnt vmcnt(0)" ::: "memory");
            const unsigned og = xb_add(&bar[XB_TOP], 1u);
            const unsigned tg = og / nx;
            if (og + 1u == (tg + 1u) * nx) xb_add(&bar[XB_TOPGEN], 1u);
            else XB_SPIN(xb_ld(&bar[XB_TOPGEN]) == tg, bar);
            __builtin_amdgcn_fence(__ATOMIC_ACQUIRE, "agent");
            xb_add(&bar[XB_XGEN(b.x)], 1u);
            asm volatile("s_waitcnt vmcnt(0)" ::: "memory");
        } else {
            XB_SPIN(xb_ld(&bar[XB_XGEN(b.x)]) == gen, bar);
            __builtin_amdgcn_fence(__ATOMIC_ACQUIRE, "agent");
            asm volatile("s_waitcnt vmcnt(0)" ::: "memory");
        }
    }
    __syncthreads();
}
constexpr int N_STEPS = 27, STEP_PRO1 = 13, STEP_FIN = 26, KPL = 13;
enum { K_PRO = 100, K_FIN = 101, K_A = 0, K_A2 = 1, K_B = 2, K_C = 3, K_D = 4, K_E1 = 5, K_E2 = 6, K_E3 = 7, K_E4 = 8, K_F = 9, K_G = 10, K_H = 11 };
struct Args { const float* in[16]; float* out; unsigned char* ws; int ph_lo, ph_hi; };

enum { SEL_ALL = 0, SEL_PRO = 1, SEL_FIN = 2, SEL_B = 3, SEL_C = 4, SEL_D = 5, SEL_GEMM = 6, SEL_GATES = 7 };
template <int SEL> __global__ void __launch_bounds__(512, 2) mk_fwd(Args args) {
    extern __shared__ __attribute__((aligned(16))) unsigned char lds[];
    constexpr int G = 256; const int bid = blockIdx.x;
    {
        LAS unsigned char* ldsl0 = (LAS unsigned char*)lds;
        for (int u = threadIdx.x; u < (LDS_BYTES - LDSCTL_OFF) / 4; u += 512) ((LAS unsigned*)(ldsl0 + LDSCTL_OFF))[u] = 0u;
        __syncthreads();
    }
    XcdBarrier bar; bar.bar = (unsigned*)(args.ws + WS_CTL) + CW_BAR; bar.x = 0; bar.st = nullptr;
    if (MK_ONE_LAUNCH) bar = xcd_barrier_post((unsigned*)(args.ws + WS_CTL) + CW_BAR, (volatile LAS unsigned*)((LAS unsigned char*)lds + MISC_OFF) + 8);

    int prep = 0;
    for (int step = args.ph_lo; step < args.ph_hi;) {
        int tid = threadIdx.x; asm volatile("" : "+v"(tid));
        const int lane = tid & 63, wave = __builtin_amdgcn_readfirstlane(tid >> 6), gw = bid * 8 + wave, NGW = G * 8;
        unsigned char* ws = args.ws; asm volatile("" : "+s"(ws));
        int zi = 0; asm volatile("" : "+s"(zi));
#define INP(k) (args.in[(k) + zi])
        LAS unsigned char* ldsl = (LAS unsigned char*)lds;
        const float* x_in = INP(0); float* xout = args.out; asm volatile("" : "+s"(xout));
        float* ssq = (float*)(ws + WS_SSQ); float* wg = (float*)(ws + WS_WG); float* gates = (float*)(ws + WS_GATES);
        float* nloc = (float*)(ws + WS_NLOC); float* mloc = (float*)(ws + WS_MLOC); float* blast = (float*)(ws + WS_BLAST); float* mst = (float*)(ws + WS_MST);
        bf16* Wb = (bf16*)(ws + WS_W); bf16* xb = (bf16*)(ws + WS_XB); bf16* n1 = (bf16*)(ws + WS_N1); bf16* n2 = (bf16*)(ws + WS_N2); bf16* tT = (bf16*)(ws + WS_T); bf16* att = (bf16*)(ws + WS_ATT);
        bf16* cloc = (bf16*)(ws + WS_CLOC); bf16* mout = (bf16*)(ws + WS_MOUT); bf16* Yb = (bf16*)(ws + WS_Y); bf16* Zb = (bf16*)(ws + WS_Z); bf16* Hb = (bf16*)(ws + WS_H);
        const int layer = step >= STEP_PRO1 ? 1 : 0;
        const int kind = (step == 0 || step == STEP_PRO1) ? K_PRO : (step == STEP_FIN ? K_FIN : (step - 1) % KPL);
        float* ssqA = ssq + (size_t)(2 * layer) * M; float* ssqF = ssq + (size_t)(2 * layer + 1) * M; float* ssqN = ssq + (size_t)(2 * layer + 2) * M;
        const float* xres = layer == 0 ? x_in : xout;

        if ((SEL == SEL_ALL || SEL == SEL_PRO) && kind == K_PRO) {
            LAS float* scr = (LAS float*)(ldsl + wave * 16384);
            const float* w_in = INP(2) + (size_t)layer * DM * DIN_SRC; const float* g_mix = INP(1) + layer * DM;
            const float* w_a = INP(9) + (size_t)layer * 512 * DM; const float* w_m = INP(10) + (size_t)layer * 512 * DM;
            const float* w_o = INP(11) + (size_t)layer * DM * DM; const float* g_ffn = INP(12) + layer * DM;
            const float* w_up = INP(13) + (size_t)layer * DM * DFF; const float* w_dn = INP(14) + (size_t)layer * DFF * DM;
            constexpr int I_IN = 16 * 176, I_A = 8 * 32, I_M = 8 * 32, I_O = 16 * 32, I_UP = 16 * 128, I_DN = 64 * 32, NITEMS = I_IN + I_A + I_M + I_O + I_UP + I_DN;
            for (int it = gw; it < NITEMS; it += NGW) {
                int r = it;
                if (r < I_IN) { transpose_item(w_in, DIN_SRC, 1, g_mix, Wb + W_IN, 1024, 176, scr, r, lane); continue; } r -= I_IN;
                if (r < I_A) { transpose_item(w_a, DM, 0, nullptr, Wb + W_A, 512, 32, scr, r, lane); continue; } r -= I_A;
                if (r < I_M) { transpose_item(w_m, DM, 0, nullptr, Wb + W_M, 512, 32, scr, r, lane); continue; } r -= I_M;
                if (r < I_O) { transpose_item(w_o, DM, 0, nullptr, Wb + W_O, 1024, 32, scr, r, lane); continue; } r -= I_O;
                if (r < I_UP) { transpose_item(w_up, DFF, 0, g_ffn, Wb + W_UP, 1024, 128, scr, r, lane); continue; } r -= I_UP;
                transpose_item(w_dn, DM, 0, nullptr, Wb + W_DN, 4096, 32, scr, r, lane);
            }
            for (int i = bid * 512 + tid; i < 8 * 1024; i += G * 512) { const int j = i >> 10, k = i & 1023; wg[i] = g_mix[k] * w_in[(size_t)k * DIN_SRC + 3584 + j]; }
            if (layer == 0) {
                for (int i = bid * 512 + tid; i < 4 * M; i += G * 512) ssq[M + i] = 0.f;
                for (int m = gw; m < M; m += NGW) {
                    const f32x4* xr = (const f32x4*)(x_in + (size_t)m * DM) + lane; f32x4 v[4]; float s = 0.f;
#pragma unroll
                    for (int j = 0; j < 4; ++j) { v[j] = xr[64 * j]; s += (v[j].x * v[j].x + v[j].y * v[j].y) + (v[j].z * v[j].z + v[j].w * v[j].w); }
                    s = wave_sum(s); if (lane == 0) ssq[m] = s;
                    unsigned long long* o8 = (unsigned long long*)(xb + (size_t)m * DM) + lane;
#pragma unroll
                    for (int j = 0; j < 4; ++j) o8[64 * j] = (unsigned long long)pk2(v[j].x, v[j].y) | ((unsigned long long)pk2(v[j].z, v[j].w) << 32);
                }
            }
        } else if ((SEL == SEL_ALL || SEL == SEL_FIN) && kind == K_FIN) {
            const float* gf = INP(15);
            for (int m = gw; m < M; m += NGW) {
                const float rs = rsqrtf(ssqN[m] * (1.0f / 1024.0f) + EPS);
                f32x4* xr = (f32x4*)(xout + (size_t)m * DM) + lane; const f32x4* gr = (const f32x4*)gf + lane;
#pragma unroll
                for (int j = 0; j < 4; ++j) { const f32x4 v = xr[64 * j], g = gr[64 * j]; xr[64 * j] = v * rs * g; }
            }
        } else if ((SEL == SEL_ALL || SEL == SEL_B) && kind == K_B) {
#if FAST_ATTN
            attn_mfma(n1, tT, INP(7) + (size_t)layer * 8 * 513, att, (LAS float*)ldsl, bid, G, wave, lane);
            __syncthreads();
#else
            attn_naive(n1, tT, INP(7) + (size_t)layer * 8 * 513, att, bid, G, wave, lane);
#endif
#if FAST_LOCAL
            mlstm_local_mfma(tT, gates, INP(3) + (size_t)layer * 4096, INP(4) + (size_t)layer * 1024, cloc, nloc, mloc, blast, (LAS float*)ldsl, bid, G, wave, lane);
#else
            mlstm_local_naive(n2, tT, gates, INP(3) + (size_t)layer * 4096, INP(4) + (size_t)layer * 1024, cloc, nloc, mloc, blast, (float*)lds, bid, G, tid);
#endif
        } else if ((SEL == SEL_ALL || SEL == SEL_C) && kind == K_C) {
            mlstm_scan(cloc, nloc, mloc, blast, mst, bid, G, tid, prep);
#if FAST_OUT
            conv_prepass(n2, INP(3) + (size_t)layer * 4096, INP(4) + (size_t)layer * 1024, n1, bid, G, tid);
#endif
        } else if ((SEL == SEL_ALL || SEL == SEL_D) && kind == K_D) {
#if FAST_OUT
            mlstm_out_mfma(n1, n2, tT, gates, cloc, nloc, mst, INP(8) + (size_t)layer * 512, mout, (LAS float*)ldsl, bid, G, wave, lane);
#else
            mlstm_out_naive(n2, tT, gates, INP(3) + (size_t)layer * 4096, INP(4) + (size_t)layer * 1024, cloc, nloc, mst, INP(8) + (size_t)layer * 512, mout, (float*)lds, bid, G, tid);
#endif
        } else if ((SEL == SEL_ALL || SEL == SEL_GEMM) && kind <= K_H && kind != K_A2) {
#ifndef GATES_ON
#define GATES_ON 1
#endif
#ifdef GEMM_ONLY
#define GEMM_ON(k) ((k) == GEMM_ONLY)
#else
#define GEMM_ON(k) true
#endif
            pg8::StaticOrder S;
#define RUN_GEMM_X(MODE, MR_, CU_, A_, BT_, N_, K_, O_, LDC_, Z_, SSQI_, BASE_, OUTF_, SSQO_, O2_, LDC2_, SPLIT_) do { pg8::Gemm g; g.A = (A_); g.Bt = (BT_); g.M = (MR_); g.N = (N_); g.K = (K_); \
                pg8::EpiAny<MODE> E; E.O = (O_); E.ldc = (LDC_); E.Z = (Z_); E.ssq_in = (SSQI_); E.base = (BASE_); E.outf = (OUTF_); E.ssq_out = (SSQO_); E.O2 = (O2_); E.ldc2 = (LDC2_); E.split = (SPLIT_); E.dry = prep; \
                S.init((MR_), (N_), G, (CU_)); pg8::gemm_phase<pg8::EpiAny<MODE>, pg8::StaticOrder, true, true>(ldsl, g, S, E); } while (0)
#define RUN_GEMM(MODE, A_, BT_, N_, K_, O_, LDC_, Z_, SSQI_, BASE_, OUTF_, SSQO_) RUN_GEMM_X(MODE, M, bid, A_, BT_, N_, K_, O_, LDC_, Z_, SSQI_, BASE_, OUTF_, SSQO_, nullptr, 0, 0)
            if (GEMM_ON(K_A) && kind == K_A) {
                RUN_GEMM_X(0, M, bid, xb, Wb + W_IN, 2560, 1024, n1, LD1, nullptr, ssqA, nullptr, nullptr, nullptr, n2, LD2, 1024);
                RUN_GEMM_X(6, 1536, (bid + G / 2) % G, Wb + W_IN + (size_t)2048 * 1024, xb, M, 1024, tT, M, nullptr, ssqA, nullptr, nullptr, nullptr, nullptr, 0, 0);
            }
            else if (GEMM_ON(K_E1) && kind == K_E1) RUN_GEMM(2, att, Wb + W_A, 1024, 512, Yb, 1024, nullptr, nullptr, nullptr, nullptr, nullptr);
            else if (GEMM_ON(K_E2) && kind == K_E2) RUN_GEMM(3, xb, Wb + W_IN + (size_t)3584 * 1024, 1024, 1024, Yb, 1024, nullptr, ssqA, nullptr, nullptr, nullptr);
            else if (GEMM_ON(K_E3) && kind == K_E3) RUN_GEMM(2, mout, Wb + W_M, 1024, 512, Zb, 1024, nullptr, nullptr, nullptr, nullptr, nullptr);
            else if (GEMM_ON(K_E4) && kind == K_E4) RUN_GEMM(4, xb, Wb + W_IN + (size_t)4608 * 1024, 1024, 1024, Yb, 1024, Zb, ssqA, nullptr, nullptr, nullptr);
            else if (GEMM_ON(K_F) && kind == K_F)  RUN_GEMM(5, Yb, Wb + W_O, 1024, 1024, xb, 1024, nullptr, nullptr, xres, xout, ssqF);
            else if (GEMM_ON(K_G) && kind == K_G)  RUN_GEMM(1, xb, Wb + W_UP, 4096, 1024, Hb, DFF, nullptr, ssqF, nullptr, nullptr, nullptr);
            else if (GEMM_ON(K_H)) RUN_GEMM(5, Hb, Wb + W_DN, 1024, 4096, xb, 1024, nullptr, nullptr, xout, xout, ssqN);
        } else if ((SEL == SEL_ALL || SEL == SEL_GATES) && kind == K_A2) {
            gates_phase(xres, wg, INP(5) + layer * 4, INP(6) + layer * 4, gates, (LAS float*)ldsl, bid, tid);
        }
        const bool seam = !(kind == K_A || kind == K_E1 || kind == K_E2 || kind == K_E3);
        if (seam && step + 1 < args.ph_hi) { if (MK_ONE_LAUNCH) xcd_barrier(bar); }
#ifdef PROBE_REPEAT
        if ((PROBE_REPEAT_COND) && prep + 1 < PROBE_REPEAT) { ++prep; } else { prep = 0; ++step; }
#else
        ++step;
#endif
    }
}

extern "C" void kernel_launch(void* const* d_in, const int* in_sizes, int n_in, void* d_out, int out_size, void* d_ws, size_t ws_size, hipStream_t stream) {
    static int grid = 0;
    if (grid == 0) {
        if (n_in != 16 || in_sizes[0] != M * DM || out_size != M * DM || ws_size < WS_END) { fprintf(stderr, "kernel_launch: unexpected shapes (n_in %d, in0 %d, out %d, ws %zu)\n", n_in, n_in > 0 ? in_sizes[0] : -1, out_size, ws_size); grid = -1; return; }
        int dev = 0, cus = 0;
        if (hipGetDevice(&dev) != hipSuccess || hipDeviceGetAttribute(&cus, hipDeviceAttributeMultiprocessorCount, dev) != hipSuccess) { grid = -1; return; }
        bool ok = true;
#if MK_ONE_LAUNCH
        ok &= hipFuncSetAttribute((const void*)mk_fwd<SEL_ALL>, hipFuncAttributeMaxDynamicSharedMemorySize, LDS_BYTES) == hipSuccess;
#endif
#if !MK_ONE_LAUNCH
        ok &= hipFuncSetAttribute((const void*)mk_fwd<SEL_PRO>, hipFuncAttributeMaxDynamicSharedMemorySize, LDS_BYTES) == hipSuccess;
        ok &= hipFuncSetAttribute((const void*)mk_fwd<SEL_FIN>, hipFuncAttributeMaxDynamicSharedMemorySize, LDS_BYTES) == hipSuccess;
        ok &= hipFuncSetAttribute((const void*)mk_fwd<SEL_B>, hipFuncAttributeMaxDynamicSharedMemorySize, LDS_BYTES) == hipSuccess;
        ok &= hipFuncSetAttribute((const void*)mk_fwd<SEL_C>, hipFuncAttributeMaxDynamicSharedMemorySize, LDS_BYTES) == hipSuccess;
        ok &= hipFuncSetAttribute((const void*)mk_fwd<SEL_D>, hipFuncAttributeMaxDynamicSharedMemorySize, LDS_BYTES) == hipSuccess;
        ok &= hipFuncSetAttribute((const void*)mk_fwd<SEL_GATES>, hipFuncAttributeMaxDynamicSharedMemorySize, LDS_BYTES) == hipSuccess;
        ok &= hipFuncSetAttribute((const void*)mk_fwd<SEL_GEMM>, hipFuncAttributeMaxDynamicSharedMemorySize, LDS_BYTES) == hipSuccess;
#endif
        if (!ok) { fprintf(stderr, "kernel_launch: hipFuncSetAttribute failed\n"); grid = -1; return; }
        (void)hipGetLastError();
        if (cus < 256) { fprintf(stderr, "kernel_launch: needs 256 CUs, device has %d\n", cus); grid = -1; return; }
        grid = 256;
    }
    if (grid < 0) return;
    if (hipMemsetAsync((char*)d_ws + WS_CTL, 0, CTL_ZERO_BYTES, stream) != hipSuccess) return;
    Args a{};
    for (int i = 0; i < 16; ++i) a.in[i] = (const float*)d_in[i];
    a.out = (float*)d_out; a.ws = (unsigned char*)d_ws;
#if MK_ONE_LAUNCH
    {
        a.ph_lo = 0; a.ph_hi = N_STEPS;
        hipLaunchKernelGGL(mk_fwd<SEL_ALL>, dim3(grid), dim3(512), LDS_BYTES, stream, a);
    }
#else
    {
        int s = 0;
        while (s < N_STEPS) {
            int e = s + 1;
            const int k = (s == 0 || s == STEP_PRO1 || s == STEP_FIN) ? -1 : (s - 1) % KPL;
            if (k == K_E1) e = s + 4;
            a.ph_lo = s; a.ph_hi = e;
            if (k == -1 && s != STEP_FIN) hipLaunchKernelGGL(mk_fwd<SEL_PRO>, dim3(grid), dim3(512), LDS_BYTES, stream, a);
            else if (k == -1) hipLaunchKernelGGL(mk_fwd<SEL_FIN>, dim3(grid), dim3(512), LDS_BYTES, stream, a);
            else if (k == K_A2) hipLaunchKernelGGL(mk_fwd<SEL_GATES>, dim3(grid), dim3(512), LDS_BYTES, stream, a);
            else if (k == K_B) hipLaunchKernelGGL(mk_fwd<SEL_B>, dim3(grid), dim3(512), LDS_BYTES, stream, a);
            else if (k == K_C) hipLaunchKernelGGL(mk_fwd<SEL_C>, dim3(grid), dim3(512), LDS_BYTES, stream, a);
            else if (k == K_D) hipLaunchKernelGGL(mk_fwd<SEL_D>, dim3(grid), dim3(512), LDS_BYTES, stream, a);
            else hipLaunchKernelGGL(mk_fwd<SEL_GEMM>, dim3(grid), dim3(512), LDS_BYTES, stream, a);
            s = e;
        }
    }
#endif
}
```

```cpp
#include <hip/hip_runtime.h>
#include <cstdio>
#include <cstdint>

namespace pg8 {
#define PG8_LAS __attribute__((address_space(3)))
typedef unsigned short bf16_t;
typedef short bf16x8 __attribute__((ext_vector_type(8)));
typedef float f32x4 __attribute__((ext_vector_type(4)));
typedef unsigned u32x4 __attribute__((ext_vector_type(4)));
constexpr int BM = 256, BK = 64, HALF = 128, HTB = HALF * BK * 2  , STAGE_BYTES = 8 * HTB, NXCD = 8, WGM = 8;

__host__ __device__ __forceinline__ int lds_byte(int r, int c) { const int st = (r >> 4) * 2 + (c >> 5), rr = r & 15, cc = c & 31, ob = rr * 64 + cc * 2; return st * 1024 + (ob ^ (((ob >> 9) & 1) << 5)); }
__host__ __device__ __forceinline__ void stage_rc(int b, int& R, int& C) { const int st = b / 1024, sb = b % 1024, swz = sb ^ (((sb >> 9) & 1) << 5); R = (st >> 1) * 16 + swz / 64; C = (st & 1) * 32 + (swz % 64) / 2; }
__host__ __device__ __forceinline__ int perm32(int rho) { const int n = rho >> 4, i = rho & 15; return 8 * (i >> 2) + 4 * n + (i & 3); }

struct Unit { int pm, pn; };
struct Gemm { const bf16_t* A; const bf16_t* Bt; int M, N, K; };

struct StaticOrder {
    int nM, nN, nwg, G, c;
    __host__ __device__ void init(int M, int N, int G_, int c_) { nM = M / BM; nN = N / BM; nwg = nM * nN; G = G_; c = c_; }
    __host__ __device__ bool next(int i, Unit& u) const {
        const long L = (long)i * G + c; if (L >= nwg) return false;
        int wgid = (int)L; { const int q = nwg / NXCD, r = nwg % NXCD, xcd = wgid % NXCD, off = wgid / NXCD; wgid = (xcd < r ? xcd * (q + 1) : r * (q + 1) + (xcd - r) * q) + off; }
        const int nig = WGM * nN, gid = wgid / nig, fm = gid * WGM, gsz = (nM - fm) < WGM ? (nM - fm) : WGM;
        u.pm = fm + ((wgid % nig) % gsz); u.pn = (wgid % nig) / gsz; return true;
    }
    __device__ __forceinline__ void a_ready(const Unit&) const {}
    __device__ __forceinline__ void done(const Unit&) const {}
};

__device__ __forceinline__ unsigned cvt_pk_bf16(float lo, float hi) { unsigned r; asm volatile("v_cvt_pk_bf16_f32 %0, %1, %2" : "=v"(r) : "v"(lo), "v"(hi)); return r; }
__device__ __forceinline__ float bflo(unsigned w) { return __uint_as_float(w << 16); }
__device__ __forceinline__ float bfhi(unsigned w) { return __uint_as_float(w & 0xffff0000u); }
__device__ __forceinline__ float rstd_of(float ss) { return rsqrtf(ss * (1.0f / 1024.0f) + 1e-6f); }
__device__ __forceinline__ float sigm(float x) { return 1.0f / (1.0f + __expf(-x)); }
typedef unsigned u32x2 __attribute__((ext_vector_type(2)));

template <int mode> struct EpiAny {
    static constexpr bool PERM = true, AFTER_DRAIN = false;
    bf16_t* O; int ldc; const bf16_t* Z; const float* ssq_in; const float* base; float* outf; float* ssq_out; bf16_t* O2; int ldc2, split; int dry;
    __device__ __forceinline__ void operator()(const f32x4 (&acc)[2][2][4][2], const Unit& u, int wr, int wc, int fr, int fq) const {
        const int row0 = u.pm * BM + wr * 64 + fr, col0 = u.pn * BM + wc * 32 + 8 * fq;
#ifdef PROBE_REPEAT
        if (dry) { asm volatile("" :: "v"(acc[0][0][0][0][0]), "v"(acc[1][1][3][1][3])); return; }
#endif
        if (mode == 6) {
            float rs[2][8];
#pragma unroll
            for (int bj = 0; bj < 2; ++bj) { const f32x4 s0 = *(const f32x4*)(ssq_in + col0 + bj * HALF), s1 = *(const f32x4*)(ssq_in + col0 + bj * HALF + 4);
#pragma unroll
                for (int e = 0; e < 4; ++e) { rs[bj][e] = rstd_of(s0[e]); rs[bj][4 + e] = rstd_of(s1[e]); } }
#pragma unroll
            for (int ai = 0; ai < 2; ++ai)
#pragma unroll
                for (int m = 0; m < 4; ++m) {
                    const int row = row0 + ai * HALF + m * 16; bf16_t* rowp = O + (size_t)row * ldc + col0;
#pragma unroll
                    for (int bj = 0; bj < 2; ++bj) {
                        const f32x4 v0 = acc[ai][bj][m][0], v1 = acc[ai][bj][m][1];
                        u32x4 w; w.x = cvt_pk_bf16(v0[0] * rs[bj][0], v0[1] * rs[bj][1]); w.y = cvt_pk_bf16(v0[2] * rs[bj][2], v0[3] * rs[bj][3]);
                        w.z = cvt_pk_bf16(v1[0] * rs[bj][4], v1[1] * rs[bj][5]); w.w = cvt_pk_bf16(v1[2] * rs[bj][6], v1[3] * rs[bj][7]);
                        *(u32x4*)(rowp + bj * HALF) = w;
                    }
                }
        } else if (mode <= 1) {
            bf16_t* ob = O; int ld = ldc, cc = col0;
            if (mode == 0 && u.pn * BM >= split) { ob = O2; ld = ldc2; cc = col0 - split; }
#pragma unroll
            for (int ai = 0; ai < 2; ++ai)
#pragma unroll
                for (int m = 0; m < 4; ++m) {
                    const int row = row0 + ai * HALF + m * 16; const float rs = rstd_of(ssq_in[row]);
                    bf16_t* rowp = ob + (size_t)row * ld + cc;
#pragma unroll
                    for (int bj = 0; bj < 2; ++bj) {
                        f32x4 v0 = acc[ai][bj][m][0] * rs, v1 = acc[ai][bj][m][1] * rs;
                        if (mode == 1) {
#pragma unroll
                            for (int e = 0; e < 4; ++e) { const float a = fmaxf(v0[e], 0.f), b = fmaxf(v1[e], 0.f); v0[e] = a * a; v1[e] = b * b; }
                        }
                        u32x4 w; w.x = cvt_pk_bf16(v0[0], v0[1]); w.y = cvt_pk_bf16(v0[2], v0[3]); w.z = cvt_pk_bf16(v1[0], v1[1]); w.w = cvt_pk_bf16(v1[2], v1[3]);
                        *(u32x4*)(rowp + bj * HALF) = w;
                    }
                }
        } else if (mode == 2) {
#pragma unroll
            for (int ai = 0; ai < 2; ++ai)
#pragma unroll
                for (int m = 0; m < 4; ++m) {
                    const int row = row0 + ai * HALF + m * 16; bf16_t* rowp = O + (size_t)row * ldc + col0;
#pragma unroll
                    for (int bj = 0; bj < 2; ++bj) {
                        const f32x4 v0 = acc[ai][bj][m][0], v1 = acc[ai][bj][m][1];
                        u32x4 w; w.x = cvt_pk_bf16(v0[0], v0[1]); w.y = cvt_pk_bf16(v0[2], v0[3]); w.z = cvt_pk_bf16(v1[0], v1[1]); w.w = cvt_pk_bf16(v1[2], v1[3]);
                        *(u32x4*)(rowp + bj * HALF) = w;
                    }
                }
        } else if (mode <= 4) {
#pragma unroll
            for (int ai = 0; ai < 2; ++ai)
#pragma unroll
                for (int m = 0; m < 4; ++m) {
                    const int row = row0 + ai * HALF + m * 16; const float rs = rstd_of(ssq_in[row]);
                    bf16_t* rowp = O + (size_t)row * ldc + col0; const bf16_t* zp = Z + (size_t)row * ldc + col0;
#pragma unroll
                    for (int bj = 0; bj < 2; ++bj) {
                        const f32x4 a0 = acc[ai][bj][m][0] * rs, a1 = acc[ai][bj][m][1] * rs;
                        const u32x4 y = *(const u32x4*)(rowp + bj * HALF);
                        float yv[8] = {bflo(y.x), bfhi(y.x), bflo(y.y), bfhi(y.y), bflo(y.z), bfhi(y.z), bflo(y.w), bfhi(y.w)};
                        float gv[8] = {sigm(a0[0]), sigm(a0[1]), sigm(a0[2]), sigm(a0[3]), sigm(a1[0]), sigm(a1[1]), sigm(a1[2]), sigm(a1[3])};
                        float ov[8];
                        if (mode == 3) {
#pragma unroll
                            for (int e = 0; e < 8; ++e) ov[e] = gv[e] * yv[e];
                        } else {
                            const u32x4 z = *(const u32x4*)(zp + bj * HALF);
                            float zv[8] = {bflo(z.x), bfhi(z.x), bflo(z.y), bfhi(z.y), bflo(z.z), bfhi(z.z), bflo(z.w), bfhi(z.w)};
#pragma unroll
                            for (int e = 0; e < 8; ++e) ov[e] = yv[e] + gv[e] * zv[e];
                        }
                        u32x4 w; w.x = cvt_pk_bf16(ov[0], ov[1]); w.y = cvt_pk_bf16(ov[2], ov[3]); w.z = cvt_pk_bf16(ov[4], ov[5]); w.w = cvt_pk_bf16(ov[6], ov[7]);
                        *(u32x4*)(rowp + bj * HALF) = w;
                    }
                }
        } else {
#pragma unroll
            for (int ai = 0; ai < 2; ++ai)
#pragma unroll
                for (int m = 0; m < 4; ++m) {
                    const int row = row0 + ai * HALF + m * 16; const size_t off = (size_t)row * ldc + col0; float s = 0.f;
#pragma unroll
                    for (int bj = 0; bj < 2; ++bj) {
                        f32x4 b0, b1;
                        if (mode == 5) { b0 = *(const f32x4*)(base + off + bj * HALF); b1 = *(const f32x4*)(base + off + bj * HALF + 4); }
                        else { const u32x4 y = *(const u32x4*)(O + off + bj * HALF); b0 = (f32x4){bflo(y.x), bfhi(y.x), bflo(y.y), bfhi(y.y)}; b1 = (f32x4){bflo(y.z), bfhi(y.z), bflo(y.w), bfhi(y.w)}; }
                        const f32x4 o0 = b0 + acc[ai][bj][m][0], o1 = b1 + acc[ai][bj][m][1];
                        if (mode == 8) { *(f32x4*)(outf + off + bj * HALF) = o0; *(f32x4*)(outf + off + bj * HALF + 4) = o1; }
                        else { u32x4 w; w.x = cvt_pk_bf16(o0[0], o0[1]); w.y = cvt_pk_bf16(o0[2], o0[3]); w.z = cvt_pk_bf16(o1[0], o1[1]); w.w = cvt_pk_bf16(o1[2], o1[3]);
                            *(u32x4*)(O + off + bj * HALF) = w; }
                        s += (o0[0] * o0[0] + o0[1] * o0[1]) + (o0[2] * o0[2] + o0[3] * o0[3]) + (o1[0] * o1[0] + o1[1] * o1[1]) + (o1[2] * o1[2] + o1[3] * o1[3]);
                    }
                    s += __shfl_xor(s, 16); s += __shfl_xor(s, 32);
                    if (fq == 0) atomicAdd(ssq_out + row, s);
                }
        }
    }
};

template <class Epi, class Sched, bool ALIGN_EPI = false, bool SP2 = false>
__device__ __forceinline__ void gemm_phase(PG8_LAS unsigned char* lds, const Gemm g, const Sched& S, const Epi& E) {
    int tid_ = threadIdx.x; asm volatile("" : "+v"(tid_));
    const int tid = tid_, wid = __builtin_amdgcn_readfirstlane(tid >> 6), lane = tid & 63, wr = wid >> 2, wc = wid & 3, fr = lane & 15, fq = lane >> 4;
    const int K = g.K, nt = K / BK;
    unsigned voffA[2], voffB[2];
#pragma unroll
    for (int i = 0; i < 2; ++i) { int R, C; stage_rc(tid * 16 + i * 8192, R, C); const int Rb = Epi::PERM ? ((R & ~31) + perm32(R & 31)) : R;
        voffA[i] = (unsigned)(R * K + C) * 2u; voffB[i] = (unsigned)(Rb * K + C) * 2u; }
    const size_t kstep = (size_t)(BK * 2);
    const size_t hstep = (size_t)HALF * K * 2;
    const size_t tstep = 2 * hstep;
    const unsigned ldsw = (unsigned)wid * 1024u;
    const int aoff = lds_byte(wr * 64 + fr, fq * 8), boff = lds_byte(wc * 32 + fr, fq * 8);
#define PG8_SA(b, h) (((b) * 2 + (h)) * HTB)
#define PG8_SB(b, h) ((4 + (b) * 2 + (h)) * HTB)
#define PG8_STAGE(bufoff, gbase, voff) do { _Pragma("unroll") for (int _i = 0; _i < 2; ++_i) \
        __builtin_amdgcn_global_load_lds((const unsigned*)((const char*)(gbase) + (voff)[_i]), (PG8_LAS unsigned*)(lds + (bufoff) + ldsw + _i * 8192), 16, 0, 0); } while (0)
#define PG8_LDA(dst, b, h) do { _Pragma("unroll") for (int m = 0; m < 4; ++m) _Pragma("unroll") for (int k = 0; k < 2; ++k) dst[m][k] = *(const PG8_LAS bf16x8*)(lds + PG8_SA(b, h) + aoff + m * 2048 + k * 1024); } while (0)
#define PG8_LDB(dst, b, h) do { _Pragma("unroll") for (int n = 0; n < 2; ++n) _Pragma("unroll") for (int k = 0; k < 2; ++k) dst[n][k] = *(const PG8_LAS bf16x8*)(lds + PG8_SB(b, h) + boff + n * 2048 + k * 1024); } while (0)
#define PG8_MMA(ai, bj, At, Bt) do { __builtin_amdgcn_s_setprio(1); _Pragma("unroll") for (int m = 0; m < 4; ++m) _Pragma("unroll") for (int n = 0; n < 2; ++n) _Pragma("unroll") for (int k = 0; k < 2; ++k) \
        acc[ai][bj][m][n] = __builtin_amdgcn_mfma_f32_16x16x32_bf16(Bt[n][k], At[m][k], acc[ai][bj][m][n], 0, 0, 0); __builtin_amdgcn_s_setprio(0); } while (0)
#define PG8_WAIT_V(n) asm volatile("s_waitcnt vmcnt(" #n ")" ::: "memory")
#define PG8_WAIT_L(n) asm volatile("s_waitcnt lgkmcnt(" #n ")" ::: "memory")
#define PG8_BAR __builtin_amdgcn_s_barrier()
#define PG8_SCHED __builtin_amdgcn_sched_barrier(0)
    Unit cur, nxt; int ui = 0;
    if (!S.next(0, cur)) return;
    f32x4 acc[2][2][4][2];
#pragma unroll
    for (int a = 0; a < 2; ++a)
#pragma unroll
        for (int b = 0; b < 2; ++b)
#pragma unroll
            for (int m = 0; m < 4; ++m)
#pragma unroll
                for (int n = 0; n < 2; ++n) acc[a][b][m][n] = (f32x4){0.f, 0.f, 0.f, 0.f};
    bf16x8 At[4][2], B0[2][2], B1[2][2];
    const char* cA = (const char*)g.A + (size_t)cur.pm * tstep; const char* cB = (const char*)g.Bt + (size_t)cur.pn * tstep;
    S.a_ready(cur);
    if constexpr (SP2) {
        PG8_STAGE(PG8_SB(0, 0), cB, voffB); PG8_STAGE(PG8_SB(0, 1), cB + hstep, voffB); PG8_STAGE(PG8_SA(0, 0), cA, voffA); PG8_STAGE(PG8_SA(0, 1), cA + hstep, voffA);
        if (wr == 1) PG8_BAR;
        PG8_WAIT_V(2); PG8_BAR;
        PG8_STAGE(PG8_SB(1, 0), cB + kstep, voffB); PG8_STAGE(PG8_SA(1, 0), cA + kstep, voffA); PG8_STAGE(PG8_SB(1, 1), cB + hstep + kstep, voffB);
        PG8_WAIT_V(6); PG8_BAR;
    } else {
        PG8_STAGE(PG8_SB(0, 0), cB, voffB); PG8_STAGE(PG8_SA(0, 0), cA, voffA); PG8_STAGE(PG8_SB(0, 1), cB + hstep, voffB); PG8_STAGE(PG8_SA(0, 1), cA + hstep, voffA);
        if (wr == 1) PG8_BAR;
        PG8_WAIT_V(4); PG8_BAR;
        PG8_STAGE(PG8_SB(1, 0), cB + kstep, voffB); PG8_STAGE(PG8_SA(1, 0), cA + kstep, voffA); PG8_STAGE(PG8_SB(1, 1), cB + hstep + kstep, voffB);
        PG8_WAIT_V(6); PG8_BAR;
    }
    for (;;) {
        const bool has_next = S.next(ui + 1, nxt);
        const char* nA = has_next ? (const char*)g.A + (size_t)nxt.pm * tstep : cA; const char* nB = has_next ? (const char*)g.Bt + (size_t)nxt.pn * tstep : cB;
        for (int t = 0; t < nt; t += 2) {
            const bool last = (t == nt - 2);
            const char* a1 = cA + (size_t)(t + 1) * kstep;
            const char* a2 = last ? nA : cA + (size_t)(t + 2) * kstep; const char* b2 = last ? nB : cB + (size_t)(t + 2) * kstep;
            const char* a3 = a2 + kstep; const char* b3 = b2 + kstep;
            if (last && has_next) S.a_ready(nxt);
            if constexpr (SP2) {
            PG8_LDB(B0, 0, 0); PG8_LDB(B1, 0, 1); PG8_SCHED; PG8_LDA(At, 0, 0); PG8_STAGE(PG8_SA(1, 1), a1 + hstep, voffA);
            PG8_WAIT_V(8); PG8_WAIT_L(0); PG8_BAR; PG8_MMA(0, 0, At, B0); PG8_MMA(0, 1, At, B1); PG8_BAR; PG8_SCHED;
            PG8_LDA(At, 0, 1); PG8_STAGE(PG8_SB(0, 0), b2, voffB); PG8_STAGE(PG8_SB(0, 1), b2 + hstep, voffB); PG8_STAGE(PG8_SA(0, 0), a2, voffA);
            PG8_WAIT_V(8); PG8_WAIT_L(0); PG8_BAR; PG8_MMA(1, 0, At, B0); PG8_MMA(1, 1, At, B1); PG8_BAR; PG8_SCHED;
            PG8_LDB(B0, 1, 0); PG8_LDB(B1, 1, 1); PG8_SCHED; PG8_LDA(At, 1, 0); PG8_STAGE(PG8_SA(0, 1), a2 + hstep, voffA);
            PG8_WAIT_V(8); PG8_WAIT_L(0); PG8_BAR; PG8_MMA(0, 0, At, B0); PG8_MMA(0, 1, At, B1); PG8_BAR; PG8_SCHED;
            PG8_LDA(At, 1, 1); PG8_STAGE(PG8_SB(1, 0), b3, voffB); PG8_STAGE(PG8_SB(1, 1), b3 + hstep, voffB); PG8_STAGE(PG8_SA(1, 0), a3, voffA);
            PG8_WAIT_V(8); PG8_WAIT_L(0); PG8_BAR; PG8_MMA(1, 0, At, B0); PG8_MMA(1, 1, At, B1); PG8_BAR; PG8_SCHED;
            } else {
            PG8_LDB(B0, 0, 0); PG8_SCHED; PG8_LDA(At, 0, 0); PG8_STAGE(PG8_SA(1, 1), a1 + hstep, voffA);
            PG8_WAIT_L(8); PG8_BAR; PG8_WAIT_L(0); PG8_MMA(0, 0, At, B0); PG8_BAR; PG8_SCHED;
            PG8_LDB(B1, 0, 1); PG8_STAGE(PG8_SB(0, 0), b2, voffB);
            PG8_BAR; PG8_WAIT_L(0); PG8_MMA(0, 1, At, B1); PG8_BAR;
            PG8_LDA(At, 0, 1); PG8_STAGE(PG8_SA(0, 0), a2, voffA);
            PG8_BAR; PG8_WAIT_L(0); PG8_MMA(1, 0, At, B0); PG8_BAR; PG8_SCHED;
            PG8_STAGE(PG8_SB(0, 1), b2 + hstep, voffB);
            PG8_WAIT_V(6); PG8_BAR; PG8_MMA(1, 1, At, B1); PG8_BAR;
            PG8_LDB(B0, 1, 0); PG8_SCHED; PG8_LDA(At, 1, 0); PG8_STAGE(PG8_SA(0, 1), a2 + hstep, voffA);
            PG8_WAIT_L(8); PG8_BAR; PG8_WAIT_L(0); PG8_MMA(0, 0, At, B0); PG8_BAR; PG8_SCHED;
            PG8_LDB(B1, 1, 1); PG8_STAGE(PG8_SB(1, 0), b3, voffB);
            PG8_BAR; PG8_WAIT_L(0); PG8_MMA(0, 1, At, B1); PG8_BAR;
            PG8_LDA(At, 1, 1); PG8_STAGE(PG8_SA(1, 0), a3, voffA);
            PG8_BAR; PG8_WAIT_L(0); PG8_MMA(1, 0, At, B0); PG8_BAR; PG8_SCHED;
            PG8_STAGE(PG8_SB(1, 1), b3 + hstep, voffB);
            PG8_WAIT_V(6); PG8_BAR; PG8_MMA(1, 1, At, B1); PG8_BAR;
            }
        }
        if constexpr (ALIGN_EPI) { if (wr == 0) PG8_BAR; }
        if constexpr (!Epi::AFTER_DRAIN) { E(acc, cur, wr, wc, fr, fq); S.done(cur); }
        if (!has_next) break;
#pragma unroll
        for (int a = 0; a < 2; ++a)
#pragma unroll
            for (int b = 0; b < 2; ++b)
#pragma unroll
                for (int m = 0; m < 4; ++m)
#pragma unroll
                    for (int n = 0; n < 2; ++n) acc[a][b][m][n] = (f32x4){0.f, 0.f, 0.f, 0.f};
        cur = nxt; cA = nA; cB = nB; ++ui;
        if constexpr (ALIGN_EPI) { if (wr == 1) PG8_BAR; }
    }
    PG8_WAIT_V(0);
    if constexpr (!ALIGN_EPI) { if (wr == 0) PG8_BAR; }
    PG8_BAR;
    if constexpr (Epi::AFTER_DRAIN) { E.fused(acc, cur, wr, wc, fr, fq, lds, wid, lane); S.done(cur); }
#undef PG8_SA
#undef PG8_SB
#undef PG8_STAGE
#undef PG8_LDA
#undef PG8_LDB
#undef PG8_MMA
#undef PG8_WAIT_V
#undef PG8_WAIT_L
#undef PG8_BAR
#undef PG8_SCHED
}
}
#define GAS __attribute__((address_space(1)))
#define LAS __attribute__((address_space(3)))
typedef unsigned short bf16;
typedef unsigned v4u __attribute__((ext_vector_type(4)));
typedef float f32x4 __attribute__((ext_vector_type(4)));
#define LDS_WAIT() asm volatile("s_waitcnt lgkmcnt(0)" ::: "memory")

#ifndef FAST_ATTN
#define FAST_ATTN 1
#endif
#ifndef FAST_LOCAL
#define FAST_LOCAL 1
#endif
#ifndef FAST_OUT
#define FAST_OUT 1
#endif
#ifndef MK_ONE_LAUNCH
#define MK_ONE_LAUNCH 1
#endif

constexpr int M = 16384, DM = 1024, SEQ = 4096, NCHK = 64, CHK = 64, DFF = 4096, DIN_SRC = 5640;
constexpr int LD1 = 1024, LD2 = 1536, N2_MQ = 0, N2_MO = 512, N2_MK = 1024, T_MK = 0, T_AV = 512, T_MV = 1024;
constexpr int NUNIT = 1024;
constexpr float EPS = 1e-6f;

constexpr size_t MiB = 1u << 20;
constexpr size_t WS_CTL = 0, CTL_ZERO_BYTES = 1 * MiB;
constexpr size_t WS_SSQ = 1 * MiB;
constexpr size_t WS_WG = 1 * MiB + 320 * 1024;
constexpr size_t WS_GATES = 1 * MiB + 512 * 1024;
constexpr size_t WS_NLOC = 2 * MiB;
constexpr size_t WS_MLOC = 2 * MiB + 512 * 1024;
constexpr size_t WS_BLAST = WS_MLOC + 4096, WS_MST = WS_BLAST + 4096;
constexpr size_t WS_W = 3 * MiB;
constexpr size_t W_IN = 0, W_A = (size_t)5632 * 1024, W_M = W_A + 512 * 1024, W_O = W_M + 512 * 1024, W_UP = W_O + 1024 * 1024, W_DN = W_UP + (size_t)4096 * 1024, W_END = W_DN + (size_t)4096 * 1024;
static_assert(WS_W + W_END * 2 <= 34 * MiB, "weights");
constexpr size_t WS_XB = 34 * MiB;
constexpr size_t WS_N1 = 66 * MiB;
constexpr size_t WS_N2 = 98 * MiB;
constexpr size_t WS_T = 146 * MiB;
constexpr size_t WS_MOUT = 146 * MiB;
constexpr size_t WS_Y = 162 * MiB;
constexpr size_t WS_Z = 66 * MiB;
constexpr size_t WS_ATT = 194 * MiB;
constexpr size_t WS_CLOC = 210 * MiB;
constexpr size_t WS_H = 66 * MiB;
constexpr size_t WS_END = 242 * MiB;

constexpr int RING_BYTES = 131072, LDSCTL_OFF = RING_BYTES, MISC_OFF = LDSCTL_OFF + 320, LDS_BYTES = 147456;
constexpr int CW_BAR = 4096;

__device__ __forceinline__ unsigned f2bf(float f) { unsigned u = __builtin_bit_cast(unsigned, f); return (u + 0x7fffu + ((u >> 16) & 1u)) >> 16; }
__device__ __forceinline__ unsigned pk2(float lo, float hi) { return f2bf(lo) | (f2bf(hi) << 16); }
__device__ __forceinline__ float bf2f(bf16 v) { return __uint_as_float(((unsigned)v) << 16); }
__device__ __forceinline__ float blo(unsigned w) { return __uint_as_float(w << 16); }
__device__ __forceinline__ float bhi(unsigned w) { return __uint_as_float(w & 0xffff0000u); }
__device__ __forceinline__ float sigmf(float x) { return 1.0f / (1.0f + __expf(-x)); }
__device__ __forceinline__ float wave_sum(float v) {
#pragma unroll
    for (int o = 1; o < 64; o <<= 1) v += __shfl_xor(v, o);
    return v;
}

__device__ __forceinline__ int win_src_col(int n0) {
    if (n0 >= 3584) return n0 + 8;
    const int blk = n0 >> 9; const int st = blk == 0 ? 0 : blk == 1 ? 512 : blk == 2 ? 1536 : blk == 3 ? 3072 : blk == 4 ? 2048 : blk == 5 ? 1024 : 2560;
    return st + (n0 & 511);
}
__device__ __forceinline__ void transpose_item(const float* W, int ldw, int is_win, const float* g, bf16* WT, int K, int nblk, LAS float* scr, int item, int lane) {
    const int kb = item / nblk, nb = item % nblk, k0 = 64 * kb, n0 = 32 * nb, sc0 = is_win ? win_src_col(n0) : n0;
    float tv[32];
#pragma unroll
    for (int i = 0; i < 32; ++i) { const int kk = 2 * i + (lane >> 5); tv[i] = W[(size_t)(k0 + kk) * ldw + sc0 + (lane & 31)]; }
#pragma unroll
    for (int i = 0; i < 32; ++i) { const int kk = 2 * i + (lane >> 5); const float gv = g ? g[k0 + kk] : 1.0f; scr[kk * 33 + (lane & 31)] = tv[i] * gv; }
    LDS_WAIT(); asm volatile("" ::: "memory");
    const int c = lane & 7;
#pragma unroll
    for (int j = 0; j < 4; ++j) { const int n = (lane >> 3) + 8 * j; const LAS float* s = scr + (8 * c) * 33 + n;
        v4u o; o.x = pk2(s[0 * 33], s[1 * 33]); o.y = pk2(s[2 * 33], s[3 * 33]); o.z = pk2(s[4 * 33], s[5 * 33]); o.w = pk2(s[6 * 33], s[7 * 33]);
        *(v4u*)(WT + (size_t)(n0 + n) * K + k0 + 8 * c) = o; }
    LDS_WAIT(); asm volatile("" ::: "memory");
}

__device__ __forceinline__ f32x4 ld_bf4(const bf16* p) { const unsigned long long w = *(const unsigned long long*)p; return (f32x4){blo((unsigned)w), bhi((unsigned)w), blo((unsigned)(w >> 32)), bhi((unsigned)(w >> 32))}; }
__device__ __forceinline__ void gates_phase(const float* x, const bf16* xbf, int layer, const float* wg, const float* bi, const float* bf_, float* gates, LAS float* ldsf, int bid, int tid) {
    constexpr int XP = 132, WP = 1028;
    LAS float* WS = ldsf; LAS float* XS = ldsf + 8 * WP;
    for (int i = tid; i < 8 * 256; i += 512) { const int g = i >> 8, k4 = i & 255; *(LAS f32x4*)(WS + g * WP + 4 * k4) = *(const f32x4*)(wg + g * 1024 + 4 * k4); }
    const int lr = tid >> 5, lc = tid & 31, row = tid >> 3, gate = tid & 7, lane = tid & 63;
    for (int rb = bid; rb < M / 64; rb += 256) {
        const float* xb0 = x + (size_t)rb * 64 * DM; const bf16* xh0 = xbf + (size_t)rb * 64 * DM;
#define GLOAD(i, kc_) (layer == 0 ? *(const f32x4*)(xb0 + (size_t)(lr + 16 * (i)) * DM + (kc_) * 128 + 4 * lc) : ld_bf4(xh0 + (size_t)(lr + 16 * (i)) * DM + (kc_) * 128 + 4 * lc))
        f32x4 pre[4];
#pragma unroll
        for (int i = 0; i < 4; ++i) pre[i] = GLOAD(i, 0);
        float acc = 0.f, ss = 0.f;
        for (int kc = 0; kc < 8; ++kc) {
            __syncthreads();
#pragma unroll
            for (int i = 0; i < 4; ++i) *(LAS f32x4*)(XS + (lr + 16 * i) * XP + 4 * lc) = pre[i];
            if (kc + 1 < 8) {
#pragma unroll
                for (int i = 0; i < 4; ++i) pre[i] = GLOAD(i, kc + 1);
            }
            __syncthreads();
            const LAS float* xr = XS + row * XP; const LAS float* wr = WS + gate * WP + kc * 128;
#pragma unroll 8
            for (int k4 = 0; k4 < 32; ++k4) { const f32x4 xv = *(const LAS f32x4*)(xr + 4 * k4), wv = *(const LAS f32x4*)(wr + 4 * k4);
                acc += (xv.x * wv.x + xv.y * wv.y) + (xv.z * wv.z + xv.w * wv.w); ss += (xv.x * xv.x + xv.y * xv.y) + (xv.z * xv.z + xv.w * xv.w); }
        }
        const float rs = rsqrtf(ss * (1.0f / 1024.0f) + EPS);
        float val = acc * rs + (gate < 4 ? bi[gate] : bf_[gate - 4]);
        if (gate >= 4) val = fminf(val, 0.f) - log1pf(__expf(-fabsf(val)));
        gates[((size_t)rb * 64 + row) * 8 + gate] = val;
    }
#undef GLOAD
    __syncthreads();
}

__device__ __forceinline__ void attn_naive(const bf16* n1, const bf16* tT, const float* relb, bf16* att, int bid, int G, int wave, int lane) {
    for (int unit = bid; unit < 256; unit += G) {
        const int b = unit >> 6, c = unit & 63, h = wave, t = lane;
        const size_t tok = (size_t)b * SEQ + c * CHK + t;
        float q[64], acc[64];
        { const v4u* qp = (const v4u*)(n1 + tok * LD1 + h * 64);
#pragma unroll
          for (int i = 0; i < 8; ++i) { const v4u w = qp[i]; q[8 * i + 0] = blo(w.x) * 0.125f; q[8 * i + 1] = bhi(w.x) * 0.125f; q[8 * i + 2] = blo(w.y) * 0.125f; q[8 * i + 3] = bhi(w.y) * 0.125f;
              q[8 * i + 4] = blo(w.z) * 0.125f; q[8 * i + 5] = bhi(w.z) * 0.125f; q[8 * i + 6] = blo(w.w) * 0.125f; q[8 * i + 7] = bhi(w.w) * 0.125f; } }
#pragma unroll
        for (int d = 0; d < 64; ++d) acc[d] = 0.f;
        float mx = -1e30f, l = 0.f;
        const float* bh = relb + h * 513;
        for (int j = (c >= 8 ? 0 : 8 - c); j <= 8; ++j) {
            const size_t ktok0 = (size_t)b * SEQ + (size_t)(c - 8 + j) * CHK;
            for (int u = 0; u < 64; ++u) {
                int uo = u; asm volatile("" : "+v"(uo));
                const bf16* rowp = n1 + (ktok0 + uo) * LD1 + h * 64;
                const v4u* kp = (const v4u*)(rowp + 512); float s = 0.f;
#pragma unroll
                for (int i = 0; i < 8; ++i) { const v4u w = kp[i];
                    s += q[8 * i + 0] * blo(w.x) + q[8 * i + 1] * bhi(w.x) + q[8 * i + 2] * blo(w.y) + q[8 * i + 3] * bhi(w.y) + q[8 * i + 4] * blo(w.z) + q[8 * i + 5] * bhi(w.z) + q[8 * i + 6] * blo(w.w) + q[8 * i + 7] * bhi(w.w); }
                int rel = t - u + 64 * (8 - j); rel = rel < -256 ? -256 : (rel > 256 ? 256 : rel);
                s += bh[rel + 256];
                if (s > mx) { const float corr = __expf(mx - s); l *= corr;
#pragma unroll
                    for (int d = 0; d < 64; ++d) acc[d] *= corr;
                    mx = s; }
                const float p = __expf(s - mx); l += p;
                const bf16* vp = tT + (size_t)(T_AV + h * 64) * M + (ktok0 + uo);
#pragma unroll
                for (int d = 0; d < 64; ++d) acc[d] += p * bf2f(vp[(size_t)d * M]);
            }
        }
        const float inv = 1.0f / l;
        v4u* op = (v4u*)(att + tok * 512 + h * 64);
#pragma unroll
        for (int i = 0; i < 8; ++i) { v4u o; o.x = pk2(acc[8 * i + 0] * inv, acc[8 * i + 1] * inv); o.y = pk2(acc[8 * i + 2] * inv, acc[8 * i + 3] * inv); o.z = pk2(acc[8 * i + 4] * inv, acc[8 * i + 5] * inv); o.w = pk2(acc[8 * i + 6] * inv, acc[8 * i + 7] * inv); op[i] = o; }
    }
}

typedef short bf16x8_t __attribute__((ext_vector_type(8)));
typedef float f32x16_t __attribute__((ext_vector_type(16)));
typedef float f32x2_t __attribute__((ext_vector_type(2))); typedef __bf16 bf16x2_t __attribute__((ext_vector_type(2)));
__device__ __forceinline__ unsigned cvtpk(float lo, float hi) { f32x2_t v = {lo, hi}; bf16x2_t b = __builtin_convertvector(v, bf16x2_t); return __builtin_bit_cast(unsigned, b); }
__device__ __forceinline__ void attn_mfma(const bf16* n1, const bf16* tT, const float* relb, bf16* att, LAS float* ldsf, int bid, int G, int wave, int lane) {
    constexpr float LOG2E = 1.4426950408889634f, SC = 0.125f * LOG2E;
    const int h = wave, r32 = lane & 31, hi = lane >> 5;
    LAS float* ext = ldsf + wave * 384;
    for (int r = lane; r < 384; r += 64) { const int rel = r - 63; const int idx = (rel > 256 ? 256 : rel) + 256; ext[r] = relb[h * 513 + idx] * LOG2E; }
    const float bconst = relb[h * 513 + 512] * LOG2E;
    LDS_WAIT();
    const int pir = (r32 & ~12) | ((r32 & 4) << 1) | ((r32 & 8) >> 1);
    for (int unit = bid; unit < 256; unit += G) {
        const int b = unit >> 6, c = unit & 63; const size_t tq0 = (size_t)b * SEQ + c * CHK;
        bf16x8_t qf[2][4];
#pragma unroll
        for (int qb = 0; qb < 2; ++qb)
#pragma unroll
            for (int s = 0; s < 4; ++s) qf[qb][s] = *(const bf16x8_t*)(n1 + (tq0 + qb * 32 + r32) * LD1 + h * 64 + 32 * hi + 8 * s);
        f32x16_t o[2][2];
#pragma unroll
        for (int qb = 0; qb < 2; ++qb)
#pragma unroll
            for (int db = 0; db < 2; ++db)
#pragma unroll
                for (int i = 0; i < 16; ++i) o[qb][db][i] = 0.f;
        float mrun[2] = {-1e30f, -1e30f}, lrun[2] = {0.f, 0.f};
        const int kb0 = (c >= 8 ? 0 : 8 - c) * 2;
        bf16x8_t kf[4], vf[2][2];
        { const size_t ktok = (size_t)b * SEQ + (size_t)(c - 8) * CHK + (size_t)kb0 * 32;
#pragma unroll
          for (int s = 0; s < 4; ++s) kf[s] = *(const bf16x8_t*)(n1 + (ktok + pir) * LD1 + 512 + h * 64 + 32 * hi + 8 * s);
#pragma unroll
          for (int db = 0; db < 2; ++db)
#pragma unroll
              for (int s2 = 0; s2 < 2; ++s2) vf[db][s2] = *(const bf16x8_t*)(tT + (size_t)(T_AV + h * 64 + db * 32 + r32) * M + ktok + 16 * s2 + 8 * hi); }
        for (int kbI = kb0; kbI < 18; ++kbI) {
            const int j = kbI >> 1, kb = kbI & 1;
            bf16x8_t kn[4], vn[2][2];
            { const int nx = kbI + 1 < 18 ? kbI + 1 : 17; const size_t ktok = (size_t)b * SEQ + (size_t)(c - 8) * CHK + (size_t)nx * 32;
#pragma unroll
              for (int s = 0; s < 4; ++s) kn[s] = *(const bf16x8_t*)(n1 + (ktok + pir) * LD1 + 512 + h * 64 + 32 * hi + 8 * s);
#pragma unroll
              for (int db = 0; db < 2; ++db)
#pragma unroll
                  for (int s2 = 0; s2 < 2; ++s2) vn[db][s2] = *(const bf16x8_t*)(tT + (size_t)(T_AV + h * 64 + db * 32 + r32) * M + ktok + 16 * s2 + 8 * hi); }
#pragma unroll
            for (int qb = 0; qb < 2; ++qb) {
                f32x16_t sa;
#pragma unroll
                for (int i = 0; i < 16; ++i) sa[i] = 0.f;
#pragma unroll
                for (int s = 0; s < 4; ++s) sa = __builtin_amdgcn_mfma_f32_32x32x16_bf16(kf[s], qf[qb][s], sa, 0, 0, 0);
                float sv[16];
                if (j >= 4) {
                    const int rbase = (qb * 32 + r32) - (kb * 32 + 8 * hi) + 64 * (8 - j) + 63;
#pragma unroll
                    for (int i = 0; i < 16; ++i) sv[i] = sa[i] * SC + ext[rbase - (i & 7) - 16 * (i >> 3)];
                } else {
#pragma unroll
                    for (int i = 0; i < 16; ++i) sv[i] = sa[i] * SC + bconst;
                }
                float mx = sv[0];
#pragma unroll
                for (int i = 1; i < 16; ++i) mx = fmaxf(mx, sv[i]);
                mx = fmaxf(mx, __shfl_xor(mx, 32));
                const float mnew = fmaxf(mrun[qb], mx), alpha = __builtin_amdgcn_exp2f(mrun[qb] - mnew); mrun[qb] = mnew;
                float ps = 0.f;
#pragma unroll
                for (int i = 0; i < 16; ++i) { sv[i] = __builtin_amdgcn_exp2f(sv[i] - mnew); ps += sv[i]; }
                lrun[qb] = lrun[qb] * alpha + ps;
#pragma unroll
                for (int db = 0; db < 2; ++db)
#pragma unroll
                    for (int i = 0; i < 16; ++i) o[qb][db][i] *= alpha;
                bf16x8_t pf[2];
#pragma unroll
                for (int s2 = 0; s2 < 2; ++s2) { v4u w; w.x = cvtpk(sv[8 * s2 + 0], sv[8 * s2 + 1]); w.y = cvtpk(sv[8 * s2 + 2], sv[8 * s2 + 3]); w.z = cvtpk(sv[8 * s2 + 4], sv[8 * s2 + 5]); w.w = cvtpk(sv[8 * s2 + 6], sv[8 * s2 + 7]);
                    pf[s2] = __builtin_bit_cast(bf16x8_t, w); }
#pragma unroll
                for (int db = 0; db < 2; ++db)
#pragma unroll
                    for (int s2 = 0; s2 < 2; ++s2) o[qb][db] = __builtin_amdgcn_mfma_f32_32x32x16_bf16(vf[db][s2], pf[s2], o[qb][db], 0, 0, 0);
            }
#pragma unroll
            for (int s = 0; s < 4; ++s) kf[s] = kn[s];
#pragma unroll
            for (int db = 0; db < 2; ++db)
#pragma unroll
                for (int s2 = 0; s2 < 2; ++s2) vf[db][s2] = vn[db][s2];
        }
#pragma unroll
        for (int qb = 0; qb < 2; ++qb) {
            const float lt = lrun[qb] + __shfl_xor(lrun[qb], 32), inv = 1.0f / lt;
            bf16* op = att + (tq0 + qb * 32 + r32) * 512 + h * 64 + 4 * hi;
#pragma unroll
            for (int db = 0; db < 2; ++db)
#pragma unroll
                for (int g4 = 0; g4 < 4; ++g4) { unsigned long long w = (unsigned long long)cvtpk(o[qb][db][4 * g4 + 0] * inv, o[qb][db][4 * g4 + 1] * inv) | ((unsigned long long)cvtpk(o[qb][db][4 * g4 + 2] * inv, o[qb][db][4 * g4 + 3] * inv) << 32);
                    *(unsigned long long*)(op + db * 32 + 8 * g4) = w; }
        }
    }
}

__device__ __forceinline__ float wave_max(float v) {
#pragma unroll
    for (int o = 1; o < 64; o <<= 1) v = fmaxf(v, __shfl_xor(v, o));
    return v;
}
__device__ __forceinline__ float scan_add(float v, int lane) {
#pragma unroll
    for (int o = 1; o < 64; o <<= 1) { const float t = __shfl_up(v, o); if (lane >= o) v += t; }
    return v;
}
__device__ __forceinline__ float scan_max(float v, int lane) {
#pragma unroll
    for (int o = 1; o < 64; o <<= 1) { const float t = __shfl_up(v, o); if (lane >= o) v = fmaxf(v, t); }
    return v;
}
__device__ __forceinline__ bf16x8_t pack8(const float* v) { v4u w; w.x = cvtpk(v[0], v[1]); w.y = cvtpk(v[2], v[3]); w.z = cvtpk(v[4], v[5]); w.w = cvtpk(v[6], v[7]); return __builtin_bit_cast(bf16x8_t, w); }

__device__ __forceinline__ void mlstm_local_mfma(const bf16* tT, const float* gates, const float* cw, const float* cb, bf16* cloc, float* nloc, float* mloc, float* blast, LAS float* ldsf, int bid, int G, int wave, int lane) {
    LAS float* wsm = ldsf + wave * 64;
    const int r32 = lane & 31, hi = lane >> 5;
    for (int task = bid * 8 + wave; task < 2 * NUNIT; task += G * 8) {
        const int unit = task >> 1, kh = task & 1, b = unit >> 8, c = (unit >> 2) & 63, h = unit & 3; const size_t tok0 = (size_t)b * SEQ + c * CHK;
        const float lf = gates[(tok0 + lane) * 8 + 4 + h], ig = gates[(tok0 + lane) * 8 + h];
        const float cum = scan_add(lf, lane), bl = __shfl(cum, 63), a = bl - cum + ig, mxa = wave_max(a);
        wsm[lane] = __expf(a - mxa);
        LDS_WAIT();
        if (kh == 0 && lane == 0) { mloc[unit] = mxa; blast[unit] = bl; }
        f32x16_t acc[2][4];
#pragma unroll
        for (int kb2 = 0; kb2 < 2; ++kb2)
#pragma unroll
            for (int vb = 0; vb < 4; ++vb)
#pragma unroll
                for (int i = 0; i < 16; ++i) acc[kb2][vb][i] = 0.f;
        float nsum[2] = {0.f, 0.f};
        float cwr[2][4], cbr[2];
#pragma unroll
        for (int kb2 = 0; kb2 < 2; ++kb2) { const int ch = 512 + h * 128 + kh * 64 + kb2 * 32 + r32; cbr[kb2] = cb[ch];
#pragma unroll
            for (int j = 0; j < 4; ++j) cwr[kb2][j] = cw[j * 1024 + ch]; }
#pragma unroll
        for (int s = 0; s < 4; ++s) {
            const int l0 = 16 * s + 8 * hi;
            float wv[8];
            { const f32x4 w0 = *(const LAS f32x4*)(wsm + l0), w1 = *(const LAS f32x4*)(wsm + l0 + 4); wv[0] = w0.x; wv[1] = w0.y; wv[2] = w0.z; wv[3] = w0.w; wv[4] = w1.x; wv[5] = w1.y; wv[6] = w1.z; wv[7] = w1.w; }
            bf16x8_t af[2];
#pragma unroll
            for (int kb2 = 0; kb2 < 2; ++kb2) {
                const bf16* rp = tT + (size_t)(T_MK + h * 128 + kh * 64 + kb2 * 32 + r32) * M + tok0 + l0;
                const v4u cur = *(const v4u*)rp; unsigned long long prev = *(const unsigned long long*)(rp - 4);
                if (c == 0 && l0 == 0) prev = 0ull;
                float x[11];
                x[0] = bhi((unsigned)prev); x[1] = blo((unsigned)(prev >> 32)); x[2] = bhi((unsigned)(prev >> 32));
                x[3] = blo(cur.x); x[4] = bhi(cur.x); x[5] = blo(cur.y); x[6] = bhi(cur.y); x[7] = blo(cur.z); x[8] = bhi(cur.z); x[9] = blo(cur.w); x[10] = bhi(cur.w);
                float kv[8];
#pragma unroll
                for (int j = 0; j < 8; ++j) { const float av = cbr[kb2] + cwr[kb2][0] * x[j] + cwr[kb2][1] * x[j + 1] + cwr[kb2][2] * x[j + 2] + cwr[kb2][3] * x[j + 3];
                    const float kw = av * sigmf(av) * 0.08838834764831845f * wv[j]; kv[j] = kw; nsum[kb2] += kw; }
                af[kb2] = pack8(kv);
            }
#pragma unroll
            for (int vb = 0; vb < 4; ++vb) {
                const bf16x8_t vfr = *(const bf16x8_t*)(tT + (size_t)(T_MV + h * 128 + vb * 32 + r32) * M + tok0 + l0);
#pragma unroll
                for (int kb2 = 0; kb2 < 2; ++kb2) acc[kb2][vb] = __builtin_amdgcn_mfma_f32_32x32x16_bf16(af[kb2], vfr, acc[kb2][vb], 0, 0, 0);
            }
        }
#pragma unroll
        for (int kb2 = 0; kb2 < 2; ++kb2) { const float ns = nsum[kb2] + __shfl_xor(nsum[kb2], 32); if (hi == 0) nloc[unit * 128 + kh * 64 + kb2 * 32 + r32] = ns; }
#pragma unroll
        for (int kb2 = 0; kb2 < 2; ++kb2)
#pragma unroll
            for (int vb = 0; vb < 4; ++vb) { bf16* cp = cloc + (size_t)unit * 16384 + (size_t)(vb * 32 + r32) * 128 + kh * 64 + kb2 * 32 + 4 * hi;
#pragma unroll
                for (int g4 = 0; g4 < 4; ++g4) *(unsigned long long*)(cp + 8 * g4) = (unsigned long long)cvtpk(acc[kb2][vb][4 * g4 + 0], acc[kb2][vb][4 * g4 + 1]) | ((unsigned long long)cvtpk(acc[kb2][vb][4 * g4 + 2], acc[kb2][vb][4 * g4 + 3]) << 32); }
    }
}

__device__ __forceinline__ void conv_prepass(const bf16* n2, const float* cw, const float* cb, bf16* qk, int bid, int G, int tid) {
    for (int it = bid * 512 + tid; it < (M / 16) * 128; it += G * 512) {
        const int cg = it & 127, tr = it >> 7, ch0 = 8 * cg; const size_t t0 = (size_t)tr * 16;
        const bf16* src = n2 + (ch0 < 512 ? N2_MQ + ch0 : N2_MK + (ch0 - 512));
        const float sc = ch0 < 512 ? 1.0f : 0.08838834764831845f;
        float w[4][8], bb[8];
#pragma unroll
        for (int e = 0; e < 8; ++e) { bb[e] = cb[ch0 + e];
#pragma unroll
            for (int j = 0; j < 4; ++j) w[j][e] = cw[j * 1024 + ch0 + e]; }
        float x0[8], x1[8], x2[8];
        const bool first = (t0 & (SEQ - 1)) == 0;
#pragma unroll
        for (int r = 0; r < 3; ++r) { v4u v = {0u, 0u, 0u, 0u}; if (!first) v = *(const v4u*)(src + (t0 - 3 + r) * LD2);
            float* d = r == 0 ? x0 : (r == 1 ? x1 : x2);
            d[0] = blo(v.x); d[1] = bhi(v.x); d[2] = blo(v.y); d[3] = bhi(v.y); d[4] = blo(v.z); d[5] = bhi(v.z); d[6] = blo(v.w); d[7] = bhi(v.w); }
#pragma unroll 4
        for (int i = 0; i < 16; ++i) {
            const v4u v = *(const v4u*)(src + (t0 + i) * LD2); float x3[8] = {blo(v.x), bhi(v.x), blo(v.y), bhi(v.y), blo(v.z), bhi(v.z), blo(v.w), bhi(v.w)}; float o[8];
#pragma unroll
            for (int e = 0; e < 8; ++e) { const float a = bb[e] + w[0][e] * x0[e] + w[1][e] * x1[e] + w[2][e] * x2[e] + w[3][e] * x3[e]; o[e] = a * sigmf(a) * sc; x0[e] = x1[e]; x1[e] = x2[e]; x2[e] = x3[e]; }
            v4u ov; ov.x = cvtpk(o[0], o[1]); ov.y = cvtpk(o[2], o[3]); ov.z = cvtpk(o[4], o[5]); ov.w = cvtpk(o[6], o[7]);
            *(v4u*)(qk + (t0 + i) * 1024 + ch0) = ov;
        }
    }
}

__device__ __forceinline__ void mlstm_out_mfma(const bf16* qk, const bf16* n2, const bf16* tT, const float* gates, const bf16* cst, const float* nst, const float* mst, const float* mhg, bf16* mout, LAS float* ldsf, int bid, int G, int wave, int lane) {
    LAS float* sm = ldsf + wave * 256;
    const int r32 = lane & 31, hi = lane >> 5;
    const int pir = (r32 & ~12) | ((r32 & 4) << 1) | ((r32 & 8) >> 1);
    for (int task = bid * 8 + wave; task < 2 * NUNIT; task += G * 8) {
        const int unit = task >> 1, tb = task & 1, b = unit >> 8, c = (unit >> 2) & 63, h = unit & 3; const size_t tok0 = (size_t)b * SEQ + c * CHK;
        { const float lf = gates[(tok0 + lane) * 8 + 4 + h], ig = gates[(tok0 + lane) * 8 + h];
          const float cum = scan_add(lf, lane), e = ig - cum, pm = scan_max(e, lane), g = cum + mst[unit], mt = fmaxf(g, cum + pm);
          sm[lane] = e; sm[64 + lane] = cum; sm[128 + lane] = mt; sm[192 + lane] = __expf(g - mt); }
        LDS_WAIT();
        const int t = tb * 32 + r32; const float bc_t = sm[64 + t], mt_t = sm[128 + t], in_t = sm[192 + t];
        bf16x8_t qf[8];
#pragma unroll
        for (int s = 0; s < 8; ++s) qf[s] = *(const bf16x8_t*)(qk + (tok0 + t) * 1024 + h * 128 + 64 * hi + 8 * s);
        float nq = 0.f;
#pragma unroll
        for (int s = 0; s < 8; ++s) { const f32x4 n0 = *(const f32x4*)(nst + unit * 128 + 64 * hi + 8 * s), n1 = *(const f32x4*)(nst + unit * 128 + 64 * hi + 8 * s + 4); const v4u q = __builtin_bit_cast(v4u, qf[s]);
            nq += n0.x * blo(q.x) + n0.y * bhi(q.x) + n0.z * blo(q.y) + n0.w * bhi(q.y) + n1.x * blo(q.z) + n1.y * bhi(q.z) + n1.z * blo(q.w) + n1.w * bhi(q.w); }
        nq += __shfl_xor(nq, 32);
        f32x16_t num[4];
#pragma unroll
        for (int vb = 0; vb < 4; ++vb) {
#pragma unroll
            for (int i = 0; i < 16; ++i) num[vb][i] = 0.f;
#pragma unroll
            for (int s = 0; s < 8; ++s) { const bf16x8_t cf = *(const bf16x8_t*)(cst + (size_t)unit * 16384 + (size_t)(vb * 32 + r32) * 128 + 64 * hi + 8 * s);
                num[vb] = __builtin_amdgcn_mfma_f32_32x32x16_bf16(cf, qf[s], num[vb], 0, 0, 0); }
#pragma unroll
            for (int i = 0; i < 16; ++i) num[vb][i] *= in_t;
        }
        float dsum = 0.f;
        for (int sb = 0; sb <= tb; ++sb) {
            f32x16_t sa;
#pragma unroll
            for (int i = 0; i < 16; ++i) sa[i] = 0.f;
#pragma unroll
            for (int s = 0; s < 8; ++s) { const bf16x8_t kf = *(const bf16x8_t*)(qk + (tok0 + sb * 32 + pir) * 1024 + 512 + h * 128 + 64 * hi + 8 * s);
                sa = __builtin_amdgcn_mfma_f32_32x32x16_bf16(kf, qf[s], sa, 0, 0, 0); }
            float dv[16];
#pragma unroll
            for (int hf = 0; hf < 2; ++hf) { const int sbase = sb * 32 + 16 * hf + 8 * hi;
                const f32x4 e0 = *(const LAS f32x4*)(sm + sbase), e1 = *(const LAS f32x4*)(sm + sbase + 4); const float ev[8] = {e0.x, e0.y, e0.z, e0.w, e1.x, e1.y, e1.z, e1.w};
#pragma unroll
                for (int j = 0; j < 8; ++j) { float val = sa[8 * hf + j] * __expf(bc_t - mt_t + ev[j]); val = (sbase + j > t) ? 0.f : val; dv[8 * hf + j] = val; dsum += val; } }
            bf16x8_t pf[2] = {pack8(dv), pack8(dv + 8)};
#pragma unroll
            for (int vb = 0; vb < 4; ++vb)
#pragma unroll
                for (int s2 = 0; s2 < 2; ++s2) { const bf16x8_t vfr = *(const bf16x8_t*)(tT + (size_t)(T_MV + h * 128 + vb * 32 + r32) * M + tok0 + sb * 32 + 16 * s2 + 8 * hi);
                    num[vb] = __builtin_amdgcn_mfma_f32_32x32x16_bf16(vfr, pf[s2], num[vb], 0, 0, 0); }
        }
        dsum += __shfl_xor(dsum, 32);
        const float den = in_t * nq + dsum, inv = 1.0f / fmaxf(fabsf(den), __expf(-mt_t));
        float ss = 0.f;
#pragma unroll
        for (int vb = 0; vb < 4; ++vb)
#pragma unroll
            for (int i = 0; i < 16; ++i) { const float hv = num[vb][i] * inv; num[vb][i] = hv; ss += hv * hv; }
        ss += __shfl_xor(ss, 32);
        const float rms = rsqrtf(ss * (1.0f / 128.0f) + EPS);
#pragma unroll
        for (int vb = 0; vb < 4; ++vb)
#pragma unroll
            for (int g4 = 0; g4 < 4; ++g4) { const int v0 = vb * 32 + 8 * g4 + 4 * hi;
                const unsigned long long mo = *(const unsigned long long*)(n2 + (tok0 + t) * LD2 + N2_MO + h * 128 + v0); const f32x4 gg = *(const f32x4*)(mhg + h * 128 + v0);
                const float o0 = sigmf(blo((unsigned)mo)) * num[vb][4 * g4 + 0] * rms * gg.x, o1 = sigmf(bhi((unsigned)mo)) * num[vb][4 * g4 + 1] * rms * gg.y;
                const float o2 = sigmf(blo((unsigned)(mo >> 32))) * num[vb][4 * g4 + 2] * rms * gg.z, o3 = sigmf(bhi((unsigned)(mo >> 32))) * num[vb][4 * g4 + 3] * rms * gg.w;
                *(unsigned long long*)(mout + (tok0 + t) * 512 + h * 128 + v0) = (unsigned long long)cvtpk(o0, o1) | ((unsigned long long)cvtpk(o2, o3) << 32); }
    }
}

__device__ __forceinline__ void mlstm_local_naive(const bf16* n2, const bf16* tT, const float* gates, const float* cw, const float* cb, bf16* cloc, float* nloc, float* mloc, float* blast, float* lds, int bid, int G, int tid) {
    float* KS = lds; float* WV = lds + 8192; float* sm = lds + 16384;
    for (int unit = bid; unit < NUNIT; unit += G) {
        const int b = unit >> 8, c = (unit >> 2) & 63, h = unit & 3; const size_t tok0 = (size_t)b * SEQ + c * CHK;
        if (tid < 64) { sm[tid] = gates[(tok0 + tid) * 8 + 4 + h]; sm[64 + tid] = gates[(tok0 + tid) * 8 + h]; }
        __syncthreads();
        if (tid == 0) { float cum = 0.f; for (int l = 0; l < 64; ++l) { cum += sm[l]; sm[128 + l] = cum; }
            float mxa = -INFINITY; for (int l = 0; l < 64; ++l) { const float a = cum - sm[128 + l] + sm[64 + l]; sm[192 + l] = a; mxa = fmaxf(mxa, a); }
            for (int l = 0; l < 64; ++l) sm[192 + l] = __expf(sm[192 + l] - mxa);
            sm[256] = mxa; sm[257] = cum; }
        __syncthreads();
        for (int e = tid; e < 8192; e += 512) { const int l = e >> 7, d = e & 127, pos = c * CHK + l, ch = 512 + h * 128 + d;
            float a = cb[ch];
#pragma unroll
            for (int j = 0; j < 4; ++j) { const int p = pos - 3 + j; if (p >= 0) a += cw[j * 1024 + ch] * bf2f(n2[((size_t)b * SEQ + p) * LD2 + N2_MK + h * 128 + d]); }
            KS[e] = a * sigmf(a) * 0.08838834764831845f;
            WV[e] = sm[192 + l] * bf2f(tT[(size_t)(T_MV + h * 128 + d) * M + tok0 + l]); }
        __syncthreads();
        { const int k = tid & 127, vg = tid >> 7; float a[32];
#pragma unroll
          for (int i = 0; i < 32; ++i) a[i] = 0.f;
          for (int l = 0; l < 64; ++l) { const float kk = KS[l * 128 + k];
#pragma unroll
              for (int i = 0; i < 32; ++i) a[i] += WV[l * 128 + vg * 32 + i] * kk; }
          bf16* cp = cloc + (size_t)unit * 16384 + (size_t)(vg * 32) * 128 + k;
#pragma unroll
          for (int i = 0; i < 32; ++i) cp[i * 128] = (bf16)f2bf(a[i]); }
        if (tid < 128) { float s = 0.f; for (int l = 0; l < 64; ++l) s += sm[192 + l] * KS[l * 128 + tid]; nloc[unit * 128 + tid] = s; }
        if (tid == 0) { mloc[unit] = sm[256]; blast[unit] = sm[257]; }
        __syncthreads();
    }
}

__device__ __forceinline__ void mlstm_scan(bf16* cloc, float* nloc, const float* mloc, const float* blast, float* mst, int bid, int G, int tid, int dry) {
    const int gt = bid * 512 + tid, NT = G * 512;
    for (int it = gt; it < 16 * 8192; it += NT) {
        const int bh = it >> 13, e2 = it & 8191, b = bh >> 2, h = bh & 3; float C0 = 0.f, C1 = 0.f, m = 0.f;
        unsigned* base = (unsigned*)cloc + e2; const int u0 = b * NCHK * 4 + h;
        constexpr int PD = 16;
        unsigned w[PD]; float ml[PD], bl[PD];
#pragma unroll
        for (int i = 0; i < PD; ++i) { const int unit = u0 + 4 * i; w[i] = base[(size_t)unit * 8192]; ml[i] = mloc[unit]; bl[i] = blast[unit]; }
        for (int c0 = 0; c0 < NCHK; c0 += PD) {
#pragma unroll
            for (int i = 0; i < PD; ++i) {
                const int unit = u0 + 4 * (c0 + i); const unsigned wc = w[i]; const float mlc = ml[i], blc = bl[i];
                if (c0 + PD < NCHK) { const int un = unit + 4 * PD; w[i] = base[(size_t)un * 8192]; ml[i] = mloc[un]; bl[i] = blast[un]; }
                if (!dry) base[(size_t)unit * 8192] = pk2(C0, C1);
                if (e2 == 0 && !dry) mst[unit] = m;
                const float mn = fmaxf(blc + m, mlc), sp = __expf(blc + m - mn), sl = __expf(mlc - mn);
                C0 = sp * C0 + sl * blo(wc); C1 = sp * C1 + sl * bhi(wc); m = mn;
            }
        }
    }
    for (int it = gt; it < 16 * 128; it += NT) {
        const int bh = it >> 7, k = it & 127, b = bh >> 2, h = bh & 3; float n = 0.f, m = 0.f;
        for (int c = 0; c < NCHK; ++c) { const int unit = (b * NCHK + c) * 4 + h; const float ml = mloc[unit], bl = blast[unit];
            const float nl = nloc[unit * 128 + k]; if (!dry) nloc[unit * 128 + k] = n;
            const float mn = fmaxf(bl + m, ml), sp = __expf(bl + m - mn), sl = __expf(ml - mn);
            n = sp * n + sl * nl; m = mn; }
    }
}

__device__ __forceinline__ void mlstm_out_naive(const bf16* n2, const bf16* tT, const float* gates, const float* cw, const float* cb, const bf16* cst, const float* nst, const float* mst, const float* mhg, bf16* mout, float* lds, int bid, int G, int tid) {
    constexpr int QP = 129, DP = 65;
    float* QS = lds; float* KS = lds + 64 * QP; float* VS = lds + 2 * 64 * QP; float* DS = VS + 8192; float* sm = DS + 64 * DP;
    for (int unit = bid; unit < NUNIT; unit += G) {
        const int b = unit >> 8, c = (unit >> 2) & 63, h = unit & 3; const size_t tok0 = (size_t)b * SEQ + c * CHK;
        for (int e = tid; e < 8192; e += 512) { const int l = e >> 7, d = e & 127, pos = c * CHK + l, chq = h * 128 + d, chk = 512 + chq;
            float aq = cb[chq], ak = cb[chk];
#pragma unroll
            for (int j = 0; j < 4; ++j) { const int p = pos - 3 + j; if (p >= 0) { const bf16* rp = n2 + ((size_t)b * SEQ + p) * LD2; aq += cw[j * 1024 + chq] * bf2f(rp[N2_MQ + chq]); ak += cw[j * 1024 + chk] * bf2f(rp[N2_MK + chq]); } }
            QS[l * QP + d] = aq * sigmf(aq); KS[l * QP + d] = ak * sigmf(ak) * 0.08838834764831845f;
            VS[e] = bf2f(tT[(size_t)(T_MV + chq) * M + tok0 + l]); }
        if (tid < 64) { sm[tid] = gates[(tok0 + tid) * 8 + 4 + h]; sm[64 + tid] = gates[(tok0 + tid) * 8 + h]; }
        __syncthreads();
        if (tid == 0) { float cum = 0.f, pm = -INFINITY; const float ms = mst[unit];
            for (int t = 0; t < 64; ++t) { cum += sm[t]; sm[128 + t] = cum; pm = fmaxf(pm, sm[64 + t] - cum); const float g = cum + ms, mt = fmaxf(g, cum + pm); sm[192 + t] = mt; sm[256 + t] = __expf(g - mt); } }
        __syncthreads();
        for (int e = tid; e < 4096; e += 512) { const int t = e >> 6, s = e & 63; float val = 0.f;
            if (s <= t) { float dot = 0.f;
#pragma unroll 8
                for (int d = 0; d < 128; ++d) dot += QS[t * QP + d] * KS[s * QP + d];
                val = dot * __expf(sm[128 + t] - sm[128 + s] + sm[64 + s] - sm[192 + t]); }
            DS[t * DP + s] = val; }
        __syncthreads();
        if (tid < 64) { const int t = tid; float sq = 0.f, sd = 0.f;
            for (int k = 0; k < 128; ++k) sq += nst[unit * 128 + k] * QS[t * QP + k];
            for (int s = 0; s < 64; ++s) sd += DS[t * DP + s];
            const float den = sm[256 + t] * sq + sd; sm[320 + t] = fmaxf(fabsf(den), __expf(-sm[192 + t])); }
        const int v = tid & 127, tg = tid >> 7; float a[16];
#pragma unroll
        for (int i = 0; i < 16; ++i) a[i] = 0.f;
        { const bf16* crow = cst + (size_t)unit * 16384 + (size_t)v * 128;
          for (int k = 0; k < 128; ++k) { const float cv = bf2f(crow[k]);
#pragma unroll
              for (int i = 0; i < 16; ++i) a[i] += cv * QS[(tg * 16 + i) * QP + k]; } }
#pragma unroll
        for (int i = 0; i < 16; ++i) a[i] *= sm[256 + tg * 16 + i];
        for (int s = 0; s < 64; ++s) { const float vv = VS[s * 128 + v];
#pragma unroll
            for (int i = 0; i < 16; ++i) a[i] += DS[(tg * 16 + i) * DP + s] * vv; }
        __syncthreads();
        float* HS = KS;
#pragma unroll
        for (int i = 0; i < 16; ++i) HS[(tg * 16 + i) * QP + v] = a[i] / sm[320 + tg * 16 + i];
        __syncthreads();
        if (tid < 64) { float s = 0.f; for (int k = 0; k < 128; ++k) { const float x = HS[tid * QP + k]; s += x * x; } sm[384 + tid] = rsqrtf(s * (1.0f / 128.0f) + EPS); }
        __syncthreads();
        for (int e = tid; e < 8192; e += 512) { const int t = e >> 7, vv = e & 127;
            const float mo = bf2f(n2[(tok0 + t) * LD2 + N2_MO + h * 128 + vv]);
            mout[(tok0 + t) * 512 + h * 128 + vv] = (bf16)f2bf(sigmf(mo) * HS[t * QP + vv] * sm[384 + t] * mhg[h * 128 + vv]); }
        __syncthreads();
    }
}

#define XB_TMO      128
#define XB_XCNT(j)  (256  + 64 * (j))
#define XB_XSUB(j)  (1280 + 64 * (j))
#define XB_XGEN(j)  (2304 + 64 * (j))
#define XB_TOP      3328
#define XB_TOPGEN   3392
#define XCD_BAR_WORDS 3456
#define XB_SPIN_CAP (1u << 18)

__device__ __forceinline__ unsigned xb_ld(unsigned* p)              { return __hip_atomic_load(p, __ATOMIC_RELAXED, __HIP_MEMORY_SCOPE_AGENT); }
__device__ __forceinline__ unsigned xb_add(unsigned* p, unsigned v) { return __hip_atomic_fetch_add(p, v, __ATOMIC_RELAXED, __HIP_MEMORY_SCOPE_AGENT); }
__device__ __forceinline__ unsigned xb_xcc_id() { return (unsigned)__builtin_amdgcn_s_getreg((3 << 11) | 20) & 0xFu; }
#define XB_SPIN(cond, bar) do { unsigned _sp = 0; while (cond) { __builtin_amdgcn_s_sleep(1); \
    if ((++_sp & 255u) == 0u) { if (xb_ld(&(bar)[XB_TMO])) break; if (_sp > XB_SPIN_CAP) { atomicAdd(&(bar)[XB_TMO], 1u); break; } } } } while (0)

struct XcdBarrier {
    unsigned* bar; unsigned x;
    volatile LAS unsigned* st;
};

__device__ __forceinline__ XcdBarrier xcd_barrier_post(unsigned* bar, volatile LAS unsigned* st) {
    XcdBarrier b; b.bar = bar; b.x = xb_xcc_id(); b.st = st;
    if (threadIdx.x == 0) (void)xb_add(&bar[XB_XCNT(b.x)], 1u);
    return b;
}
__device__ __forceinline__ void xcd_barrier_complete(unsigned* bar, unsigned x, unsigned& nloc, unsigned& nx) {
    const unsigned G = gridDim.x * gridDim.y * gridDim.z;
    unsigned sum, cnt, mine, sp = 0u;
    for (;;) {
        sum = 0u; cnt = 0u; mine = 0u;
#pragma unroll
        for (unsigned j = 0; j < 16; ++j) { const unsigned c = xb_ld(&bar[XB_XCNT(j)]); sum += c; cnt += (c > 0u) ? 1u : 0u; mine = (j == x) ? c : mine; }
        if (sum == G) break;
        __builtin_amdgcn_s_sleep(1);
        if ((++sp & 255u) == 0u) { if (xb_ld(&bar[XB_TMO])) break; if (sp > XB_SPIN_CAP) { atomicAdd(&bar[XB_TMO], 1u); break; } }
    }
    nloc = mine > 0u ? mine : 1u; nx = cnt > 0u ? cnt : 1u;
}

__device__ __forceinline__ void xcd_barrier(const XcdBarrier& b) {
    asm volatile("s_waitcnt vmcnt(0)" ::: "memory");
    __syncthreads();
    if (threadIdx.x == 0) {
        unsigned* bar = b.bar;
        __builtin_amdgcn_s_waitcnt(0);
        unsigned nloc = b.st[0], nx = b.st[1];
        if (nloc == 0u) { xcd_barrier_complete(bar, b.x, nloc, nx); b.st[0] = nloc; b.st[1] = nx; }
        const unsigned old = xb_add(&bar[XB_XSUB(b.x)], 1u);
        const unsigned gen = old / nloc;
        if (old + 1u == (gen + 1u) * nloc) {
            __builtin_amdgcn_fence(__ATOMIC_RELEASE, "agent");
            asm volatile("s_waitcnt vmcnt(0)" ::: "memory");
            const unsigned og = xb_add(&bar[XB_TOP], 1u);
            const unsigned tg = og / nx;
            if (og + 1u == (tg + 1u) * nx) xb_add(&bar[XB_TOPGEN], 1u);
            else XB_SPIN(xb_ld(&bar[XB_TOPGEN]) == tg, bar);
            __builtin_amdgcn_fence(__ATOMIC_ACQUIRE, "agent");
            xb_add(&bar[XB_XGEN(b.x)], 1u);
            asm volatile("s_waitcnt vmcnt(0)" ::: "memory");
        } else {
            XB_SPIN(xb_ld(&bar[XB_XGEN(b.x)]) == gen, bar);
            __builtin_amdgcn_fence(__ATOMIC_ACQUIRE, "agent");
            asm volatile("s_waitcnt vmcnt(0)" ::: "memory");
        }
    }
    __syncthreads();
}
constexpr int N_STEPS = 27, STEP_PRO1 = 13, STEP_FIN = 26, KPL = 13;
enum { K_PRO = 100, K_FIN = 101, K_A = 0, K_A2 = 1, K_B = 2, K_C = 3, K_D = 4, K_E1 = 5, K_E2 = 6, K_E3 = 7, K_E4 = 8, K_F = 9, K_G = 10, K_H = 11 };
struct Args { const float* in[16]; float* out; unsigned char* ws; int ph_lo, ph_hi; };

enum { SEL_ALL = 0, SEL_PRO = 1, SEL_FIN = 2, SEL_B = 3, SEL_C = 4, SEL_D = 5, SEL_GEMM = 6, SEL_GATES = 7 };
template <int SEL> __global__ void __launch_bounds__(512, 2) mk_fwd(Args args) {
    extern __shared__ __attribute__((aligned(16))) unsigned char lds[];
    constexpr int G = 256; const int bid = blockIdx.x;
    {
        LAS unsigned char* ldsl0 = (LAS unsigned char*)lds;
        for (int u = threadIdx.x; u < (LDS_BYTES - LDSCTL_OFF) / 4; u += 512) ((LAS unsigned*)(ldsl0 + LDSCTL_OFF))[u] = 0u;
        __syncthreads();
    }
    XcdBarrier bar; bar.bar = (unsigned*)(args.ws + WS_CTL) + CW_BAR; bar.x = 0; bar.st = nullptr;
    if (MK_ONE_LAUNCH) bar = xcd_barrier_post((unsigned*)(args.ws + WS_CTL) + CW_BAR, (volatile LAS unsigned*)((LAS unsigned char*)lds + MISC_OFF) + 8);

    int prep = 0;
    for (int step = args.ph_lo; step < args.ph_hi;) {
        int tid = threadIdx.x; asm volatile("" : "+v"(tid));
        const int lane = tid & 63, wave = __builtin_amdgcn_readfirstlane(tid >> 6), gw = bid * 8 + wave, NGW = G * 8;
        unsigned char* ws = args.ws; asm volatile("" : "+s"(ws));
        int zi = 0; asm volatile("" : "+s"(zi));
#define INP(k) (args.in[(k) + zi])
        LAS unsigned char* ldsl = (LAS unsigned char*)lds;
        const float* x_in = INP(0); float* xout = args.out; asm volatile("" : "+s"(xout));
        float* ssq = (float*)(ws + WS_SSQ); float* wg = (float*)(ws + WS_WG); float* gates = (float*)(ws + WS_GATES);
        float* nloc = (float*)(ws + WS_NLOC); float* mloc = (float*)(ws + WS_MLOC); float* blast = (float*)(ws + WS_BLAST); float* mst = (float*)(ws + WS_MST);
        bf16* Wb = (bf16*)(ws + WS_W); bf16* xb = (bf16*)(ws + WS_XB); bf16* n1 = (bf16*)(ws + WS_N1); bf16* n2 = (bf16*)(ws + WS_N2); bf16* tT = (bf16*)(ws + WS_T); bf16* att = (bf16*)(ws + WS_ATT);
        bf16* cloc = (bf16*)(ws + WS_CLOC); bf16* mout = (bf16*)(ws + WS_MOUT); bf16* Yb = (bf16*)(ws + WS_Y); bf16* Zb = (bf16*)(ws + WS_Z); bf16* Hb = (bf16*)(ws + WS_H);
        const int layer = step >= STEP_PRO1 ? 1 : 0;
        const int kind = (step == 0 || step == STEP_PRO1) ? K_PRO : (step == STEP_FIN ? K_FIN : (step - 1) % KPL);
        float* ssqA = ssq + (size_t)(2 * layer) * M; float* ssqF = ssq + (size_t)(2 * layer + 1) * M; float* ssqN = ssq + (size_t)(2 * layer + 2) * M;

        if ((SEL == SEL_ALL || SEL == SEL_PRO) && kind == K_PRO) {
            LAS float* scr = (LAS float*)(ldsl + wave * 16384);
            const float* w_in = INP(2) + (size_t)layer * DM * DIN_SRC; const float* g_mix = INP(1) + layer * DM;
            const float* w_a = INP(9) + (size_t)layer * 512 * DM; const float* w_m = INP(10) + (size_t)layer * 512 * DM;
            const float* w_o = INP(11) + (size_t)layer * DM * DM; const float* g_ffn = INP(12) + layer * DM;
            const float* w_up = INP(13) + (size_t)layer * DM * DFF; const float* w_dn = INP(14) + (size_t)layer * DFF * DM;
            constexpr int I_IN = 16 * 176, I_A = 8 * 32, I_M = 8 * 32, I_O = 16 * 32, I_UP = 16 * 128, I_DN = 64 * 32, NITEMS = I_IN + I_A + I_M + I_O + I_UP + I_DN;
            for (int it = gw; it < NITEMS; it += NGW) {
                int r = it;
                if (r < I_IN) { transpose_item(w_in, DIN_SRC, 1, g_mix, Wb + W_IN, 1024, 176, scr, r, lane); continue; } r -= I_IN;
                if (r < I_A) { transpose_item(w_a, DM, 0, nullptr, Wb + W_A, 512, 32, scr, r, lane); continue; } r -= I_A;
                if (r < I_M) { transpose_item(w_m, DM, 0, nullptr, Wb + W_M, 512, 32, scr, r, lane); continue; } r -= I_M;
                if (r < I_O) { transpose_item(w_o, DM, 0, nullptr, Wb + W_O, 1024, 32, scr, r, lane); continue; } r -= I_O;
                if (r < I_UP) { transpose_item(w_up, DFF, 0, g_ffn, Wb + W_UP, 1024, 128, scr, r, lane); continue; } r -= I_UP;
                transpose_item(w_dn, DM, 0, nullptr, Wb + W_DN, 4096, 32, scr, r, lane);
            }
            for (int i = bid * 512 + tid; i < 8 * 1024; i += G * 512) { const int j = i >> 10, k = i & 1023; wg[i] = g_mix[k] * w_in[(size_t)k * DIN_SRC + 3584 + j]; }
            if (layer == 0) {
                for (int i = bid * 512 + tid; i < 4 * M; i += G * 512) ssq[M + i] = 0.f;
                for (int m = gw; m < M; m += NGW) {
                    const f32x4* xr = (const f32x4*)(x_in + (size_t)m * DM) + lane; f32x4 v[4]; float s = 0.f;
#pragma unroll
                    for (int j = 0; j < 4; ++j) { v[j] = xr[64 * j]; s += (v[j].x * v[j].x + v[j].y * v[j].y) + (v[j].z * v[j].z + v[j].w * v[j].w); }
                    s = wave_sum(s); if (lane == 0) ssq[m] = s;
                    unsigned long long* o8 = (unsigned long long*)(xb + (size_t)m * DM) + lane;
#pragma unroll
                    for (int j = 0; j < 4; ++j) o8[64 * j] = (unsigned long long)pk2(v[j].x, v[j].y) | ((unsigned long long)pk2(v[j].z, v[j].w) << 32);
                }
            }
        } else if ((SEL == SEL_ALL || SEL == SEL_FIN) && kind == K_FIN) {
            const float* gf = INP(15);
            for (int m = gw; m < M; m += NGW) {
                const float rs = rsqrtf(ssqN[m] * (1.0f / 1024.0f) + EPS);
                f32x4* xr = (f32x4*)(xout + (size_t)m * DM) + lane; const f32x4* gr = (const f32x4*)gf + lane;
#pragma unroll
                for (int j = 0; j < 4; ++j) { const f32x4 v = xr[64 * j], g = gr[64 * j]; xr[64 * j] = v * rs * g; }
            }
        } else if ((SEL == SEL_ALL || SEL == SEL_B) && kind == K_B) {
#if FAST_ATTN
            attn_mfma(n1, tT, INP(7) + (size_t)layer * 8 * 513, att, (LAS float*)ldsl, bid, G, wave, lane);
            __syncthreads();
#else
            attn_naive(n1, tT, INP(7) + (size_t)layer * 8 * 513, att, bid, G, wave, lane);
#endif
#if FAST_LOCAL
            mlstm_local_mfma(tT, gates, INP(3) + (size_t)layer * 4096, INP(4) + (size_t)layer * 1024, cloc, nloc, mloc, blast, (LAS float*)ldsl, bid, G, wave, lane);
#else
            mlstm_local_naive(n2, tT, gates, INP(3) + (size_t)layer * 4096, INP(4) + (size_t)layer * 1024, cloc, nloc, mloc, blast, (float*)lds, bid, G, tid);
#endif
        } else if ((SEL == SEL_ALL || SEL == SEL_C) && kind == K_C) {
            mlstm_scan(cloc, nloc, mloc, blast, mst, bid, G, tid, prep);
#if FAST_OUT
            conv_prepass(n2, INP(3) + (size_t)layer * 4096, INP(4) + (size_t)layer * 1024, n1, bid, G, tid);
#endif
        } else if ((SEL == SEL_ALL || SEL == SEL_D) && kind == K_D) {
#if FAST_OUT
            mlstm_out_mfma(n1, n2, tT, gates, cloc, nloc, mst, INP(8) + (size_t)layer * 512, mout, (LAS float*)ldsl, bid, G, wave, lane);
#else
            mlstm_out_naive(n2, tT, gates, INP(3) + (size_t)layer * 4096, INP(4) + (size_t)layer * 1024, cloc, nloc, mst, INP(8) + (size_t)layer * 512, mout, (float*)lds, bid, G, tid);
#endif
        } else if ((SEL == SEL_ALL || SEL == SEL_GEMM) && kind <= K_H && kind != K_A2) {
#ifndef GATES_ON
#define GATES_ON 1
#endif
#ifdef GEMM_ONLY
#define GEMM_ON(k) ((k) == GEMM_ONLY)
#else
#define GEMM_ON(k) true
#endif
            pg8::StaticOrder S;
#define RUN_GEMM_X(MODE, MR_, CU_, A_, BT_, N_, K_, O_, LDC_, Z_, SSQI_, BASE_, OUTF_, SSQO_, O2_, LDC2_, SPLIT_) do { pg8::Gemm g; g.A = (A_); g.Bt = (BT_); g.M = (MR_); g.N = (N_); g.K = (K_); \
                pg8::EpiAny<MODE> E; E.O = (O_); E.ldc = (LDC_); E.Z = (Z_); E.ssq_in = (SSQI_); E.base = (BASE_); E.outf = (OUTF_); E.ssq_out = (SSQO_); E.O2 = (O2_); E.ldc2 = (LDC2_); E.split = (SPLIT_); E.dry = prep; \
                S.init((MR_), (N_), G, (CU_)); pg8::gemm_phase<pg8::EpiAny<MODE>, pg8::StaticOrder, true, true>(ldsl, g, S, E); } while (0)
#define RUN_GEMM(MODE, A_, BT_, N_, K_, O_, LDC_, Z_, SSQI_, BASE_, OUTF_, SSQO_) RUN_GEMM_X(MODE, M, bid, A_, BT_, N_, K_, O_, LDC_, Z_, SSQI_, BASE_, OUTF_, SSQO_, nullptr, 0, 0)
            if (GEMM_ON(K_A) && kind == K_A) {
                RUN_GEMM_X(0, M, bid, xb, Wb + W_IN, 2560, 1024, n1, LD1, nullptr, ssqA, nullptr, nullptr, nullptr, n2, LD2, 1024);
                RUN_GEMM_X(6, 1536, (bid + G / 2) % G, Wb + W_IN + (size_t)2048 * 1024, xb, M, 1024, tT, M, nullptr, ssqA, nullptr, nullptr, nullptr, nullptr, 0, 0);
            }
            else if (GEMM_ON(K_E1) && kind == K_E1) RUN_GEMM(2, att, Wb + W_A, 1024, 512, Yb, 1024, nullptr, nullptr, nullptr, nullptr, nullptr);
            else if (GEMM_ON(K_E2) && kind == K_E2) RUN_GEMM(3, xb, Wb + W_IN + (size_t)3584 * 1024, 1024, 1024, Yb, 1024, nullptr, ssqA, nullptr, nullptr, nullptr);
            else if (GEMM_ON(K_E3) && kind == K_E3) RUN_GEMM(2, mout, Wb + W_M, 1024, 512, Zb, 1024, nullptr, nullptr, nullptr, nullptr, nullptr);
            else if (GEMM_ON(K_E4) && kind == K_E4) RUN_GEMM(4, xb, Wb + W_IN + (size_t)4608 * 1024, 1024, 1024, Yb, 1024, Zb, ssqA, nullptr, nullptr, nullptr);
            else if (GEMM_ON(K_F) && kind == K_F) { if (layer == 0) RUN_GEMM(5, Yb, Wb + W_O, 1024, 1024, xb, 1024, nullptr, nullptr, x_in, nullptr, ssqF);
                                                  else RUN_GEMM(7, Yb, Wb + W_O, 1024, 1024, xb, 1024, nullptr, nullptr, nullptr, nullptr, ssqF); }
            else if (GEMM_ON(K_G) && kind == K_G)  RUN_GEMM(1, xb, Wb + W_UP, 4096, 1024, Hb, DFF, nullptr, ssqF, nullptr, nullptr, nullptr);
            else if (GEMM_ON(K_H)) { if (layer == 0) RUN_GEMM(7, Hb, Wb + W_DN, 1024, 4096, xb, 1024, nullptr, nullptr, nullptr, nullptr, ssqN);
                                     else RUN_GEMM(8, Hb, Wb + W_DN, 1024, 4096, xb, 1024, nullptr, nullptr, nullptr, xout, ssqN); }
        } else if ((SEL == SEL_ALL || SEL == SEL_GATES) && kind == K_A2) {
            gates_phase(x_in, xb, layer, wg, INP(5) + layer * 4, INP(6) + layer * 4, gates, (LAS float*)ldsl, bid, tid);
        }
        const bool seam = !(kind == K_A || kind == K_E1 || kind == K_E2 || kind == K_E3);
        if (seam && step + 1 < args.ph_hi) { if (MK_ONE_LAUNCH) xcd_barrier(bar); }
#ifdef PROBE_BAR
        if (step == 3) { for (int pb = 0; pb < PROBE_BAR; ++pb) xcd_barrier(bar); }
#endif
#ifdef PROBE_REPEAT
        if ((PROBE_REPEAT_COND) && prep + 1 < PROBE_REPEAT) { ++prep; } else { prep = 0; ++step; }
#else
        ++step;
#endif
    }
}

extern "C" void kernel_launch(void* const* d_in, const int* in_sizes, int n_in, void* d_out, int out_size, void* d_ws, size_t ws_size, hipStream_t stream) {
    static int grid = 0;
    if (grid == 0) {
        if (n_in != 16 || in_sizes[0] != M * DM || out_size != M * DM || ws_size < WS_END) { fprintf(stderr, "kernel_launch: unexpected shapes (n_in %d, in0 %d, out %d, ws %zu)\n", n_in, n_in > 0 ? in_sizes[0] : -1, out_size, ws_size); grid = -1; return; }
        int dev = 0, cus = 0;
        if (hipGetDevice(&dev) != hipSuccess || hipDeviceGetAttribute(&cus, hipDeviceAttributeMultiprocessorCount, dev) != hipSuccess) { grid = -1; return; }
        bool ok = true;
#if MK_ONE_LAUNCH
        ok &= hipFuncSetAttribute((const void*)mk_fwd<SEL_ALL>, hipFuncAttributeMaxDynamicSharedMemorySize, LDS_BYTES) == hipSuccess;
#endif
#if !MK_ONE_LAUNCH
        ok &= hipFuncSetAttribute((const void*)mk_fwd<SEL_PRO>, hipFuncAttributeMaxDynamicSharedMemorySize, LDS_BYTES) == hipSuccess;
        ok &= hipFuncSetAttribute((const void*)mk_fwd<SEL_FIN>, hipFuncAttributeMaxDynamicSharedMemorySize, LDS_BYTES) == hipSuccess;
        ok &= hipFuncSetAttribute((const void*)mk_fwd<SEL_B>, hipFuncAttributeMaxDynamicSharedMemorySize, LDS_BYTES) == hipSuccess;
        ok &= hipFuncSetAttribute((const void*)mk_fwd<SEL_C>, hipFuncAttributeMaxDynamicSharedMemorySize, LDS_BYTES) == hipSuccess;
        ok &= hipFuncSetAttribute((const void*)mk_fwd<SEL_D>, hipFuncAttributeMaxDynamicSharedMemorySize, LDS_BYTES) == hipSuccess;
        ok &= hipFuncSetAttribute((const void*)mk_fwd<SEL_GATES>, hipFuncAttributeMaxDynamicSharedMemorySize, LDS_BYTES) == hipSuccess;
        ok &= hipFuncSetAttribute((const void*)mk_fwd<SEL_GEMM>, hipFuncAttributeMaxDynamicSharedMemorySize, LDS_BYTES) == hipSuccess;
#endif
        if (!ok) { fprintf(stderr, "kernel_launch: hipFuncSetAttribute failed\n"); grid = -1; return; }
        (void)hipGetLastError();
        if (cus < 256) { fprintf(stderr, "kernel_launch: needs 256 CUs, device has %d\n", cus); grid = -1; return; }
        grid = 256;
    }
    if (grid < 0) return;
    if (hipMemsetAsync((char*)d_ws + WS_CTL, 0, CTL_ZERO_BYTES, stream) != hipSuccess) return;
    Args a{};
    for (int i = 0; i < 16; ++i) a.in[i] = (const float*)d_in[i];
    a.out = (float*)d_out; a.ws = (unsigned char*)d_ws;
#if MK_ONE_LAUNCH
    {
        a.ph_lo = 0; a.ph_hi = N_STEPS;
        hipLaunchKernelGGL(mk_fwd<SEL_ALL>, dim3(grid), dim3(512), LDS_BYTES, stream, a);
    }
#else
    {
        int s = 0;
        while (s < N_STEPS) {
            int e = s + 1;
            const int k = (s == 0 || s == STEP_PRO1 || s == STEP_FIN) ? -1 : (s - 1) % KPL;
            if (k == K_E1) e = s + 4;
            a.ph_lo = s; a.ph_hi = e;
            if (k == -1 && s != STEP_FIN) hipLaunchKernelGGL(mk_fwd<SEL_PRO>, dim3(grid), dim3(512), LDS_BYTES, stream, a);
            else if (k == -1) hipLaunchKernelGGL(mk_fwd<SEL_FIN>, dim3(grid), dim3(512), LDS_BYTES, stream, a);
            else if (k == K_A2) hipLaunchKernelGGL(mk_fwd<SEL_GATES>, dim3(grid), dim3(512), LDS_BYTES, stream, a);
            else if (k == K_B) hipLaunchKernelGGL(mk_fwd<SEL_B>, dim3(grid), dim3(512), LDS_BYTES, stream, a);
            else if (k == K_C) hipLaunchKernelGGL(mk_fwd<SEL_C>, dim3(grid), dim3(512), LDS_BYTES, stream, a);
            else if (k == K_D) hipLaunchKernelGGL(mk_fwd<SEL_D>, dim3(grid), dim3(512), LDS_BYTES, stream, a);
            else hipLaunchKernelGGL(mk_fwd<SEL_GEMM>, dim3(grid), dim3(512), LDS_BYTES, stream, a);
            s = e;
        }
    }
#endif
}
```

```cpp
#include <hip/hip_runtime.h>
#include <cstdio>
#include <cstdint>

namespace pg8 {
#define PG8_LAS __attribute__((address_space(3)))
typedef unsigned short bf16_t;
typedef short bf16x8 __attribute__((ext_vector_type(8)));
typedef float f32x4 __attribute__((ext_vector_type(4)));
typedef unsigned u32x4 __attribute__((ext_vector_type(4)));
constexpr int BM = 256, BK = 64, HALF = 128, HTB = HALF * BK * 2  , STAGE_BYTES = 8 * HTB, NXCD = 8, WGM = 8;

__host__ __device__ __forceinline__ int lds_byte(int r, int c) { const int st = (r >> 4) * 2 + (c >> 5), rr = r & 15, cc = c & 31, ob = rr * 64 + cc * 2; return st * 1024 + (ob ^ (((ob >> 9) & 1) << 5)); }
__host__ __device__ __forceinline__ void stage_rc(int b, int& R, int& C) { const int st = b / 1024, sb = b % 1024, swz = sb ^ (((sb >> 9) & 1) << 5); R = (st >> 1) * 16 + swz / 64; C = (st & 1) * 32 + (swz % 64) / 2; }
__host__ __device__ __forceinline__ int perm32(int rho) { const int n = rho >> 4, i = rho & 15; return 8 * (i >> 2) + 4 * n + (i & 3); }

struct Unit { int pm, pn; };
struct Gemm { const bf16_t* A; const bf16_t* Bt; int M, N, K; };

struct StaticOrder {
    int nM, nN, nwg, G, c;
    __host__ __device__ void init(int M, int N, int G_, int c_) { nM = M / BM; nN = N / BM; nwg = nM * nN; G = G_; c = c_; }
    __host__ __device__ bool next(int i, Unit& u) const {
        const long L = (long)i * G + c; if (L >= nwg) return false;
        int wgid = (int)L; { const int q = nwg / NXCD, r = nwg % NXCD, xcd = wgid % NXCD, off = wgid / NXCD; wgid = (xcd < r ? xcd * (q + 1) : r * (q + 1) + (xcd - r) * q) + off; }
        const int nig = WGM * nN, gid = wgid / nig, fm = gid * WGM, gsz = (nM - fm) < WGM ? (nM - fm) : WGM;
        u.pm = fm + ((wgid % nig) % gsz); u.pn = (wgid % nig) / gsz; return true;
    }
    __device__ __forceinline__ void a_ready(const Unit&) const {}
    __device__ __forceinline__ void done(const Unit&) const {}
};

__device__ __forceinline__ unsigned cvt_pk_bf16(float lo, float hi) { unsigned r; asm volatile("v_cvt_pk_bf16_f32 %0, %1, %2" : "=v"(r) : "v"(lo), "v"(hi)); return r; }
__device__ __forceinline__ float bflo(unsigned w) { return __uint_as_float(w << 16); }
__device__ __forceinline__ float bfhi(unsigned w) { return __uint_as_float(w & 0xffff0000u); }
__device__ __forceinline__ float rstd_of(float ss) { return rsqrtf(ss * (1.0f / 1024.0f) + 1e-6f); }
__device__ __forceinline__ float sigm(float x) { return __builtin_amdgcn_rcpf(1.0f + __expf(-x)); }
typedef unsigned u32x2 __attribute__((ext_vector_type(2)));

template <int mode> struct EpiAny {
    static constexpr bool PERM = true, AFTER_DRAIN = false;
    bf16_t* O; int ldc; const bf16_t* Z; const float* ssq_in; const float* base; float* outf; float* ssq_out; bf16_t* O2; int ldc2, split; int dry;
    __device__ __forceinline__ void operator()(const f32x4 (&acc)[2][2][4][2], const Unit& u, int wr, int wc, int fr, int fq) const {
        const int row0 = u.pm * BM + wr * 64 + fr, col0 = u.pn * BM + wc * 32 + 8 * fq;
#ifdef PROBE_REPEAT
        if (dry) { asm volatile("" :: "v"(acc[0][0][0][0][0]), "v"(acc[1][1][3][1][3])); return; }
#endif
        if (mode == 6) {
            float rs[2][8];
#pragma unroll
            for (int bj = 0; bj < 2; ++bj) { const f32x4 s0 = *(const f32x4*)(ssq_in + col0 + bj * HALF), s1 = *(const f32x4*)(ssq_in + col0 + bj * HALF + 4);
#pragma unroll
                for (int e = 0; e < 4; ++e) { rs[bj][e] = rstd_of(s0[e]); rs[bj][4 + e] = rstd_of(s1[e]); } }
#pragma unroll
            for (int ai = 0; ai < 2; ++ai)
#pragma unroll
                for (int m = 0; m < 4; ++m) {
                    const int row = row0 + ai * HALF + m * 16; bf16_t* rowp = O + (size_t)row * ldc + col0;
#pragma unroll
                    for (int bj = 0; bj < 2; ++bj) {
                        const f32x4 v0 = acc[ai][bj][m][0], v1 = acc[ai][bj][m][1];
                        u32x4 w; w.x = cvt_pk_bf16(v0[0] * rs[bj][0], v0[1] * rs[bj][1]); w.y = cvt_pk_bf16(v0[2] * rs[bj][2], v0[3] * rs[bj][3]);
                        w.z = cvt_pk_bf16(v1[0] * rs[bj][4], v1[1] * rs[bj][5]); w.w = cvt_pk_bf16(v1[2] * rs[bj][6], v1[3] * rs[bj][7]);
                        *(u32x4*)(rowp + bj * HALF) = w;
                    }
                }
        } else if (mode <= 1) {
            bf16_t* ob = O; int ld = ldc, cc = col0;
            if (mode == 0 && u.pn * BM >= split) { ob = O2; ld = ldc2; cc = col0 - split; }
#pragma unroll
            for (int ai = 0; ai < 2; ++ai)
#pragma unroll
                for (int m = 0; m < 4; ++m) {
                    const int row = row0 + ai * HALF + m * 16; const float rs = rstd_of(ssq_in[row]);
                    bf16_t* rowp = ob + (size_t)row * ld + cc;
#pragma unroll
                    for (int bj = 0; bj < 2; ++bj) {
                        f32x4 v0 = acc[ai][bj][m][0] * rs, v1 = acc[ai][bj][m][1] * rs;
                        if (mode == 1) {
#pragma unroll
                            for (int e = 0; e < 4; ++e) { const float a = fmaxf(v0[e], 0.f), b = fmaxf(v1[e], 0.f); v0[e] = a * a; v1[e] = b * b; }
                        }
                        u32x4 w; w.x = cvt_pk_bf16(v0[0], v0[1]); w.y = cvt_pk_bf16(v0[2], v0[3]); w.z = cvt_pk_bf16(v1[0], v1[1]); w.w = cvt_pk_bf16(v1[2], v1[3]);
                        *(u32x4*)(rowp + bj * HALF) = w;
                    }
                }
        } else if (mode == 2) {
#pragma unroll
            for (int ai = 0; ai < 2; ++ai)
#pragma unroll
                for (int m = 0; m < 4; ++m) {
                    const int row = row0 + ai * HALF + m * 16; bf16_t* rowp = O + (size_t)row * ldc + col0;
#pragma unroll
                    for (int bj = 0; bj < 2; ++bj) {
                        const f32x4 v0 = acc[ai][bj][m][0], v1 = acc[ai][bj][m][1];
                        u32x4 w; w.x = cvt_pk_bf16(v0[0], v0[1]); w.y = cvt_pk_bf16(v0[2], v0[3]); w.z = cvt_pk_bf16(v1[0], v1[1]); w.w = cvt_pk_bf16(v1[2], v1[3]);
                        *(u32x4*)(rowp + bj * HALF) = w;
                    }
                }
        } else if (mode <= 4) {
#pragma unroll
            for (int ai = 0; ai < 2; ++ai)
#pragma unroll
                for (int m = 0; m < 4; ++m) {
                    const int row = row0 + ai * HALF + m * 16; const float rs = rstd_of(ssq_in[row]);
                    bf16_t* rowp = O + (size_t)row * ldc + col0; const bf16_t* zp = Z + (size_t)row * ldc + col0;
#pragma unroll
                    for (int bj = 0; bj < 2; ++bj) {
                        const f32x4 a0 = acc[ai][bj][m][0] * rs, a1 = acc[ai][bj][m][1] * rs;
                        const u32x4 y = *(const u32x4*)(rowp + bj * HALF);
                        float yv[8] = {bflo(y.x), bfhi(y.x), bflo(y.y), bfhi(y.y), bflo(y.z), bfhi(y.z), bflo(y.w), bfhi(y.w)};
                        float gv[8] = {sigm(a0[0]), sigm(a0[1]), sigm(a0[2]), sigm(a0[3]), sigm(a1[0]), sigm(a1[1]), sigm(a1[2]), sigm(a1[3])};
                        float ov[8];
                        if (mode == 3) {
#pragma unroll
                            for (int e = 0; e < 8; ++e) ov[e] = gv[e] * yv[e];
                        } else {
                            const u32x4 z = *(const u32x4*)(zp + bj * HALF);
                            float zv[8] = {bflo(z.x), bfhi(z.x), bflo(z.y), bfhi(z.y), bflo(z.z), bfhi(z.z), bflo(z.w), bfhi(z.w)};
#pragma unroll
                            for (int e = 0; e < 8; ++e) ov[e] = yv[e] + gv[e] * zv[e];
                        }
                        u32x4 w; w.x = cvt_pk_bf16(ov[0], ov[1]); w.y = cvt_pk_bf16(ov[2], ov[3]); w.z = cvt_pk_bf16(ov[4], ov[5]); w.w = cvt_pk_bf16(ov[6], ov[7]);
                        *(u32x4*)(rowp + bj * HALF) = w;
                    }
                }
        } else {
#pragma unroll
            for (int ai = 0; ai < 2; ++ai)
#pragma unroll
                for (int m = 0; m < 4; ++m) {
                    const int row = row0 + ai * HALF + m * 16; const size_t off = (size_t)row * ldc + col0; float s = 0.f;
#pragma unroll
                    for (int bj = 0; bj < 2; ++bj) {
                        f32x4 b0, b1;
                        if (mode == 5) { b0 = *(const f32x4*)(base + off + bj * HALF); b1 = *(const f32x4*)(base + off + bj * HALF + 4); }
                        else { const u32x4 y = *(const u32x4*)(O + off + bj * HALF); b0 = (f32x4){bflo(y.x), bfhi(y.x), bflo(y.y), bfhi(y.y)}; b1 = (f32x4){bflo(y.z), bfhi(y.z), bflo(y.w), bfhi(y.w)}; }
                        const f32x4 o0 = b0 + acc[ai][bj][m][0], o1 = b1 + acc[ai][bj][m][1];
                        if (mode == 8) { *(f32x4*)(outf + off + bj * HALF) = o0; *(f32x4*)(outf + off + bj * HALF + 4) = o1; }
                        else { u32x4 w; w.x = cvt_pk_bf16(o0[0], o0[1]); w.y = cvt_pk_bf16(o0[2], o0[3]); w.z = cvt_pk_bf16(o1[0], o1[1]); w.w = cvt_pk_bf16(o1[2], o1[3]);
                            *(u32x4*)(O + off + bj * HALF) = w; }
                        s += (o0[0] * o0[0] + o0[1] * o0[1]) + (o0[2] * o0[2] + o0[3] * o0[3]) + (o1[0] * o1[0] + o1[1] * o1[1]) + (o1[2] * o1[2] + o1[3] * o1[3]);
                    }
                    s += __shfl_xor(s, 16); s += __shfl_xor(s, 32);
                    if (fq == 0) atomicAdd(ssq_out + row, s);
                }
        }
    }
};

template <class Epi, class Sched, bool ALIGN_EPI = false, bool SP2 = false>
__device__ __forceinline__ void gemm_phase(PG8_LAS unsigned char* lds, const Gemm g, const Sched& S, const Epi& E) {
    int tid_ = threadIdx.x; asm volatile("" : "+v"(tid_));
    const int tid = tid_, wid = __builtin_amdgcn_readfirstlane(tid >> 6), lane = tid & 63, wr = wid >> 2, wc = wid & 3, fr = lane & 15, fq = lane >> 4;
    const int K = g.K, nt = K / BK;
    unsigned voffA[2], voffB[2];
#pragma unroll
    for (int i = 0; i < 2; ++i) { int R, C; stage_rc(tid * 16 + i * 8192, R, C); const int Rb = Epi::PERM ? ((R & ~31) + perm32(R & 31)) : R;
        voffA[i] = (unsigned)(R * K + C) * 2u; voffB[i] = (unsigned)(Rb * K + C) * 2u; }
    const size_t kstep = (size_t)(BK * 2);
    const size_t hstep = (size_t)HALF * K * 2;
    const size_t tstep = 2 * hstep;
    const unsigned ldsw = (unsigned)wid * 1024u;
    const int aoff = lds_byte(wr * 64 + fr, fq * 8), boff = lds_byte(wc * 32 + fr, fq * 8);
#define PG8_SA(b, h) (((b) * 2 + (h)) * HTB)
#define PG8_SB(b, h) ((4 + (b) * 2 + (h)) * HTB)
#define PG8_STAGE(bufoff, gbase, voff) do { _Pragma("unroll") for (int _i = 0; _i < 2; ++_i) \
        __builtin_amdgcn_global_load_lds((const unsigned*)((const char*)(gbase) + (voff)[_i]), (PG8_LAS unsigned*)(lds + (bufoff) + ldsw + _i * 8192), 16, 0, 0); } while (0)
#define PG8_LDA(dst, b, h) do { _Pragma("unroll") for (int m = 0; m < 4; ++m) _Pragma("unroll") for (int k = 0; k < 2; ++k) dst[m][k] = *(const PG8_LAS bf16x8*)(lds + PG8_SA(b, h) + aoff + m * 2048 + k * 1024); } while (0)
#define PG8_LDB(dst, b, h) do { _Pragma("unroll") for (int n = 0; n < 2; ++n) _Pragma("unroll") for (int k = 0; k < 2; ++k) dst[n][k] = *(const PG8_LAS bf16x8*)(lds + PG8_SB(b, h) + boff + n * 2048 + k * 1024); } while (0)
#define PG8_MMA(ai, bj, At, Bt) do { __builtin_amdgcn_s_setprio(1); _Pragma("unroll") for (int m = 0; m < 4; ++m) _Pragma("unroll") for (int n = 0; n < 2; ++n) _Pragma("unroll") for (int k = 0; k < 2; ++k) \
        acc[ai][bj][m][n] = __builtin_amdgcn_mfma_f32_16x16x32_bf16(Bt[n][k], At[m][k], acc[ai][bj][m][n], 0, 0, 0); __builtin_amdgcn_s_setprio(0); } while (0)
#define PG8_WAIT_V(n) asm volatile("s_waitcnt vmcnt(" #n ")" ::: "memory")
#define PG8_WAIT_L(n) asm volatile("s_waitcnt lgkmcnt(" #n ")" ::: "memory")
#define PG8_BAR __builtin_amdgcn_s_barrier()
#define PG8_SCHED __builtin_amdgcn_sched_barrier(0)
    Unit cur, nxt; int ui = 0;
    if (!S.next(0, cur)) return;
    f32x4 acc[2][2][4][2];
#pragma unroll
    for (int a = 0; a < 2; ++a)
#pragma unroll
        for (int b = 0; b < 2; ++b)
#pragma unroll
            for (int m = 0; m < 4; ++m)
#pragma unroll
                for (int n = 0; n < 2; ++n) acc[a][b][m][n] = (f32x4){0.f, 0.f, 0.f, 0.f};
    bf16x8 At[4][2], B0[2][2], B1[2][2];
    const char* cA = (const char*)g.A + (size_t)cur.pm * tstep; const char* cB = (const char*)g.Bt + (size_t)cur.pn * tstep;
    S.a_ready(cur);
    if constexpr (SP2) {
        PG8_STAGE(PG8_SB(0, 0), cB, voffB); PG8_STAGE(PG8_SB(0, 1), cB + hstep, voffB); PG8_STAGE(PG8_SA(0, 0), cA, voffA); PG8_STAGE(PG8_SA(0, 1), cA + hstep, voffA);
        if (wr == 1) PG8_BAR;
        PG8_WAIT_V(2); PG8_BAR;
        PG8_STAGE(PG8_SB(1, 0), cB + kstep, voffB); PG8_STAGE(PG8_SA(1, 0), cA + kstep, voffA); PG8_STAGE(PG8_SB(1, 1), cB + hstep + kstep, voffB);
        PG8_WAIT_V(6); PG8_BAR;
    } else {
        PG8_STAGE(PG8_SB(0, 0), cB, voffB); PG8_STAGE(PG8_SA(0, 0), cA, voffA); PG8_STAGE(PG8_SB(0, 1), cB + hstep, voffB); PG8_STAGE(PG8_SA(0, 1), cA + hstep, voffA);
        if (wr == 1) PG8_BAR;
        PG8_WAIT_V(4); PG8_BAR;
        PG8_STAGE(PG8_SB(1, 0), cB + kstep, voffB); PG8_STAGE(PG8_SA(1, 0), cA + kstep, voffA); PG8_STAGE(PG8_SB(1, 1), cB + hstep + kstep, voffB);
        PG8_WAIT_V(6); PG8_BAR;
    }
    for (;;) {
        const bool has_next = S.next(ui + 1, nxt);
        const char* nA = has_next ? (const char*)g.A + (size_t)nxt.pm * tstep : cA; const char* nB = has_next ? (const char*)g.Bt + (size_t)nxt.pn * tstep : cB;
        for (int t = 0; t < nt; t += 2) {
            const bool last = (t == nt - 2);
            const char* a1 = cA + (size_t)(t + 1) * kstep;
            const char* a2 = last ? nA : cA + (size_t)(t + 2) * kstep; const char* b2 = last ? nB : cB + (size_t)(t + 2) * kstep;
            const char* a3 = a2 + kstep; const char* b3 = b2 + kstep;
            if (last && has_next) S.a_ready(nxt);
            if constexpr (SP2) {
            PG8_LDB(B0, 0, 0); PG8_LDB(B1, 0, 1); PG8_SCHED; PG8_LDA(At, 0, 0); PG8_STAGE(PG8_SA(1, 1), a1 + hstep, voffA);
            PG8_WAIT_V(8); PG8_WAIT_L(0); PG8_BAR; PG8_MMA(0, 0, At, B0); PG8_MMA(0, 1, At, B1); PG8_BAR; PG8_SCHED;
            PG8_LDA(At, 0, 1); PG8_STAGE(PG8_SB(0, 0), b2, voffB); PG8_STAGE(PG8_SB(0, 1), b2 + hstep, voffB); PG8_STAGE(PG8_SA(0, 0), a2, voffA);
            PG8_WAIT_V(8); PG8_WAIT_L(0); PG8_BAR; PG8_MMA(1, 0, At, B0); PG8_MMA(1, 1, At, B1); PG8_BAR; PG8_SCHED;
            PG8_LDB(B0, 1, 0); PG8_LDB(B1, 1, 1); PG8_SCHED; PG8_LDA(At, 1, 0); PG8_STAGE(PG8_SA(0, 1), a2 + hstep, voffA);
            PG8_WAIT_V(8); PG8_WAIT_L(0); PG8_BAR; PG8_MMA(0, 0, At, B0); PG8_MMA(0, 1, At, B1); PG8_BAR; PG8_SCHED;
            PG8_LDA(At, 1, 1); PG8_STAGE(PG8_SB(1, 0), b3, voffB); PG8_STAGE(PG8_SB(1, 1), b3 + hstep, voffB); PG8_STAGE(PG8_SA(1, 0), a3, voffA);
            PG8_WAIT_V(8); PG8_WAIT_L(0); PG8_BAR; PG8_MMA(1, 0, At, B0); PG8_MMA(1, 1, At, B1); PG8_BAR; PG8_SCHED;
            } else {
            PG8_LDB(B0, 0, 0); PG8_SCHED; PG8_LDA(At, 0, 0); PG8_STAGE(PG8_SA(1, 1), a1 + hstep, voffA);
            PG8_WAIT_L(8); PG8_BAR; PG8_WAIT_L(0); PG8_MMA(0, 0, At, B0); PG8_BAR; PG8_SCHED;
            PG8_LDB(B1, 0, 1); PG8_STAGE(PG8_SB(0, 0), b2, voffB);
            PG8_BAR; PG8_WAIT_L(0); PG8_MMA(0, 1, At, B1); PG8_BAR;
            PG8_LDA(At, 0, 1); PG8_STAGE(PG8_SA(0, 0), a2, voffA);
            PG8_BAR; PG8_WAIT_L(0); PG8_MMA(1, 0, At, B0); PG8_BAR; PG8_SCHED;
            PG8_STAGE(PG8_SB(0, 1), b2 + hstep, voffB);
            PG8_WAIT_V(6); PG8_BAR; PG8_MMA(1, 1, At, B1); PG8_BAR;
            PG8_LDB(B0, 1, 0); PG8_SCHED; PG8_LDA(At, 1, 0); PG8_STAGE(PG8_SA(0, 1), a2 + hstep, voffA);
            PG8_WAIT_L(8); PG8_BAR; PG8_WAIT_L(0); PG8_MMA(0, 0, At, B0); PG8_BAR; PG8_SCHED;
            PG8_LDB(B1, 1, 1); PG8_STAGE(PG8_SB(1, 0), b3, voffB);
            PG8_BAR; PG8_WAIT_L(0); PG8_MMA(0, 1, At, B1); PG8_BAR;
            PG8_LDA(At, 1, 1); PG8_STAGE(PG8_SA(1, 0), a3, voffA);
            PG8_BAR; PG8_WAIT_L(0); PG8_MMA(1, 0, At, B0); PG8_BAR; PG8_SCHED;
            PG8_STAGE(PG8_SB(1, 1), b3 + hstep, voffB);
            PG8_WAIT_V(6); PG8_BAR; PG8_MMA(1, 1, At, B1); PG8_BAR;
            }
        }
        if constexpr (ALIGN_EPI) { if (wr == 0) PG8_BAR; }
        if constexpr (!Epi::AFTER_DRAIN) { E(acc, cur, wr, wc, fr, fq); S.done(cur); }
        if (!has_next) break;
#pragma unroll
        for (int a = 0; a < 2; ++a)
#pragma unroll
            for (int b = 0; b < 2; ++b)
#pragma unroll
                for (int m = 0; m < 4; ++m)
#pragma unroll
                    for (int n = 0; n < 2; ++n) acc[a][b][m][n] = (f32x4){0.f, 0.f, 0.f, 0.f};
        cur = nxt; cA = nA; cB = nB; ++ui;
        if constexpr (ALIGN_EPI) { if (wr == 1) PG8_BAR; }
    }
    PG8_WAIT_V(0);
    if constexpr (!ALIGN_EPI) { if (wr == 0) PG8_BAR; }
    PG8_BAR;
    if constexpr (Epi::AFTER_DRAIN) { E.fused(acc, cur, wr, wc, fr, fq, lds, wid, lane); S.done(cur); }
#undef PG8_SA
#undef PG8_SB
#undef PG8_STAGE
#undef PG8_LDA
#undef PG8_LDB
#undef PG8_MMA
#undef PG8_WAIT_V
#undef PG8_WAIT_L
#undef PG8_BAR
#undef PG8_SCHED
}
}
#define GAS __attribute__((address_space(1)))
#define LAS __attribute__((address_space(3)))
typedef unsigned short bf16;
typedef unsigned v4u __attribute__((ext_vector_type(4)));
typedef float f32x4 __attribute__((ext_vector_type(4)));
#define LDS_WAIT() asm volatile("s_waitcnt lgkmcnt(0)" ::: "memory")

#ifndef FAST_ATTN
#define FAST_ATTN 1
#endif
#ifndef ATTN_LDS
#define ATTN_LDS 1
#endif
#ifndef FAST_LOCAL
#define FAST_LOCAL 1
#endif
#ifndef FAST_OUT
#define FAST_OUT 1
#endif
#ifndef MK_ONE_LAUNCH
#define MK_ONE_LAUNCH 1
#endif

constexpr int M = 16384, DM = 1024, SEQ = 4096, NCHK = 64, CHK = 64, DFF = 4096, DIN_SRC = 5640;
constexpr int LD1 = 1024, LD2 = 1536, N2_MQ = 0, N2_MO = 512, N2_MK = 1024, T_MK = 0, T_AV = 512, T_MV = 1024;
constexpr int NUNIT = 1024;
constexpr float EPS = 1e-6f;

constexpr size_t MiB = 1u << 20;
constexpr size_t WS_CTL = 0, CTL_ZERO_BYTES = 1 * MiB;
constexpr size_t WS_SSQ = 1 * MiB;
constexpr size_t WS_WG = 1 * MiB + 320 * 1024;
constexpr size_t WS_GATES = 1 * MiB + 512 * 1024;
constexpr size_t WS_NLOC = 2 * MiB;
constexpr size_t WS_MLOC = 2 * MiB + 512 * 1024;
constexpr size_t WS_BLAST = WS_MLOC + 4096, WS_MST = WS_BLAST + 4096;
constexpr size_t WS_W = 3 * MiB;
constexpr size_t W_IN = 0, W_A = (size_t)5632 * 1024, W_M = W_A + 512 * 1024, W_O = W_M + 512 * 1024, W_UP = W_O + 1024 * 1024, W_DN = W_UP + (size_t)4096 * 1024, W_END = W_DN + (size_t)4096 * 1024;
static_assert(WS_W + W_END * 2 <= 34 * MiB, "weights");
constexpr size_t WS_XB = 34 * MiB;
constexpr size_t WS_N1 = 66 * MiB;
constexpr size_t WS_N2 = 98 * MiB;
constexpr size_t WS_T = 146 * MiB;
constexpr size_t WS_MOUT = 146 * MiB;
constexpr size_t WS_Y = 162 * MiB;
constexpr size_t WS_Z = 66 * MiB;
constexpr size_t WS_ATT = 194 * MiB;
constexpr size_t WS_CLOC = 210 * MiB;
constexpr size_t WS_H = 66 * MiB;
constexpr size_t WS_END = 242 * MiB;

constexpr int RING_BYTES = 131072, LDSCTL_OFF = RING_BYTES, MISC_OFF = LDSCTL_OFF + 320, LDS_BYTES = 147456;
constexpr int CW_BAR = 4096;

__device__ __forceinline__ unsigned f2bf(float f) { unsigned u = __builtin_bit_cast(unsigned, f); return (u + 0x7fffu + ((u >> 16) & 1u)) >> 16; }
__device__ __forceinline__ unsigned pk2(float lo, float hi) { return f2bf(lo) | (f2bf(hi) << 16); }
__device__ __forceinline__ float bf2f(bf16 v) { return __uint_as_float(((unsigned)v) << 16); }
__device__ __forceinline__ float blo(unsigned w) { return __uint_as_float(w << 16); }
__device__ __forceinline__ float bhi(unsigned w) { return __uint_as_float(w & 0xffff0000u); }
__device__ __forceinline__ float sigmf(float x) { return __builtin_amdgcn_rcpf(1.0f + __expf(-x)); }
__device__ __forceinline__ float wave_sum(float v) {
#pragma unroll
    for (int o = 1; o < 64; o <<= 1) v += __shfl_xor(v, o);
    return v;
}

__device__ __forceinline__ int win_src_col(int n0) {
    if (n0 >= 3584) return n0 + 8;
    const int blk = n0 >> 9; const int st = blk == 0 ? 0 : blk == 1 ? 512 : blk == 2 ? 1536 : blk == 3 ? 3072 : blk == 4 ? 2048 : blk == 5 ? 1024 : 2560;
    return st + (n0 & 511);
}
__device__ __forceinline__ void transpose_item(const float* W, int ldw, int is_win, const float* g, bf16* WT, int K, int nblk, LAS float* scr, int item, int lane) {
    const int kb = item / nblk, nb = item % nblk, k0 = 64 * kb, n0 = 32 * nb, sc0 = is_win ? win_src_col(n0) : n0;
    float tv[32];
#pragma unroll
    for (int i = 0; i < 32; ++i) { const int kk = 2 * i + (lane >> 5); tv[i] = W[(size_t)(k0 + kk) * ldw + sc0 + (lane & 31)]; }
#pragma unroll
    for (int i = 0; i < 32; ++i) { const int kk = 2 * i + (lane >> 5); const float gv = g ? g[k0 + kk] : 1.0f; scr[kk * 33 + (lane & 31)] = tv[i] * gv; }
    LDS_WAIT(); asm volatile("" ::: "memory");
    const int c = lane & 7;
#pragma unroll
    for (int j = 0; j < 4; ++j) { const int n = (lane >> 3) + 8 * j; const LAS float* s = scr + (8 * c) * 33 + n;
        v4u o; o.x = pk2(s[0 * 33], s[1 * 33]); o.y = pk2(s[2 * 33], s[3 * 33]); o.z = pk2(s[4 * 33], s[5 * 33]); o.w = pk2(s[6 * 33], s[7 * 33]);
        *(v4u*)(WT + (size_t)(n0 + n) * K + k0 + 8 * c) = o; }
    LDS_WAIT(); asm volatile("" ::: "memory");
}

__device__ __forceinline__ f32x4 ld_bf4(const bf16* p) { const unsigned long long w = *(const unsigned long long*)p; return (f32x4){blo((unsigned)w), bhi((unsigned)w), blo((unsigned)(w >> 32)), bhi((unsigned)(w >> 32))}; }
__device__ __forceinline__ void gates_phase(const float* x, const bf16* xbf, int layer, const float* wg, const float* bi, const float* bf_, float* gates, LAS float* ldsf, int bid, int tid) {
    constexpr int XP = 132, WP = 1028;
    LAS float* WS = ldsf; LAS float* XS = ldsf + 8 * WP;
    for (int i = tid; i < 8 * 256; i += 512) { const int g = i >> 8, k4 = i & 255; *(LAS f32x4*)(WS + g * WP + 4 * k4) = *(const f32x4*)(wg + g * 1024 + 4 * k4); }
    const int lr = tid >> 5, lc = tid & 31, row = tid >> 3, gate = tid & 7, lane = tid & 63;
    for (int rb = bid; rb < M / 64; rb += 256) {
        const float* xb0 = x + (size_t)rb * 64 * DM; const bf16* xh0 = xbf + (size_t)rb * 64 * DM;
#define GLOAD(i, kc_) (layer == 0 ? *(const f32x4*)(xb0 + (size_t)(lr + 16 * (i)) * DM + (kc_) * 128 + 4 * lc) : ld_bf4(xh0 + (size_t)(lr + 16 * (i)) * DM + (kc_) * 128 + 4 * lc))
        f32x4 pre[4];
#pragma unroll
        for (int i = 0; i < 4; ++i) pre[i] = GLOAD(i, 0);
        float acc = 0.f, ss = 0.f;
        for (int kc = 0; kc < 8; ++kc) {
            __syncthreads();
#pragma unroll
            for (int i = 0; i < 4; ++i) *(LAS f32x4*)(XS + (lr + 16 * i) * XP + 4 * lc) = pre[i];
            if (kc + 1 < 8) {
#pragma unroll
                for (int i = 0; i < 4; ++i) pre[i] = GLOAD(i, kc + 1);
            }
            __syncthreads();
            const LAS float* xr = XS + row * XP; const LAS float* wr = WS + gate * WP + kc * 128;
#pragma unroll 8
            for (int k4 = 0; k4 < 32; ++k4) { const f32x4 xv = *(const LAS f32x4*)(xr + 4 * k4), wv = *(const LAS f32x4*)(wr + 4 * k4);
                acc += (xv.x * wv.x + xv.y * wv.y) + (xv.z * wv.z + xv.w * wv.w); ss += (xv.x * xv.x + xv.y * xv.y) + (xv.z * xv.z + xv.w * xv.w); }
        }
        const float rs = rsqrtf(ss * (1.0f / 1024.0f) + EPS);
        float val = acc * rs + (gate < 4 ? bi[gate] : bf_[gate - 4]);
        if (gate >= 4) val = fminf(val, 0.f) - log1pf(__expf(-fabsf(val)));
        gates[((size_t)rb * 64 + row) * 8 + gate] = val;
    }
#undef GLOAD
    __syncthreads();
}

__device__ __forceinline__ void attn_naive(const bf16* n1, const bf16* tT, const float* relb, bf16* att, int bid, int G, int wave, int lane) {
    for (int unit = bid; unit < 256; unit += G) {
        const int b = unit >> 6, c = unit & 63, h = wave, t = lane;
        const size_t tok = (size_t)b * SEQ + c * CHK + t;
        float q[64], acc[64];
        { const v4u* qp = (const v4u*)(n1 + tok * LD1 + h * 64);
#pragma unroll
          for (int i = 0; i < 8; ++i) { const v4u w = qp[i]; q[8 * i + 0] = blo(w.x) * 0.125f; q[8 * i + 1] = bhi(w.x) * 0.125f; q[8 * i + 2] = blo(w.y) * 0.125f; q[8 * i + 3] = bhi(w.y) * 0.125f;
              q[8 * i + 4] = blo(w.z) * 0.125f; q[8 * i + 5] = bhi(w.z) * 0.125f; q[8 * i + 6] = blo(w.w) * 0.125f; q[8 * i + 7] = bhi(w.w) * 0.125f; } }
#pragma unroll
        for (int d = 0; d < 64; ++d) acc[d] = 0.f;
        float mx = -1e30f, l = 0.f;
        const float* bh = relb + h * 513;
        for (int j = (c >= 8 ? 0 : 8 - c); j <= 8; ++j) {
            const size_t ktok0 = (size_t)b * SEQ + (size_t)(c - 8 + j) * CHK;
            for (int u = 0; u < 64; ++u) {
                int uo = u; asm volatile("" : "+v"(uo));
                const bf16* rowp = n1 + (ktok0 + uo) * LD1 + h * 64;
                const v4u* kp = (const v4u*)(rowp + 512); float s = 0.f;
#pragma unroll
                for (int i = 0; i < 8; ++i) { const v4u w = kp[i];
                    s += q[8 * i + 0] * blo(w.x) + q[8 * i + 1] * bhi(w.x) + q[8 * i + 2] * blo(w.y) + q[8 * i + 3] * bhi(w.y) + q[8 * i + 4] * blo(w.z) + q[8 * i + 5] * bhi(w.z) + q[8 * i + 6] * blo(w.w) + q[8 * i + 7] * bhi(w.w); }
                int rel = t - u + 64 * (8 - j); rel = rel < -256 ? -256 : (rel > 256 ? 256 : rel);
                s += bh[rel + 256];
                if (s > mx) { const float corr = __expf(mx - s); l *= corr;
#pragma unroll
                    for (int d = 0; d < 64; ++d) acc[d] *= corr;
                    mx = s; }
                const float p = __expf(s - mx); l += p;
                const bf16* vp = tT + (size_t)(T_AV + h * 64) * M + (ktok0 + uo);
#pragma unroll
                for (int d = 0; d < 64; ++d) acc[d] += p * bf2f(vp[(size_t)d * M]);
            }
        }
        const float inv = 1.0f / l;
        v4u* op = (v4u*)(att + tok * 512 + h * 64);
#pragma unroll
        for (int i = 0; i < 8; ++i) { v4u o; o.x = pk2(acc[8 * i + 0] * inv, acc[8 * i + 1] * inv); o.y = pk2(acc[8 * i + 2] * inv, acc[8 * i + 3] * inv); o.z = pk2(acc[8 * i + 4] * inv, acc[8 * i + 5] * inv); o.w = pk2(acc[8 * i + 6] * inv, acc[8 * i + 7] * inv); op[i] = o; }
    }
}

typedef short bf16x8_t __attribute__((ext_vector_type(8)));
typedef float f32x16_t __attribute__((ext_vector_type(16)));
typedef float f32x2_t __attribute__((ext_vector_type(2))); typedef __bf16 bf16x2_t __attribute__((ext_vector_type(2)));
__device__ __forceinline__ unsigned cvtpk(float lo, float hi) { f32x2_t v = {lo, hi}; bf16x2_t b = __builtin_convertvector(v, bf16x2_t); return __builtin_bit_cast(unsigned, b); }
__device__ __forceinline__ void attn_mfma(const bf16* n1, const bf16* tT, const float* relb, bf16* att, LAS float* ldsf, int bid, int G, int wave, int lane) {
    constexpr float LOG2E = 1.4426950408889634f, SC = 0.125f * LOG2E;
    const int h = wave, r32 = lane & 31, hi = lane >> 5;
    LAS float* ext = ldsf + wave * 384;
    for (int r = lane; r < 384; r += 64) { const int rel = r - 63; const int idx = (rel > 256 ? 256 : rel) + 256; ext[r] = relb[h * 513 + idx] * LOG2E; }
    const float bconst = relb[h * 513 + 512] * LOG2E;
    LDS_WAIT();
    const int pir = (r32 & ~12) | ((r32 & 4) << 1) | ((r32 & 8) >> 1);
    for (int unit = bid; unit < 256; unit += G) {
        const int b = unit >> 6, c = unit & 63; const size_t tq0 = (size_t)b * SEQ + c * CHK;
        bf16x8_t qf[2][4];
#pragma unroll
        for (int qb = 0; qb < 2; ++qb)
#pragma unroll
            for (int s = 0; s < 4; ++s) qf[qb][s] = *(const bf16x8_t*)(n1 + (tq0 + qb * 32 + r32) * LD1 + h * 64 + 32 * hi + 8 * s);
        f32x16_t o[2][2];
#pragma unroll
        for (int qb = 0; qb < 2; ++qb)
#pragma unroll
            for (int db = 0; db < 2; ++db)
#pragma unroll
                for (int i = 0; i < 16; ++i) o[qb][db][i] = 0.f;
        float mrun[2] = {-1e30f, -1e30f}, lrun[2] = {0.f, 0.f};
        const int kb0 = (c >= 8 ? 0 : 8 - c) * 2;
        bf16x8_t kf[4], vf[2][2];
        { const size_t ktok = (size_t)b * SEQ + (size_t)(c - 8) * CHK + (size_t)kb0 * 32;
#pragma unroll
          for (int s = 0; s < 4; ++s) kf[s] = *(const bf16x8_t*)(n1 + (ktok + pir) * LD1 + 512 + h * 64 + 32 * hi + 8 * s);
#pragma unroll
          for (int db = 0; db < 2; ++db)
#pragma unroll
              for (int s2 = 0; s2 < 2; ++s2) vf[db][s2] = *(const bf16x8_t*)(tT + (size_t)(T_AV + h * 64 + db * 32 + r32) * M + ktok + 16 * s2 + 8 * hi); }
        for (int kbI = kb0; kbI < 18; ++kbI) {
            const int j = kbI >> 1, kb = kbI & 1;
            bf16x8_t kn[4], vn[2][2];
            { const int nx = kbI + 1 < 18 ? kbI + 1 : 17; const size_t ktok = (size_t)b * SEQ + (size_t)(c - 8) * CHK + (size_t)nx * 32;
#pragma unroll
              for (int s = 0; s < 4; ++s) kn[s] = *(const bf16x8_t*)(n1 + (ktok + pir) * LD1 + 512 + h * 64 + 32 * hi + 8 * s);
#pragma unroll
              for (int db = 0; db < 2; ++db)
#pragma unroll
                  for (int s2 = 0; s2 < 2; ++s2) vn[db][s2] = *(const bf16x8_t*)(tT + (size_t)(T_AV + h * 64 + db * 32 + r32) * M + ktok + 16 * s2 + 8 * hi); }
#pragma unroll
            for (int qb = 0; qb < 2; ++qb) {
                f32x16_t sa;
#pragma unroll
                for (int i = 0; i < 16; ++i) sa[i] = 0.f;
#pragma unroll
                for (int s = 0; s < 4; ++s) sa = __builtin_amdgcn_mfma_f32_32x32x16_bf16(kf[s], qf[qb][s], sa, 0, 0, 0);
                float sv[16];
                if (j >= 4) {
                    const int rbase = (qb * 32 + r32) - (kb * 32 + 8 * hi) + 64 * (8 - j) + 63;
#pragma unroll
                    for (int i = 0; i < 16; ++i) sv[i] = sa[i] * SC + ext[rbase - (i & 7) - 16 * (i >> 3)];
                } else {
#pragma unroll
                    for (int i = 0; i < 16; ++i) sv[i] = sa[i] * SC + bconst;
                }
                float mx = sv[0];
#pragma unroll
                for (int i = 1; i < 16; ++i) mx = fmaxf(mx, sv[i]);
                mx = fmaxf(mx, __shfl_xor(mx, 32));
                const float mnew = fmaxf(mrun[qb], mx), alpha = __builtin_amdgcn_exp2f(mrun[qb] - mnew); mrun[qb] = mnew;
                float ps = 0.f;
#pragma unroll
                for (int i = 0; i < 16; ++i) { sv[i] = __builtin_amdgcn_exp2f(sv[i] - mnew); ps += sv[i]; }
                lrun[qb] = lrun[qb] * alpha + ps;
#pragma unroll
                for (int db = 0; db < 2; ++db)
#pragma unroll
                    for (int i = 0; i < 16; ++i) o[qb][db][i] *= alpha;
                bf16x8_t pf[2];
#pragma unroll
                for (int s2 = 0; s2 < 2; ++s2) { v4u w; w.x = cvtpk(sv[8 * s2 + 0], sv[8 * s2 + 1]); w.y = cvtpk(sv[8 * s2 + 2], sv[8 * s2 + 3]); w.z = cvtpk(sv[8 * s2 + 4], sv[8 * s2 + 5]); w.w = cvtpk(sv[8 * s2 + 6], sv[8 * s2 + 7]);
                    pf[s2] = __builtin_bit_cast(bf16x8_t, w); }
#pragma unroll
                for (int db = 0; db < 2; ++db)
#pragma unroll
                    for (int s2 = 0; s2 < 2; ++s2) o[qb][db] = __builtin_amdgcn_mfma_f32_32x32x16_bf16(vf[db][s2], pf[s2], o[qb][db], 0, 0, 0);
            }
#pragma unroll
            for (int s = 0; s < 4; ++s) kf[s] = kn[s];
#pragma unroll
            for (int db = 0; db < 2; ++db)
#pragma unroll
                for (int s2 = 0; s2 < 2; ++s2) vf[db][s2] = vn[db][s2];
        }
#pragma unroll
        for (int qb = 0; qb < 2; ++qb) {
            const float lt = lrun[qb] + __shfl_xor(lrun[qb], 32), inv = 1.0f / lt;
            bf16* op = att + (tq0 + qb * 32 + r32) * 512 + h * 64 + 4 * hi;
#pragma unroll
            for (int db = 0; db < 2; ++db)
#pragma unroll
                for (int g4 = 0; g4 < 4; ++g4) { unsigned long long w = (unsigned long long)cvtpk(o[qb][db][4 * g4 + 0] * inv, o[qb][db][4 * g4 + 1] * inv) | ((unsigned long long)cvtpk(o[qb][db][4 * g4 + 2] * inv, o[qb][db][4 * g4 + 3] * inv) << 32);
                    *(unsigned long long*)(op + db * 32 + 8 * g4) = w; }
        }
    }
}

__device__ __forceinline__ float wave_max(float v) {
#pragma unroll
    for (int o = 1; o < 64; o <<= 1) v = fmaxf(v, __shfl_xor(v, o));
    return v;
}
__device__ __forceinline__ float scan_add(float v, int lane) {
#pragma unroll
    for (int o = 1; o < 64; o <<= 1) { const float t = __shfl_up(v, o); if (lane >= o) v += t; }
    return v;
}
__device__ __forceinline__ float scan_max(float v, int lane) {
#pragma unroll
    for (int o = 1; o < 64; o <<= 1) { const float t = __shfl_up(v, o); if (lane >= o) v = fmaxf(v, t); }
    return v;
}
__device__ __forceinline__ bf16x8_t pack8(const float* v) { v4u w; w.x = cvtpk(v[0], v[1]); w.y = cvtpk(v[2], v[3]); w.z = cvtpk(v[4], v[5]); w.w = cvtpk(v[6], v[7]); return __builtin_bit_cast(bf16x8_t, w); }

__device__ __forceinline__ void attn_mfma_lds(const bf16* n1, const bf16* tT, const float* relb, bf16* att, LAS unsigned char* ldsb, int bid, int G, int wave, int lane) {
    constexpr float LOG2E = 1.4426950408889634f, SC = 0.125f * LOG2E;
    const int h = wave, r32 = lane & 31, hi = lane >> 5;
    LAS float* ext = (LAS float*)(ldsb + RING_BYTES + 1024) + wave * 384;
    for (int r = lane; r < 384; r += 64) { const int rel = r - 63; const int idx = (rel > 256 ? 256 : rel) + 256; ext[r] = relb[h * 513 + idx] * LOG2E; }
    const float bconst = relb[h * 513 + 512] * LOG2E;
    LAS unsigned char* KI = ldsb + wave * 8192; LAS unsigned char* VI = KI + 4096;
    const int pir = (r32 & ~12) | ((r32 & 4) << 1) | ((r32 & 8) >> 1);
    const int krow_s = lane >> 3, kch_s = lane & 7, vrow_s = lane >> 2, vch_s = lane & 3;
    const int kwev = krow_s * 128 + ((kch_s ^ (krow_s >> 1)) << 4), kwod = krow_s * 128 + ((kch_s ^ (krow_s >> 1) ^ 4) << 4);
    const int vw = vrow_s * 64 + ((vch_s ^ ((vrow_s >> 2) & 3)) << 4);
    int koff[4], voff[2];
#pragma unroll
    for (int s = 0; s < 4; ++s) koff[s] = pir * 128 + (((4 * hi + s) ^ ((pir >> 1) & 7)) << 4);
#pragma unroll
    for (int s2 = 0; s2 < 2; ++s2) voff[s2] = r32 * 64 + (((2 * s2 + hi) ^ ((r32 >> 2) & 3)) << 4);
    const bf16* kbase = n1 + (size_t)krow_s * LD1 + 512 + h * 64 + kch_s * 8;
    const bf16* vbase = tT + (size_t)(T_AV + h * 64 + vrow_s) * M + vch_s * 8;
    for (int unit = bid; unit < 256; unit += G) {
        const int b = unit >> 6, c = unit & 63; const size_t tq0 = (size_t)b * SEQ + c * CHK;
        bf16x8_t qf[2][4];
#pragma unroll
        for (int qb = 0; qb < 2; ++qb)
#pragma unroll
            for (int s = 0; s < 4; ++s) qf[qb][s] = *(const bf16x8_t*)(n1 + (tq0 + qb * 32 + r32) * LD1 + h * 64 + 32 * hi + 8 * s);
        f32x16_t o[2][2];
#pragma unroll
        for (int qb = 0; qb < 2; ++qb)
#pragma unroll
            for (int db = 0; db < 2; ++db)
#pragma unroll
                for (int i = 0; i < 16; ++i) o[qb][db][i] = 0.f;
        float mrun[2] = {-1e30f, -1e30f}, lrun[2] = {0.f, 0.f};
        const int kb0 = (c >= 8 ? 0 : 8 - c) * 2;
        const size_t kt00 = (size_t)b * SEQ + (size_t)(c - 8) * CHK;
        v4u gk[4], gv[4];
        { const size_t ktok = kt00 + (size_t)kb0 * 32;
#pragma unroll
          for (int i = 0; i < 4; ++i) { gk[i] = *(const v4u*)(kbase + (ktok + 8 * i) * LD1); gv[i] = *(const v4u*)(vbase + (size_t)(16 * i) * M + ktok); } }
        for (int kbI = kb0; kbI < 18; ++kbI) {
            const int j = kbI >> 1, kb = kbI & 1;
#pragma unroll
            for (int i = 0; i < 4; ++i) { *(LAS v4u*)(KI + ((i & 1) ? kwod : kwev) + 1024 * i) = gk[i]; *(LAS v4u*)(VI + vw + 1024 * i) = gv[i]; }
            { const int nx = kbI + 1 < 18 ? kbI + 1 : 17; const size_t ktok = kt00 + (size_t)nx * 32;
#pragma unroll
              for (int i = 0; i < 4; ++i) { gk[i] = *(const v4u*)(kbase + (ktok + 8 * i) * LD1); gv[i] = *(const v4u*)(vbase + (size_t)(16 * i) * M + ktok); } }
            bf16x8_t kf[4], vf[2][2];
#pragma unroll
            for (int s = 0; s < 4; ++s) kf[s] = *(const LAS bf16x8_t*)(KI + koff[s]);
#pragma unroll
            for (int db = 0; db < 2; ++db)
#pragma unroll
                for (int s2 = 0; s2 < 2; ++s2) vf[db][s2] = *(const LAS bf16x8_t*)(VI + db * 2048 + voff[s2]);
#pragma unroll
            for (int qb = 0; qb < 2; ++qb) {
                f32x16_t sa;
#pragma unroll
                for (int i = 0; i < 16; ++i) sa[i] = 0.f;
#pragma unroll
                for (int s = 0; s < 4; ++s) sa = __builtin_amdgcn_mfma_f32_32x32x16_bf16(kf[s], qf[qb][s], sa, 0, 0, 0);
                float sv[16];
                if (j >= 4) {
                    const int rbase = (qb * 32 + r32) - (kb * 32 + 8 * hi) + 64 * (8 - j) + 63;
#pragma unroll
                    for (int i = 0; i < 16; ++i) sv[i] = sa[i] * SC + ext[rbase - (i & 7) - 16 * (i >> 3)];
                } else {
#pragma unroll
                    for (int i = 0; i < 16; ++i) sv[i] = sa[i] * SC + bconst;
                }
                float mx = sv[0];
#pragma unroll
                for (int i = 1; i < 16; ++i) mx = fmaxf(mx, sv[i]);
                mx = fmaxf(mx, __shfl_xor(mx, 32));
                const float mnew = fmaxf(mrun[qb], mx), alpha = __builtin_amdgcn_exp2f(mrun[qb] - mnew); mrun[qb] = mnew;
                float ps = 0.f;
#pragma unroll
                for (int i = 0; i < 16; ++i) { sv[i] = __builtin_amdgcn_exp2f(sv[i] - mnew); ps += sv[i]; }
                lrun[qb] = lrun[qb] * alpha + ps;
#pragma unroll
                for (int db = 0; db < 2; ++db)
#pragma unroll
                    for (int i = 0; i < 16; ++i) o[qb][db][i] *= alpha;
                bf16x8_t pf[2] = {pack8(sv), pack8(sv + 8)};
#pragma unroll
                for (int db = 0; db < 2; ++db)
#pragma unroll
                    for (int s2 = 0; s2 < 2; ++s2) o[qb][db] = __builtin_amdgcn_mfma_f32_32x32x16_bf16(vf[db][s2], pf[s2], o[qb][db], 0, 0, 0);
            }
        }
#pragma unroll
        for (int qb = 0; qb < 2; ++qb) {
            const float lt = lrun[qb] + __shfl_xor(lrun[qb], 32), inv = 1.0f / lt;
            bf16* op = att + (tq0 + qb * 32 + r32) * 512 + h * 64 + 4 * hi;
#pragma unroll
            for (int db = 0; db < 2; ++db)
#pragma unroll
                for (int g4 = 0; g4 < 4; ++g4) { unsigned long long w = (unsigned long long)cvtpk(o[qb][db][4 * g4 + 0] * inv, o[qb][db][4 * g4 + 1] * inv) | ((unsigned long long)cvtpk(o[qb][db][4 * g4 + 2] * inv, o[qb][db][4 * g4 + 3] * inv) << 32);
                    *(unsigned long long*)(op + db * 32 + 8 * g4) = w; }
        }
    }
}


__device__ __forceinline__ void mlstm_local_mfma(const bf16* tT, const float* gates, const float* cw, const float* cb, bf16* cloc, float* nloc, float* mloc, float* blast, LAS float* ldsf, int bid, int G, int wave, int lane) {
    LAS float* wsm = ldsf + wave * 64;
    const int r32 = lane & 31, hi = lane >> 5;
    for (int task = bid * 8 + wave; task < 2 * NUNIT; task += G * 8) {
        const int unit = task >> 1, kh = task & 1, b = unit >> 8, c = (unit >> 2) & 63, h = unit & 3; const size_t tok0 = (size_t)b * SEQ + c * CHK;
        const float lf = gates[(tok0 + lane) * 8 + 4 + h], ig = gates[(tok0 + lane) * 8 + h];
        const float cum = scan_add(lf, lane), bl = __shfl(cum, 63), a = bl - cum + ig, mxa = wave_max(a);
        wsm[lane] = __expf(a - mxa);
        LDS_WAIT();
        if (kh == 0 && lane == 0) { mloc[unit] = mxa; blast[unit] = bl; }
        f32x16_t acc[2][4];
#pragma unroll
        for (int kb2 = 0; kb2 < 2; ++kb2)
#pragma unroll
            for (int vb = 0; vb < 4; ++vb)
#pragma unroll
                for (int i = 0; i < 16; ++i) acc[kb2][vb][i] = 0.f;
        float nsum[2] = {0.f, 0.f};
        float cwr[2][4], cbr[2];
#pragma unroll
        for (int kb2 = 0; kb2 < 2; ++kb2) { const int ch = 512 + h * 128 + kh * 64 + kb2 * 32 + r32; cbr[kb2] = cb[ch];
#pragma unroll
            for (int j = 0; j < 4; ++j) cwr[kb2][j] = cw[j * 1024 + ch]; }
#pragma unroll
        for (int s = 0; s < 4; ++s) {
            const int l0 = 16 * s + 8 * hi;
            float wv[8];
            { const f32x4 w0 = *(const LAS f32x4*)(wsm + l0), w1 = *(const LAS f32x4*)(wsm + l0 + 4); wv[0] = w0.x; wv[1] = w0.y; wv[2] = w0.z; wv[3] = w0.w; wv[4] = w1.x; wv[5] = w1.y; wv[6] = w1.z; wv[7] = w1.w; }
            bf16x8_t af[2];
#pragma unroll
            for (int kb2 = 0; kb2 < 2; ++kb2) {
                const bf16* rp = tT + (size_t)(T_MK + h * 128 + kh * 64 + kb2 * 32 + r32) * M + tok0 + l0;
                const v4u cur = *(const v4u*)rp; unsigned long long prev = *(const unsigned long long*)(rp - 4);
                if (c == 0 && l0 == 0) prev = 0ull;
                float x[11];
                x[0] = bhi((unsigned)prev); x[1] = blo((unsigned)(prev >> 32)); x[2] = bhi((unsigned)(prev >> 32));
                x[3] = blo(cur.x); x[4] = bhi(cur.x); x[5] = blo(cur.y); x[6] = bhi(cur.y); x[7] = blo(cur.z); x[8] = bhi(cur.z); x[9] = blo(cur.w); x[10] = bhi(cur.w);
                float kv[8];
#pragma unroll
                for (int j = 0; j < 8; ++j) { const float av = cbr[kb2] + cwr[kb2][0] * x[j] + cwr[kb2][1] * x[j + 1] + cwr[kb2][2] * x[j + 2] + cwr[kb2][3] * x[j + 3];
                    const float kw = av * sigmf(av) * 0.08838834764831845f * wv[j]; kv[j] = kw; nsum[kb2] += kw; }
                af[kb2] = pack8(kv);
            }
#pragma unroll
            for (int vb = 0; vb < 4; ++vb) {
                const bf16x8_t vfr = *(const bf16x8_t*)(tT + (size_t)(T_MV + h * 128 + vb * 32 + r32) * M + tok0 + l0);
#pragma unroll
                for (int kb2 = 0; kb2 < 2; ++kb2) acc[kb2][vb] = __builtin_amdgcn_mfma_f32_32x32x16_bf16(af[kb2], vfr, acc[kb2][vb], 0, 0, 0);
            }
        }
#pragma unroll
        for (int kb2 = 0; kb2 < 2; ++kb2) { const float ns = nsum[kb2] + __shfl_xor(nsum[kb2], 32); if (hi == 0) nloc[unit * 128 + kh * 64 + kb2 * 32 + r32] = ns; }
#pragma unroll
        for (int kb2 = 0; kb2 < 2; ++kb2)
#pragma unroll
            for (int vb = 0; vb < 4; ++vb) { bf16* cp = cloc + (size_t)unit * 16384 + (size_t)(vb * 32 + r32) * 128 + kh * 64 + kb2 * 32 + 4 * hi;
#pragma unroll
                for (int g4 = 0; g4 < 4; ++g4) *(unsigned long long*)(cp + 8 * g4) = (unsigned long long)cvtpk(acc[kb2][vb][4 * g4 + 0], acc[kb2][vb][4 * g4 + 1]) | ((unsigned long long)cvtpk(acc[kb2][vb][4 * g4 + 2], acc[kb2][vb][4 * g4 + 3]) << 32); }
    }
}

__device__ __forceinline__ void conv_prepass(const bf16* n2, const float* cw, const float* cb, bf16* qk, int bid, int G, int tid) {
    for (int it = bid * 512 + tid; it < (M / 16) * 128; it += G * 512) {
        const int cg = it & 127, tr = it >> 7, ch0 = 8 * cg; const size_t t0 = (size_t)tr * 16;
        const bf16* src = n2 + (ch0 < 512 ? N2_MQ + ch0 : N2_MK + (ch0 - 512));
        const float sc = ch0 < 512 ? 1.0f : 0.08838834764831845f;
        float w[4][8], bb[8];
#pragma unroll
        for (int e = 0; e < 8; ++e) { bb[e] = cb[ch0 + e];
#pragma unroll
            for (int j = 0; j < 4; ++j) w[j][e] = cw[j * 1024 + ch0 + e]; }
        float x0[8], x1[8], x2[8];
        const bool first = (t0 & (SEQ - 1)) == 0;
#pragma unroll
        for (int r = 0; r < 3; ++r) { v4u v = {0u, 0u, 0u, 0u}; if (!first) v = *(const v4u*)(src + (t0 - 3 + r) * LD2);
            float* d = r == 0 ? x0 : (r == 1 ? x1 : x2);
            d[0] = blo(v.x); d[1] = bhi(v.x); d[2] = blo(v.y); d[3] = bhi(v.y); d[4] = blo(v.z); d[5] = bhi(v.z); d[6] = blo(v.w); d[7] = bhi(v.w); }
#pragma unroll 4
        for (int i = 0; i < 16; ++i) {
            const v4u v = *(const v4u*)(src + (t0 + i) * LD2); float x3[8] = {blo(v.x), bhi(v.x), blo(v.y), bhi(v.y), blo(v.z), bhi(v.z), blo(v.w), bhi(v.w)}; float o[8];
#pragma unroll
            for (int e = 0; e < 8; ++e) { const float a = bb[e] + w[0][e] * x0[e] + w[1][e] * x1[e] + w[2][e] * x2[e] + w[3][e] * x3[e]; o[e] = a * sigmf(a) * sc; x0[e] = x1[e]; x1[e] = x2[e]; x2[e] = x3[e]; }
            v4u ov; ov.x = cvtpk(o[0], o[1]); ov.y = cvtpk(o[2], o[3]); ov.z = cvtpk(o[4], o[5]); ov.w = cvtpk(o[6], o[7]);
            *(v4u*)(qk + (t0 + i) * 1024 + ch0) = ov;
        }
    }
}

__device__ __forceinline__ void mlstm_out_mfma(const bf16* qk, const bf16* n2, const bf16* tT, const float* gates, const bf16* cst, const float* nst, const float* mst, const float* mhg, bf16* mout, LAS float* ldsf, int bid, int G, int wave, int lane) {
    LAS float* sm = ldsf + wave * 256;
    const int r32 = lane & 31, hi = lane >> 5;
    const int pir = (r32 & ~12) | ((r32 & 4) << 1) | ((r32 & 8) >> 1);
    for (int task = bid * 8 + wave; task < 2 * NUNIT; task += G * 8) {
        const int unit = task >> 1, tb = task & 1, b = unit >> 8, c = (unit >> 2) & 63, h = unit & 3; const size_t tok0 = (size_t)b * SEQ + c * CHK;
        { const float lf = gates[(tok0 + lane) * 8 + 4 + h], ig = gates[(tok0 + lane) * 8 + h];
          const float cum = scan_add(lf, lane), e = ig - cum, pm = scan_max(e, lane), g = cum + mst[unit], mt = fmaxf(g, cum + pm);
          sm[lane] = e; sm[64 + lane] = cum; sm[128 + lane] = mt; sm[192 + lane] = __expf(g - mt); }
        LDS_WAIT();
        const int t = tb * 32 + r32; const float bc_t = sm[64 + t], mt_t = sm[128 + t], in_t = sm[192 + t];
        bf16x8_t qf[8];
#pragma unroll
        for (int s = 0; s < 8; ++s) qf[s] = *(const bf16x8_t*)(qk + (tok0 + t) * 1024 + h * 128 + 64 * hi + 8 * s);
        float nq = 0.f;
#pragma unroll
        for (int s = 0; s < 8; ++s) { const f32x4 n0 = *(const f32x4*)(nst + unit * 128 + 64 * hi + 8 * s), n1 = *(const f32x4*)(nst + unit * 128 + 64 * hi + 8 * s + 4); const v4u q = __builtin_bit_cast(v4u, qf[s]);
            nq += n0.x * blo(q.x) + n0.y * bhi(q.x) + n0.z * blo(q.y) + n0.w * bhi(q.y) + n1.x * blo(q.z) + n1.y * bhi(q.z) + n1.z * blo(q.w) + n1.w * bhi(q.w); }
        nq += __shfl_xor(nq, 32);
        f32x16_t num[4];
#pragma unroll
        for (int vb = 0; vb < 4; ++vb) {
#pragma unroll
            for (int i = 0; i < 16; ++i) num[vb][i] = 0.f;
#pragma unroll
            for (int s = 0; s < 8; ++s) { const bf16x8_t cf = *(const bf16x8_t*)(cst + (size_t)unit * 16384 + (size_t)(vb * 32 + r32) * 128 + 64 * hi + 8 * s);
                num[vb] = __builtin_amdgcn_mfma_f32_32x32x16_bf16(cf, qf[s], num[vb], 0, 0, 0); }
#pragma unroll
            for (int i = 0; i < 16; ++i) num[vb][i] *= in_t;
        }
        float dsum = 0.f;
        for (int sb = 0; sb <= tb; ++sb) {
            f32x16_t sa;
#pragma unroll
            for (int i = 0; i < 16; ++i) sa[i] = 0.f;
#pragma unroll
            for (int s = 0; s < 8; ++s) { const bf16x8_t kf = *(const bf16x8_t*)(qk + (tok0 + sb * 32 + pir) * 1024 + 512 + h * 128 + 64 * hi + 8 * s);
                sa = __builtin_amdgcn_mfma_f32_32x32x16_bf16(kf, qf[s], sa, 0, 0, 0); }
            float dv[16];
#pragma unroll
            for (int hf = 0; hf < 2; ++hf) { const int sbase = sb * 32 + 16 * hf + 8 * hi;
                const f32x4 e0 = *(const LAS f32x4*)(sm + sbase), e1 = *(const LAS f32x4*)(sm + sbase + 4); const float ev[8] = {e0.x, e0.y, e0.z, e0.w, e1.x, e1.y, e1.z, e1.w};
#pragma unroll
                for (int j = 0; j < 8; ++j) { float val = sa[8 * hf + j] * __expf(bc_t - mt_t + ev[j]); val = (sbase + j > t) ? 0.f : val; dv[8 * hf + j] = val; dsum += val; } }
            bf16x8_t pf[2] = {pack8(dv), pack8(dv + 8)};
#pragma unroll
            for (int vb = 0; vb < 4; ++vb)
#pragma unroll
                for (int s2 = 0; s2 < 2; ++s2) { const bf16x8_t vfr = *(const bf16x8_t*)(tT + (size_t)(T_MV + h * 128 + vb * 32 + r32) * M + tok0 + sb * 32 + 16 * s2 + 8 * hi);
                    num[vb] = __builtin_amdgcn_mfma_f32_32x32x16_bf16(vfr, pf[s2], num[vb], 0, 0, 0); }
        }
        dsum += __shfl_xor(dsum, 32);
        const float den = in_t * nq + dsum, inv = 1.0f / fmaxf(fabsf(den), __expf(-mt_t));
        float ss = 0.f;
#pragma unroll
        for (int vb = 0; vb < 4; ++vb)
#pragma unroll
            for (int i = 0; i < 16; ++i) { const float hv = num[vb][i] * inv; num[vb][i] = hv; ss += hv * hv; }
        ss += __shfl_xor(ss, 32);
        const float rms = rsqrtf(ss * (1.0f / 128.0f) + EPS);
#pragma unroll
        for (int vb = 0; vb < 4; ++vb)
#pragma unroll
            for (int g4 = 0; g4 < 4; ++g4) { const int v0 = vb * 32 + 8 * g4 + 4 * hi;
                const unsigned long long mo = *(const unsigned long long*)(n2 + (tok0 + t) * LD2 + N2_MO + h * 128 + v0); const f32x4 gg = *(const f32x4*)(mhg + h * 128 + v0);
                const float o0 = sigmf(blo((unsigned)mo)) * num[vb][4 * g4 + 0] * rms * gg.x, o1 = sigmf(bhi((unsigned)mo)) * num[vb][4 * g4 + 1] * rms * gg.y;
                const float o2 = sigmf(blo((unsigned)(mo >> 32))) * num[vb][4 * g4 + 2] * rms * gg.z, o3 = sigmf(bhi((unsigned)(mo >> 32))) * num[vb][4 * g4 + 3] * rms * gg.w;
                *(unsigned long long*)(mout + (tok0 + t) * 512 + h * 128 + v0) = (unsigned long long)cvtpk(o0, o1) | ((unsigned long long)cvtpk(o2, o3) << 32); }
    }
}

__device__ __forceinline__ void mlstm_local_naive(const bf16* n2, const bf16* tT, const float* gates, const float* cw, const float* cb, bf16* cloc, float* nloc, float* mloc, float* blast, float* lds, int bid, int G, int tid) {
    float* KS = lds; float* WV = lds + 8192; float* sm = lds + 16384;
    for (int unit = bid; unit < NUNIT; unit += G) {
        const int b = unit >> 8, c = (unit >> 2) & 63, h = unit & 3; const size_t tok0 = (size_t)b * SEQ + c * CHK;
        if (tid < 64) { sm[tid] = gates[(tok0 + tid) * 8 + 4 + h]; sm[64 + tid] = gates[(tok0 + tid) * 8 + h]; }
        __syncthreads();
        if (tid == 0) { float cum = 0.f; for (int l = 0; l < 64; ++l) { cum += sm[l]; sm[128 + l] = cum; }
            float mxa = -INFINITY; for (int l = 0; l < 64; ++l) { const float a = cum - sm[128 + l] + sm[64 + l]; sm[192 + l] = a; mxa = fmaxf(mxa, a); }
            for (int l = 0; l < 64; ++l) sm[192 + l] = __expf(sm[192 + l] - mxa);
            sm[256] = mxa; sm[257] = cum; }
        __syncthreads();
        for (int e = tid; e < 8192; e += 512) { const int l = e >> 7, d = e & 127, pos = c * CHK + l, ch = 512 + h * 128 + d;
            float a = cb[ch];
#pragma unroll
            for (int j = 0; j < 4; ++j) { const int p = pos - 3 + j; if (p >= 0) a += cw[j * 1024 + ch] * bf2f(n2[((size_t)b * SEQ + p) * LD2 + N2_MK + h * 128 + d]); }
            KS[e] = a * sigmf(a) * 0.08838834764831845f;
            WV[e] = sm[192 + l] * bf2f(tT[(size_t)(T_MV + h * 128 + d) * M + tok0 + l]); }
        __syncthreads();
        { const int k = tid & 127, vg = tid >> 7; float a[32];
#pragma unroll
          for (int i = 0; i < 32; ++i) a[i] = 0.f;
          for (int l = 0; l < 64; ++l) { const float kk = KS[l * 128 + k];
#pragma unroll
              for (int i = 0; i < 32; ++i) a[i] += WV[l * 128 + vg * 32 + i] * kk; }
          bf16* cp = cloc + (size_t)unit * 16384 + (size_t)(vg * 32) * 128 + k;
#pragma unroll
          for (int i = 0; i < 32; ++i) cp[i * 128] = (bf16)f2bf(a[i]); }
        if (tid < 128) { float s = 0.f; for (int l = 0; l < 64; ++l) s += sm[192 + l] * KS[l * 128 + tid]; nloc[unit * 128 + tid] = s; }
        if (tid == 0) { mloc[unit] = sm[256]; blast[unit] = sm[257]; }
        __syncthreads();
    }
}

__device__ __forceinline__ void mlstm_scan(bf16* cloc, float* nloc, const float* mloc, const float* blast, float* mst, int bid, int G, int tid, int dry) {
    const int gt = bid * 512 + tid, NT = G * 512;
    for (int it = gt; it < 16 * 8192; it += NT) {
        const int bh = it >> 13, e2 = it & 8191, b = bh >> 2, h = bh & 3; float C0 = 0.f, C1 = 0.f, m = 0.f;
        unsigned* base = (unsigned*)cloc + e2; const int u0 = b * NCHK * 4 + h;
        constexpr int PD = 16;
        unsigned w[PD]; float ml[PD], bl[PD];
#pragma unroll
        for (int i = 0; i < PD; ++i) { const int unit = u0 + 4 * i; w[i] = base[(size_t)unit * 8192]; ml[i] = mloc[unit]; bl[i] = blast[unit]; }
        for (int c0 = 0; c0 < NCHK; c0 += PD) {
#pragma unroll
            for (int i = 0; i < PD; ++i) {
                const int unit = u0 + 4 * (c0 + i); const unsigned wc = w[i]; const float mlc = ml[i], blc = bl[i];
                if (c0 + PD < NCHK) { const int un = unit + 4 * PD; w[i] = base[(size_t)un * 8192]; ml[i] = mloc[un]; bl[i] = blast[un]; }
                if (!dry) base[(size_t)unit * 8192] = pk2(C0, C1);
                if (e2 == 0 && !dry) mst[unit] = m;
                const float mn = fmaxf(blc + m, mlc), sp = __expf(blc + m - mn), sl = __expf(mlc - mn);
                C0 = sp * C0 + sl * blo(wc); C1 = sp * C1 + sl * bhi(wc); m = mn;
            }
        }
    }
    for (int it = gt; it < 16 * 128; it += NT) {
        const int bh = it >> 7, k = it & 127, b = bh >> 2, h = bh & 3; float n = 0.f, m = 0.f;
        for (int c = 0; c < NCHK; ++c) { const int unit = (b * NCHK + c) * 4 + h; const float ml = mloc[unit], bl = blast[unit];
            const float nl = nloc[unit * 128 + k]; if (!dry) nloc[unit * 128 + k] = n;
            const float mn = fmaxf(bl + m, ml), sp = __expf(bl + m - mn), sl = __expf(ml - mn);
            n = sp * n + sl * nl; m = mn; }
    }
}

__device__ __forceinline__ void mlstm_out_naive(const bf16* n2, const bf16* tT, const float* gates, const float* cw, const float* cb, const bf16* cst, const float* nst, const float* mst, const float* mhg, bf16* mout, float* lds, int bid, int G, int tid) {
    constexpr int QP = 129, DP = 65;
    float* QS = lds; float* KS = lds + 64 * QP; float* VS = lds + 2 * 64 * QP; float* DS = VS + 8192; float* sm = DS + 64 * DP;
    for (int unit = bid; unit < NUNIT; unit += G) {
        const int b = unit >> 8, c = (unit >> 2) & 63, h = unit & 3; const size_t tok0 = (size_t)b * SEQ + c * CHK;
        for (int e = tid; e < 8192; e += 512) { const int l = e >> 7, d = e & 127, pos = c * CHK + l, chq = h * 128 + d, chk = 512 + chq;
            float aq = cb[chq], ak = cb[chk];
#pragma unroll
            for (int j = 0; j < 4; ++j) { const int p = pos - 3 + j; if (p >= 0) { const bf16* rp = n2 + ((size_t)b * SEQ + p) * LD2; aq += cw[j * 1024 + chq] * bf2f(rp[N2_MQ + chq]); ak += cw[j * 1024 + chk] * bf2f(rp[N2_MK + chq]); } }
            QS[l * QP + d] = aq * sigmf(aq); KS[l * QP + d] = ak * sigmf(ak) * 0.08838834764831845f;
            VS[e] = bf2f(tT[(size_t)(T_MV + chq) * M + tok0 + l]); }
        if (tid < 64) { sm[tid] = gates[(tok0 + tid) * 8 + 4 + h]; sm[64 + tid] = gates[(tok0 + tid) * 8 + h]; }
        __syncthreads();
        if (tid == 0) { float cum = 0.f, pm = -INFINITY; const float ms = mst[unit];
            for (int t = 0; t < 64; ++t) { cum += sm[t]; sm[128 + t] = cum; pm = fmaxf(pm, sm[64 + t] - cum); const float g = cum + ms, mt = fmaxf(g, cum + pm); sm[192 + t] = mt; sm[256 + t] = __expf(g - mt); } }
        __syncthreads();
        for (int e = tid; e < 4096; e += 512) { const int t = e >> 6, s = e & 63; float val = 0.f;
            if (s <= t) { float dot = 0.f;
#pragma unroll 8
                for (int d = 0; d < 128; ++d) dot += QS[t * QP + d] * KS[s * QP + d];
                val = dot * __expf(sm[128 + t] - sm[128 + s] + sm[64 + s] - sm[192 + t]); }
            DS[t * DP + s] = val; }
        __syncthreads();
        if (tid < 64) { const int t = tid; float sq = 0.f, sd = 0.f;
            for (int k = 0; k < 128; ++k) sq += nst[unit * 128 + k] * QS[t * QP + k];
            for (int s = 0; s < 64; ++s) sd += DS[t * DP + s];
            const float den = sm[256 + t] * sq + sd; sm[320 + t] = fmaxf(fabsf(den), __expf(-sm[192 + t])); }
        const int v = tid & 127, tg = tid >> 7; float a[16];
#pragma unroll
        for (int i = 0; i < 16; ++i) a[i] = 0.f;
        { const bf16* crow = cst + (size_t)unit * 16384 + (size_t)v * 128;
          for (int k = 0; k < 128; ++k) { const float cv = bf2f(crow[k]);
#pragma unroll
              for (int i = 0; i < 16; ++i) a[i] += cv * QS[(tg * 16 + i) * QP + k]; } }
#pragma unroll
        for (int i = 0; i < 16; ++i) a[i] *= sm[256 + tg * 16 + i];
        for (int s = 0; s < 64; ++s) { const float vv = VS[s * 128 + v];
#pragma unroll
            for (int i = 0; i < 16; ++i) a[i] += DS[(tg * 16 + i) * DP + s] * vv; }
        __syncthreads();
        float* HS = KS;
#pragma unroll
        for (int i = 0; i < 16; ++i) HS[(tg * 16 + i) * QP + v] = a[i] / sm[320 + tg * 16 + i];
        __syncthreads();
        if (tid < 64) { float s = 0.f; for (int k = 0; k < 128; ++k) { const float x = HS[tid * QP + k]; s += x * x; } sm[384 + tid] = rsqrtf(s * (1.0f / 128.0f) + EPS); }
        __syncthreads();
        for (int e = tid; e < 8192; e += 512) { const int t = e >> 7, vv = e & 127;
            const float mo = bf2f(n2[(tok0 + t) * LD2 + N2_MO + h * 128 + vv]);
            mout[(tok0 + t) * 512 + h * 128 + vv] = (bf16)f2bf(sigmf(mo) * HS[t * QP + vv] * sm[384 + t] * mhg[h * 128 + vv]); }
        __syncthreads();
    }
}

#define XB_TMO      128
#define XB_XCNT(j)  (256  + 64 * (j))
#define XB_XSUB(j)  (1280 + 64 * (j))
#define XB_XGEN(j)  (2304 + 64 * (j))
#define XB_TOP      3328
#define XB_TOPGEN   3392
#define XCD_BAR_WORDS 3456
#define XB_SPIN_CAP (1u << 18)

__device__ __forceinline__ unsigned xb_ld(unsigned* p)              { return __hip_atomic_load(p, __ATOMIC_RELAXED, __HIP_MEMORY_SCOPE_AGENT); }
__device__ __forceinline__ unsigned xb_add(unsigned* p, unsigned v) { return __hip_atomic_fetch_add(p, v, __ATOMIC_RELAXED, __HIP_MEMORY_SCOPE_AGENT); }
__device__ __forceinline__ unsigned xb_xcc_id() { return (unsigned)__builtin_amdgcn_s_getreg((3 << 11) | 20) & 0xFu; }
#define XB_SPIN(cond, bar) do { unsigned _sp = 0; while (cond) { __builtin_amdgcn_s_sleep(1); \
    if ((++_sp & 255u) == 0u) { if (xb_ld(&(bar)[XB_TMO])) break; if (_sp > XB_SPIN_CAP) { atomicAdd(&(bar)[XB_TMO], 1u); break; } } } } while (0)

struct XcdBarrier {
    unsigned* bar; unsigned x;
    volatile LAS unsigned* st;
};

__device__ __forceinline__ XcdBarrier xcd_barrier_post(unsigned* bar, volatile LAS unsigned* st) {
    XcdBarrier b; b.bar = bar; b.x = xb_xcc_id(); b.st = st;
    if (threadIdx.x == 0) (void)xb_add(&bar[XB_XCNT(b.x)], 1u);
    return b;
}
__device__ __forceinline__ void xcd_barrier_complete(unsigned* bar, unsigned x, unsigned& nloc, unsigned& nx) {
    const unsigned G = gridDim.x * gridDim.y * gridDim.z;
    unsigned sum, cnt, mine, sp = 0u;
    for (;;) {
        sum = 0u; cnt = 0u; mine = 0u;
#pragma unroll
        for (unsigned j = 0; j < 16; ++j) { const unsigned c = xb_ld(&bar[XB_XCNT(j)]); sum += c; cnt += (c > 0u) ? 1u : 0u; mine = (j == x) ? c : mine; }
        if (sum == G) break;
        __builtin_amdgcn_s_sleep(1);
        if ((++sp & 255u) == 0u) { if (xb_ld(&bar[XB_TMO])) break; if (sp > XB_SPIN_CAP) { atomicAdd(&bar[XB_TMO], 1u); break; } }
    }
    nloc = mine > 0u ? mine : 1u; nx = cnt > 0u ? cnt : 1u;
}

__device__ __forceinline__ void xcd_barrier(const XcdBarrier& b) {
    asm volatile("s_waitcnt vmcnt(0)" ::: "memory");
    __syncthreads();
    if (threadIdx.x == 0) {
        unsigned* bar = b.bar;
        __builtin_amdgcn_s_waitcnt(0);
        unsigned nloc = b.st[0], nx = b.st[1];
        if (nloc == 0u) { xcd_barrier_complete(bar, b.x, nloc, nx); b.st[0] = nloc; b.st[1] = nx; }
        const unsigned old = xb_add(&bar[XB_XSUB(b.x)], 1u);
        const unsigned gen = old / nloc;
        if (old + 1u == (gen + 1u) * nloc) {
            __builtin_amdgcn_fence(__ATOMIC_RELEASE, "agent");
            asm volatile("s_waitcnt vmcnt(0)" ::: "memory");
            const unsigned og = xb_add(&bar[XB_TOP], 1u);
            const unsigned tg = og / nx;
            if (og + 1u == (tg + 1u) * nx) xb_add(&bar[XB_TOPGEN], 1u);
            else XB_SPIN(xb_ld(&bar[XB_TOPGEN]) == tg, bar);
            __builtin_amdgcn_fence(__ATOMIC_ACQUIRE, "agent");
            xb_add(&bar[XB_XGEN(b.x)], 1u);
            asm volatile("s_waitcnt vmcnt(0)" ::: "memory");
        } else {
            XB_SPIN(xb_ld(&bar[XB_XGEN(b.x)]) == gen, bar);
            __builtin_amdgcn_fence(__ATOMIC_ACQUIRE, "agent");
            asm volatile("s_waitcnt vmcnt(0)" ::: "memory");
        }
    }
    __syncthreads();
}
constexpr int N_STEPS = 27, STEP_PRO1 = 13, STEP_FIN = 26, KPL = 13;
enum { K_PRO = 100, K_FIN = 101, K_A = 0, K_A2 = 1, K_B = 2, K_C = 3, K_D = 4, K_E1 = 5, K_E2 = 6, K_E3 = 7, K_E4 = 8, K_F = 9, K_G = 10, K_H = 11 };
struct Args { const float* in[16]; float* out; unsigned char* ws; int ph_lo, ph_hi; };

enum { SEL_ALL = 0, SEL_PRO = 1, SEL_FIN = 2, SEL_B = 3, SEL_C = 4, SEL_D = 5, SEL_GEMM = 6, SEL_GATES = 7 };
template <int SEL> __global__ void __launch_bounds__(512, 2) mk_fwd(Args args) {
    extern __shared__ __attribute__((aligned(16))) unsigned char lds[];
    constexpr int G = 256; const int bid = blockIdx.x;
    {
        LAS unsigned char* ldsl0 = (LAS unsigned char*)lds;
        for (int u = threadIdx.x; u < (LDS_BYTES - LDSCTL_OFF) / 4; u += 512) ((LAS unsigned*)(ldsl0 + LDSCTL_OFF))[u] = 0u;
        __syncthreads();
    }
    if (MK_ONE_LAUNCH) (void)xcd_barrier_post((unsigned*)(args.ws + WS_CTL) + CW_BAR, (volatile LAS unsigned*)((LAS unsigned char*)lds + MISC_OFF) + 8);
#define GRID_BARRIER() do { XcdBarrier bar_; bar_.bar = (unsigned*)(ws + WS_CTL) + CW_BAR; bar_.x = xb_xcc_id(); bar_.st = (volatile LAS unsigned*)((LAS unsigned char*)lds + MISC_OFF) + 8; xcd_barrier(bar_); } while (0)

    int prep = 0;
    for (int step = args.ph_lo; step < args.ph_hi;) {
        int tid = threadIdx.x; asm volatile("" : "+v"(tid));
        const int lane = tid & 63, wave = __builtin_amdgcn_readfirstlane(tid >> 6), gw = bid * 8 + wave, NGW = G * 8;
        size_t zo = 0; asm volatile("" : "+s"(zo));
        unsigned char* ws = args.ws + zo;
        int zi = 0; asm volatile("" : "+s"(zi));
#define INP(k) (args.in[(k) + zi])
        LAS unsigned char* ldsl = (LAS unsigned char*)lds;
        const float* x_in = INP(0); float* xout = args.out + zo;
        float* ssq = (float*)(ws + WS_SSQ); float* wg = (float*)(ws + WS_WG); float* gates = (float*)(ws + WS_GATES);
        float* nloc = (float*)(ws + WS_NLOC); float* mloc = (float*)(ws + WS_MLOC); float* blast = (float*)(ws + WS_BLAST); float* mst = (float*)(ws + WS_MST);
        bf16* Wb = (bf16*)(ws + WS_W); bf16* xb = (bf16*)(ws + WS_XB); bf16* n1 = (bf16*)(ws + WS_N1); bf16* n2 = (bf16*)(ws + WS_N2); bf16* tT = (bf16*)(ws + WS_T); bf16* att = (bf16*)(ws + WS_ATT);
        bf16* cloc = (bf16*)(ws + WS_CLOC); bf16* mout = (bf16*)(ws + WS_MOUT); bf16* Yb = (bf16*)(ws + WS_Y); bf16* Zb = (bf16*)(ws + WS_Z); bf16* Hb = (bf16*)(ws + WS_H);
        const int layer = step >= STEP_PRO1 ? 1 : 0;
        const int kind = (step == 0 || step == STEP_PRO1) ? K_PRO : (step == STEP_FIN ? K_FIN : (step - 1) % KPL);
        float* ssqA = ssq + (size_t)(2 * layer) * M; float* ssqF = ssq + (size_t)(2 * layer + 1) * M; float* ssqN = ssq + (size_t)(2 * layer + 2) * M;

        if ((SEL == SEL_ALL || SEL == SEL_PRO) && kind == K_PRO) {
            LAS float* scr = (LAS float*)(ldsl + wave * 16384);
            const float* w_in = INP(2) + (size_t)layer * DM * DIN_SRC; const float* g_mix = INP(1) + layer * DM;
            const float* w_a = INP(9) + (size_t)layer * 512 * DM; const float* w_m = INP(10) + (size_t)layer * 512 * DM;
            const float* w_o = INP(11) + (size_t)layer * DM * DM; const float* g_ffn = INP(12) + layer * DM;
            const float* w_up = INP(13) + (size_t)layer * DM * DFF; const float* w_dn = INP(14) + (size_t)layer * DFF * DM;
            constexpr int I_IN = 16 * 176, I_A = 8 * 32, I_M = 8 * 32, I_O = 16 * 32, I_UP = 16 * 128, I_DN = 64 * 32, NITEMS = I_IN + I_A + I_M + I_O + I_UP + I_DN;
            for (int it = gw; it < NITEMS; it += NGW) {
                int r = it;
                if (r < I_IN) { transpose_item(w_in, DIN_SRC, 1, g_mix, Wb + W_IN, 1024, 176, scr, r, lane); continue; } r -= I_IN;
                if (r < I_A) { transpose_item(w_a, DM, 0, nullptr, Wb + W_A, 512, 32, scr, r, lane); continue; } r -= I_A;
                if (r < I_M) { transpose_item(w_m, DM, 0, nullptr, Wb + W_M, 512, 32, scr, r, lane); continue; } r -= I_M;
                if (r < I_O) { transpose_item(w_o, DM, 0, nullptr, Wb + W_O, 1024, 32, scr, r, lane); continue; } r -= I_O;
                if (r < I_UP) { transpose_item(w_up, DFF, 0, g_ffn, Wb + W_UP, 1024, 128, scr, r, lane); continue; } r -= I_UP;
                transpose_item(w_dn, DM, 0, nullptr, Wb + W_DN, 4096, 32, scr, r, lane);
            }
            for (int i = bid * 512 + tid; i < 8 * 1024; i += G * 512) { const int j = i >> 10, k = i & 1023; wg[i] = g_mix[k] * w_in[(size_t)k * DIN_SRC + 3584 + j]; }
            if (layer == 0) {
                for (int i = bid * 512 + tid; i < 4 * M; i += G * 512) ssq[M + i] = 0.f;
                for (int m = gw; m < M; m += NGW) {
                    const f32x4* xr = (const f32x4*)(x_in + (size_t)m * DM) + lane; f32x4 v[4]; float s = 0.f;
#pragma unroll
                    for (int j = 0; j < 4; ++j) { v[j] = xr[64 * j]; s += (v[j].x * v[j].x + v[j].y * v[j].y) + (v[j].z * v[j].z + v[j].w * v[j].w); }
                    s = wave_sum(s); if (lane == 0) ssq[m] = s;
                    unsigned long long* o8 = (unsigned long long*)(xb + (size_t)m * DM) + lane;
#pragma unroll
                    for (int j = 0; j < 4; ++j) o8[64 * j] = (unsigned long long)pk2(v[j].x, v[j].y) | ((unsigned long long)pk2(v[j].z, v[j].w) << 32);
                }
            }
        } else if ((SEL == SEL_ALL || SEL == SEL_FIN) && kind == K_FIN) {
            const float* gf = INP(15);
            for (int m = gw; m < M; m += NGW) {
                const float rs = rsqrtf(ssqN[m] * (1.0f / 1024.0f) + EPS);
                f32x4* xr = (f32x4*)(xout + (size_t)m * DM) + lane; const f32x4* gr = (const f32x4*)gf + lane;
#pragma unroll
                for (int j = 0; j < 4; ++j) { const f32x4 v = xr[64 * j], g = gr[64 * j]; xr[64 * j] = v * rs * g; }
            }
        } else if ((SEL == SEL_ALL || SEL == SEL_B) && kind == K_B) {
#if FAST_ATTN
#ifdef PROBE_SKIP_ATTN_REP
            if (prep == 0)
#endif
#if ATTN_LDS
            attn_mfma_lds(n1, tT, INP(7) + (size_t)layer * 8 * 513, att, ldsl, bid, G, wave, lane);
#else
            attn_mfma(n1, tT, INP(7) + (size_t)layer * 8 * 513, att, (LAS float*)ldsl, bid, G, wave, lane);
#endif
            __syncthreads();
#else
            attn_naive(n1, tT, INP(7) + (size_t)layer * 8 * 513, att, bid, G, wave, lane);
#endif
#if FAST_LOCAL
#ifdef PROBE_SKIP_LOCAL_REP
            if (prep == 0)
#endif
            mlstm_local_mfma(tT, gates, INP(3) + (size_t)layer * 4096, INP(4) + (size_t)layer * 1024, cloc, nloc, mloc, blast, (LAS float*)ldsl, bid, G, wave, lane);
#else
            mlstm_local_naive(n2, tT, gates, INP(3) + (size_t)layer * 4096, INP(4) + (size_t)layer * 1024, cloc, nloc, mloc, blast, (float*)lds, bid, G, tid);
#endif
        } else if ((SEL == SEL_ALL || SEL == SEL_C) && kind == K_C) {
            mlstm_scan(cloc, nloc, mloc, blast, mst, bid, G, tid, prep);
#if FAST_OUT
            conv_prepass(n2, INP(3) + (size_t)layer * 4096, INP(4) + (size_t)layer * 1024, n1, bid, G, tid);
#endif
        } else if ((SEL == SEL_ALL || SEL == SEL_D) && kind == K_D) {
#if FAST_OUT
            mlstm_out_mfma(n1, n2, tT, gates, cloc, nloc, mst, INP(8) + (size_t)layer * 512, mout, (LAS float*)ldsl, bid, G, wave, lane);
#else
            mlstm_out_naive(n2, tT, gates, INP(3) + (size_t)layer * 4096, INP(4) + (size_t)layer * 1024, cloc, nloc, mst, INP(8) + (size_t)layer * 512, mout, (float*)lds, bid, G, tid);
#endif
        } else if ((SEL == SEL_ALL || SEL == SEL_GEMM) && kind <= K_H && kind != K_A2) {
#ifndef GATES_ON
#define GATES_ON 1
#endif
#ifdef GEMM_ONLY
#define GEMM_ON(k) ((k) == GEMM_ONLY)
#else
#define GEMM_ON(k) true
#endif
            pg8::StaticOrder S;
#define RUN_GEMM_X(MODE, MR_, CU_, A_, BT_, N_, K_, O_, LDC_, Z_, SSQI_, BASE_, OUTF_, SSQO_, O2_, LDC2_, SPLIT_) do { pg8::Gemm g; g.A = (A_); g.Bt = (BT_); g.M = (MR_); g.N = (N_); g.K = (K_); \
                pg8::EpiAny<MODE> E; E.O = (O_); E.ldc = (LDC_); E.Z = (Z_); E.ssq_in = (SSQI_); E.base = (BASE_); E.outf = (OUTF_); E.ssq_out = (SSQO_); E.O2 = (O2_); E.ldc2 = (LDC2_); E.split = (SPLIT_); E.dry = prep; \
                S.init((MR_), (N_), G, (CU_)); pg8::gemm_phase<pg8::EpiAny<MODE>, pg8::StaticOrder, true, true>(ldsl, g, S, E); } while (0)
#define RUN_GEMM(MODE, A_, BT_, N_, K_, O_, LDC_, Z_, SSQI_, BASE_, OUTF_, SSQO_) RUN_GEMM_X(MODE, M, bid, A_, BT_, N_, K_, O_, LDC_, Z_, SSQI_, BASE_, OUTF_, SSQO_, nullptr, 0, 0)
            if (GEMM_ON(K_A) && kind == K_A) {
                RUN_GEMM_X(0, M, bid, xb, Wb + W_IN, 2560, 1024, n1, LD1, nullptr, ssqA, nullptr, nullptr, nullptr, n2, LD2, 1024);
                RUN_GEMM_X(6, 1536, (bid + G / 2) % G, Wb + W_IN + (size_t)2048 * 1024, xb, M, 1024, tT, M, nullptr, ssqA, nullptr, nullptr, nullptr, nullptr, 0, 0);
            }
            else if (GEMM_ON(K_E1) && kind == K_E1) RUN_GEMM(2, att, Wb + W_A, 1024, 512, Yb, 1024, nullptr, nullptr, nullptr, nullptr, nullptr);
            else if (GEMM_ON(K_E2) && kind == K_E2) RUN_GEMM(3, xb, Wb + W_IN + (size_t)3584 * 1024, 1024, 1024, Yb, 1024, nullptr, ssqA, nullptr, nullptr, nullptr);
            else if (GEMM_ON(K_E3) && kind == K_E3) RUN_GEMM(2, mout, Wb + W_M, 1024, 512, Zb, 1024, nullptr, nullptr, nullptr, nullptr, nullptr);
            else if (GEMM_ON(K_E4) && kind == K_E4) RUN_GEMM(4, xb, Wb + W_IN + (size_t)4608 * 1024, 1024, 1024, Yb, 1024, Zb, ssqA, nullptr, nullptr, nullptr);
            else if (GEMM_ON(K_F) && kind == K_F) { if (layer == 0) RUN_GEMM(5, Yb, Wb + W_O, 1024, 1024, xb, 1024, nullptr, nullptr, x_in, nullptr, ssqF);
                                                  else RUN_GEMM(7, Yb, Wb + W_O, 1024, 1024, xb, 1024, nullptr, nullptr, nullptr, nullptr, ssqF); }
            else if (GEMM_ON(K_G) && kind == K_G)  RUN_GEMM(1, xb, Wb + W_UP, 4096, 1024, Hb, DFF, nullptr, ssqF, nullptr, nullptr, nullptr);
            else if (GEMM_ON(K_H)) { if (layer == 0) RUN_GEMM(7, Hb, Wb + W_DN, 1024, 4096, xb, 1024, nullptr, nullptr, nullptr, nullptr, ssqN);
                                     else RUN_GEMM(8, Hb, Wb + W_DN, 1024, 4096, xb, 1024, nullptr, nullptr, nullptr, xout, ssqN); }
        } else if ((SEL == SEL_ALL || SEL == SEL_GATES) && kind == K_A2) {
            gates_phase(x_in, xb, layer, wg, INP(5) + layer * 4, INP(6) + layer * 4, gates, (LAS float*)ldsl, bid, tid);
        }
        const bool seam = !(kind == K_A || kind == K_E1 || kind == K_E2 || kind == K_E3);
        if (seam && step + 1 < args.ph_hi) { if (MK_ONE_LAUNCH) GRID_BARRIER(); }
#ifdef PROBE_BAR
        if (step == 3) { for (int pb = 0; pb < PROBE_BAR; ++pb) GRID_BARRIER(); }
#endif
#ifdef PROBE_REPEAT
        if ((PROBE_REPEAT_COND) && prep + 1 < PROBE_REPEAT) { ++prep; } else { prep = 0; ++step; }
#else
        ++step;
#endif
    }
}

extern "C" void kernel_launch(void* const* d_in, const int* in_sizes, int n_in, void* d_out, int out_size, void* d_ws, size_t ws_size, hipStream_t stream) {
    static int grid = 0;
    if (grid == 0) {
        if (n_in != 16 || in_sizes[0] != M * DM || out_size != M * DM || ws_size < WS_END) { fprintf(stderr, "kernel_launch: unexpected shapes (n_in %d, in0 %d, out %d, ws %zu)\n", n_in, n_in > 0 ? in_sizes[0] : -1, out_size, ws_size); grid = -1; return; }
        int dev = 0, cus = 0;
        if (hipGetDevice(&dev) != hipSuccess || hipDeviceGetAttribute(&cus, hipDeviceAttributeMultiprocessorCount, dev) != hipSuccess) { grid = -1; return; }
        bool ok = true;
#if MK_ONE_LAUNCH
        ok &= hipFuncSetAttribute((const void*)mk_fwd<SEL_ALL>, hipFuncAttributeMaxDynamicSharedMemorySize, LDS_BYTES) == hipSuccess;
#endif
#if !MK_ONE_LAUNCH
        ok &= hipFuncSetAttribute((const void*)mk_fwd<SEL_PRO>, hipFuncAttributeMaxDynamicSharedMemorySize, LDS_BYTES) == hipSuccess;
        ok &= hipFuncSetAttribute((const void*)mk_fwd<SEL_FIN>, hipFuncAttributeMaxDynamicSharedMemorySize, LDS_BYTES) == hipSuccess;
        ok &= hipFuncSetAttribute((const void*)mk_fwd<SEL_B>, hipFuncAttributeMaxDynamicSharedMemorySize, LDS_BYTES) == hipSuccess;
        ok &= hipFuncSetAttribute((const void*)mk_fwd<SEL_C>, hipFuncAttributeMaxDynamicSharedMemorySize, LDS_BYTES) == hipSuccess;
        ok &= hipFuncSetAttribute((const void*)mk_fwd<SEL_D>, hipFuncAttributeMaxDynamicSharedMemorySize, LDS_BYTES) == hipSuccess;
        ok &= hipFuncSetAttribute((const void*)mk_fwd<SEL_GATES>, hipFuncAttributeMaxDynamicSharedMemorySize, LDS_BYTES) == hipSuccess;
        ok &= hipFuncSetAttribute((const void*)mk_fwd<SEL_GEMM>, hipFuncAttributeMaxDynamicSharedMemorySize, LDS_BYTES) == hipSuccess;
#endif
        if (!ok) { fprintf(stderr, "kernel_launch: hipFuncSetAttribute failed\n"); grid = -1; return; }
        (void)hipGetLastError();
        if (cus < 256) { fprintf(stderr, "kernel_launch: needs 256 CUs, device has %d\n", cus); grid = -1; return; }
        grid = 256;
    }
    if (grid < 0) return;
    if (hipMemsetAsync((char*)d_ws + WS_CTL, 0, CTL_ZERO_BYTES, stream) != hipSuccess) return;
    Args a{};
    for (int i = 0; i < 16; ++i) a.in[i] = (const float*)d_in[i];
    a.out = (float*)d_out; a.ws = (unsigned char*)d_ws;
#if MK_ONE_LAUNCH
    {
        a.ph_lo = 0; a.ph_hi = N_STEPS;
        hipLaunchKernelGGL(mk_fwd<SEL_ALL>, dim3(grid), dim3(512), LDS_BYTES, stream, a);
    }
#else
    {
        int s = 0;
        while (s < N_STEPS) {
            int e = s + 1;
            const int k = (s == 0 || s == STEP_PRO1 || s == STEP_FIN) ? -1 : (s - 1) % KPL;
            if (k == K_E1) e = s + 4;
            a.ph_lo = s; a.ph_hi = e;
            if (k == -1 && s != STEP_FIN) hipLaunchKernelGGL(mk_fwd<SEL_PRO>, dim3(grid), dim3(512), LDS_BYTES, stream, a);
            else if (k == -1) hipLaunchKernelGGL(mk_fwd<SEL_FIN>, dim3(grid), dim3(512), LDS_BYTES, stream, a);
            else if (k == K_A2) hipLaunchKernelGGL(mk_fwd<SEL_GATES>, dim3(grid), dim3(512), LDS_BYTES, stream, a);
            else if (k == K_B) hipLaunchKernelGGL(mk_fwd<SEL_B>, dim3(grid), dim3(512), LDS_BYTES, stream, a);
            else if (k == K_C) hipLaunchKernelGGL(mk_fwd<SEL_C>, dim3(grid), dim3(512), LDS_BYTES, stream, a);
            else if (k == K_D) hipLaunchKernelGGL(mk_fwd<SEL_D>, dim3(grid), dim3(512), LDS_BYTES, stream, a);
            else hipLaunchKernelGGL(mk_fwd<SEL_GEMM>, dim3(grid), dim3(512), LDS_BYTES, stream, a);
            s = e;
        }
    }
#endif
}
```

```cpp
#include <hip/hip_runtime.h>
#include <cstdio>
#include <cstdint>

namespace pg8 {
#define PG8_LAS __attribute__((address_space(3)))
typedef unsigned short bf16_t;
typedef short bf16x8 __attribute__((ext_vector_type(8)));
typedef float f32x4 __attribute__((ext_vector_type(4)));
typedef unsigned u32x4 __attribute__((ext_vector_type(4)));
constexpr int BM = 256, BK = 64, HALF = 128, HTB = HALF * BK * 2  , STAGE_BYTES = 8 * HTB, NXCD = 8, WGM = 8;

__host__ __device__ __forceinline__ int lds_byte(int r, int c) { const int st = (r >> 4) * 2 + (c >> 5), rr = r & 15, cc = c & 31, ob = rr * 64 + cc * 2; return st * 1024 + (ob ^ (((ob >> 9) & 1) << 5)); }
__host__ __device__ __forceinline__ void stage_rc(int b, int& R, int& C) { const int st = b / 1024, sb = b % 1024, swz = sb ^ (((sb >> 9) & 1) << 5); R = (st >> 1) * 16 + swz / 64; C = (st & 1) * 32 + (swz % 64) / 2; }
__host__ __device__ __forceinline__ int perm32(int rho) { const int n = rho >> 4, i = rho & 15; return 8 * (i >> 2) + 4 * n + (i & 3); }

struct Unit { int pm, pn; };
struct Gemm { const bf16_t* A; const bf16_t* Bt; int M, N, K; };

struct StaticOrder {
    int nM, nN, nwg, G, c;
    __host__ __device__ void init(int M, int N, int G_, int c_) { nM = M / BM; nN = N / BM; nwg = nM * nN; G = G_; c = c_; }
    __host__ __device__ bool next(int i, Unit& u) const {
        const long L = (long)i * G + c; if (L >= nwg) return false;
        int wgid = (int)L; { const int q = nwg / NXCD, r = nwg % NXCD, xcd = wgid % NXCD, off = wgid / NXCD; wgid = (xcd < r ? xcd * (q + 1) : r * (q + 1) + (xcd - r) * q) + off; }
        const int nig = WGM * nN, gid = wgid / nig, fm = gid * WGM, gsz = (nM - fm) < WGM ? (nM - fm) : WGM;
        u.pm = fm + ((wgid % nig) % gsz); u.pn = (wgid % nig) / gsz; return true;
    }
    __device__ __forceinline__ void a_ready(const Unit&) const {}
    __device__ __forceinline__ void done(const Unit&) const {}
};

__device__ __forceinline__ unsigned cvt_pk_bf16(float lo, float hi) { unsigned r; asm volatile("v_cvt_pk_bf16_f32 %0, %1, %2" : "=v"(r) : "v"(lo), "v"(hi)); return r; }
__device__ __forceinline__ float bflo(unsigned w) { return __uint_as_float(w << 16); }
__device__ __forceinline__ float bfhi(unsigned w) { return __uint_as_float(w & 0xffff0000u); }
__device__ __forceinline__ float rstd_of(float ss) { return rsqrtf(ss * (1.0f / 1024.0f) + 1e-6f); }
__device__ __forceinline__ float sigm(float x) { return __builtin_amdgcn_rcpf(1.0f + __expf(-x)); }
typedef unsigned u32x2 __attribute__((ext_vector_type(2)));

template <int mode> struct EpiAny {
    static constexpr bool PERM = true, AFTER_DRAIN = false;
    bf16_t* O; int ldc; const bf16_t* Z; const float* ssq_in; const float* base; float* outf; float* ssq_out; bf16_t* O2; int ldc2, split; int dry;
    __device__ __forceinline__ void operator()(const f32x4 (&acc)[2][2][4][2], const Unit& u, int wr, int wc, int fr, int fq) const {
        const int row0 = u.pm * BM + wr * 64 + fr, col0 = u.pn * BM + wc * 32 + 8 * fq;
#ifdef PROBE_REPEAT
        if (dry) { asm volatile("" :: "v"(acc[0][0][0][0][0]), "v"(acc[1][1][3][1][3])); return; }
#endif
        if (mode == 6) {
            float rs[2][8];
#pragma unroll
            for (int bj = 0; bj < 2; ++bj) { const f32x4 s0 = *(const f32x4*)(ssq_in + col0 + bj * HALF), s1 = *(const f32x4*)(ssq_in + col0 + bj * HALF + 4);
#pragma unroll
                for (int e = 0; e < 4; ++e) { rs[bj][e] = rstd_of(s0[e]); rs[bj][4 + e] = rstd_of(s1[e]); } }
#pragma unroll
            for (int ai = 0; ai < 2; ++ai)
#pragma unroll
                for (int m = 0; m < 4; ++m) {
                    const int row = row0 + ai * HALF + m * 16; bf16_t* rowp = O + (size_t)row * ldc + col0;
#pragma unroll
                    for (int bj = 0; bj < 2; ++bj) {
                        const f32x4 v0 = acc[ai][bj][m][0], v1 = acc[ai][bj][m][1];
                        u32x4 w; w.x = cvt_pk_bf16(v0[0] * rs[bj][0], v0[1] * rs[bj][1]); w.y = cvt_pk_bf16(v0[2] * rs[bj][2], v0[3] * rs[bj][3]);
                        w.z = cvt_pk_bf16(v1[0] * rs[bj][4], v1[1] * rs[bj][5]); w.w = cvt_pk_bf16(v1[2] * rs[bj][6], v1[3] * rs[bj][7]);
                        *(u32x4*)(rowp + bj * HALF) = w;
                    }
                }
        } else if (mode <= 1) {
            bf16_t* ob = O; int ld = ldc, cc = col0;
            if (mode == 0 && u.pn * BM >= split) { ob = O2; ld = ldc2; cc = col0 - split; }
#pragma unroll
            for (int ai = 0; ai < 2; ++ai)
#pragma unroll
                for (int m = 0; m < 4; ++m) {
                    const int row = row0 + ai * HALF + m * 16; const float rs = rstd_of(ssq_in[row]);
                    bf16_t* rowp = ob + (size_t)row * ld + cc;
#pragma unroll
                    for (int bj = 0; bj < 2; ++bj) {
                        f32x4 v0 = acc[ai][bj][m][0] * rs, v1 = acc[ai][bj][m][1] * rs;
                        if (mode == 1) {
#pragma unroll
                            for (int e = 0; e < 4; ++e) { const float a = fmaxf(v0[e], 0.f), b = fmaxf(v1[e], 0.f); v0[e] = a * a; v1[e] = b * b; }
                        }
                        u32x4 w; w.x = cvt_pk_bf16(v0[0], v0[1]); w.y = cvt_pk_bf16(v0[2], v0[3]); w.z = cvt_pk_bf16(v1[0], v1[1]); w.w = cvt_pk_bf16(v1[2], v1[3]);
                        *(u32x4*)(rowp + bj * HALF) = w;
                    }
                }
        } else if (mode == 2) {
#pragma unroll
            for (int ai = 0; ai < 2; ++ai)
#pragma unroll
                for (int m = 0; m < 4; ++m) {
                    const int row = row0 + ai * HALF + m * 16; bf16_t* rowp = O + (size_t)row * ldc + col0;
#pragma unroll
                    for (int bj = 0; bj < 2; ++bj) {
                        const f32x4 v0 = acc[ai][bj][m][0], v1 = acc[ai][bj][m][1];
                        u32x4 w; w.x = cvt_pk_bf16(v0[0], v0[1]); w.y = cvt_pk_bf16(v0[2], v0[3]); w.z = cvt_pk_bf16(v1[0], v1[1]); w.w = cvt_pk_bf16(v1[2], v1[3]);
                        *(u32x4*)(rowp + bj * HALF) = w;
                    }
                }
        } else if (mode <= 4) {
#pragma unroll
            for (int ai = 0; ai < 2; ++ai)
#pragma unroll
                for (int m = 0; m < 4; ++m) {
                    const int row = row0 + ai * HALF + m * 16; const float rs = rstd_of(ssq_in[row]);
                    bf16_t* rowp = O + (size_t)row * ldc + col0; const bf16_t* zp = Z + (size_t)row * ldc + col0;
#pragma unroll
                    for (int bj = 0; bj < 2; ++bj) {
                        const f32x4 a0 = acc[ai][bj][m][0] * rs, a1 = acc[ai][bj][m][1] * rs;
                        const u32x4 y = *(const u32x4*)(rowp + bj * HALF);
                        float yv[8] = {bflo(y.x), bfhi(y.x), bflo(y.y), bfhi(y.y), bflo(y.z), bfhi(y.z), bflo(y.w), bfhi(y.w)};
                        float gv[8] = {sigm(a0[0]), sigm(a0[1]), sigm(a0[2]), sigm(a0[3]), sigm(a1[0]), sigm(a1[1]), sigm(a1[2]), sigm(a1[3])};
                        float ov[8];
                        if (mode == 3) {
#pragma unroll
                            for (int e = 0; e < 8; ++e) ov[e] = gv[e] * yv[e];
                        } else {
                            const u32x4 z = *(const u32x4*)(zp + bj * HALF);
                            float zv[8] = {bflo(z.x), bfhi(z.x), bflo(z.y), bfhi(z.y), bflo(z.z), bfhi(z.z), bflo(z.w), bfhi(z.w)};
#pragma unroll
                            for (int e = 0; e < 8; ++e) ov[e] = yv[e] + gv[e] * zv[e];
                        }
                        u32x4 w; w.x = cvt_pk_bf16(ov[0], ov[1]); w.y = cvt_pk_bf16(ov[2], ov[3]); w.z = cvt_pk_bf16(ov[4], ov[5]); w.w = cvt_pk_bf16(ov[6], ov[7]);
                        *(u32x4*)(rowp + bj * HALF) = w;
                    }
                }
        } else {
#pragma unroll
            for (int ai = 0; ai < 2; ++ai)
#pragma unroll
                for (int m = 0; m < 4; ++m) {
                    const int row = row0 + ai * HALF + m * 16; const size_t off = (size_t)row * ldc + col0; float s = 0.f;
#pragma unroll
                    for (int bj = 0; bj < 2; ++bj) {
                        f32x4 b0, b1;
                        if (mode == 5) { b0 = *(const f32x4*)(base + off + bj * HALF); b1 = *(const f32x4*)(base + off + bj * HALF + 4); }
                        else { const u32x4 y = *(const u32x4*)(O + off + bj * HALF); b0 = (f32x4){bflo(y.x), bfhi(y.x), bflo(y.y), bfhi(y.y)}; b1 = (f32x4){bflo(y.z), bfhi(y.z), bflo(y.w), bfhi(y.w)}; }
                        const f32x4 o0 = b0 + acc[ai][bj][m][0], o1 = b1 + acc[ai][bj][m][1];
                        if (mode == 8) { *(f32x4*)(outf + off + bj * HALF) = o0; *(f32x4*)(outf + off + bj * HALF + 4) = o1; }
                        else { u32x4 w; w.x = cvt_pk_bf16(o0[0], o0[1]); w.y = cvt_pk_bf16(o0[2], o0[3]); w.z = cvt_pk_bf16(o1[0], o1[1]); w.w = cvt_pk_bf16(o1[2], o1[3]);
                            *(u32x4*)(O + off + bj * HALF) = w; }
                        s += (o0[0] * o0[0] + o0[1] * o0[1]) + (o0[2] * o0[2] + o0[3] * o0[3]) + (o1[0] * o1[0] + o1[1] * o1[1]) + (o1[2] * o1[2] + o1[3] * o1[3]);
                    }
                    s += __shfl_xor(s, 16); s += __shfl_xor(s, 32);
                    if (fq == 0) atomicAdd(ssq_out + row, s);
                }
        }
    }
};

template <class Epi, class Sched, bool ALIGN_EPI = false, bool SP2 = false>
__device__ __forceinline__ void gemm_phase(PG8_LAS unsigned char* lds, const Gemm g, const Sched& S, const Epi& E) {
    int tid_ = threadIdx.x; asm volatile("" : "+v"(tid_));
    const int tid = tid_, wid = __builtin_amdgcn_readfirstlane(tid >> 6), lane = tid & 63, wr = wid >> 2, wc = wid & 3, fr = lane & 15, fq = lane >> 4;
    const int K = g.K, nt = K / BK;
    unsigned voffA[2], voffB[2];
#pragma unroll
    for (int i = 0; i < 2; ++i) { int R, C; stage_rc(tid * 16 + i * 8192, R, C); const int Rb = Epi::PERM ? ((R & ~31) + perm32(R & 31)) : R;
        voffA[i] = (unsigned)(R * K + C) * 2u; voffB[i] = (unsigned)(Rb * K + C) * 2u; }
    const size_t kstep = (size_t)(BK * 2);
    const size_t hstep = (size_t)HALF * K * 2;
    const size_t tstep = 2 * hstep;
    const unsigned ldsw = (unsigned)wid * 1024u;
    const int aoff = lds_byte(wr * 64 + fr, fq * 8), boff = lds_byte(wc * 32 + fr, fq * 8);
#define PG8_SA(b, h) (((b) * 2 + (h)) * HTB)
#define PG8_SB(b, h) ((4 + (b) * 2 + (h)) * HTB)
#define PG8_STAGE(bufoff, gbase, voff) do { _Pragma("unroll") for (int _i = 0; _i < 2; ++_i) \
        __builtin_amdgcn_global_load_lds((const unsigned*)((const char*)(gbase) + (voff)[_i]), (PG8_LAS unsigned*)(lds + (bufoff) + ldsw + _i * 8192), 16, 0, 0); } while (0)
#define PG8_LDA(dst, b, h) do { _Pragma("unroll") for (int m = 0; m < 4; ++m) _Pragma("unroll") for (int k = 0; k < 2; ++k) dst[m][k] = *(const PG8_LAS bf16x8*)(lds + PG8_SA(b, h) + aoff + m * 2048 + k * 1024); } while (0)
#define PG8_LDB(dst, b, h) do { _Pragma("unroll") for (int n = 0; n < 2; ++n) _Pragma("unroll") for (int k = 0; k < 2; ++k) dst[n][k] = *(const PG8_LAS bf16x8*)(lds + PG8_SB(b, h) + boff + n * 2048 + k * 1024); } while (0)
#define PG8_MMA(ai, bj, At, Bt) do { __builtin_amdgcn_s_setprio(1); _Pragma("unroll") for (int m = 0; m < 4; ++m) _Pragma("unroll") for (int n = 0; n < 2; ++n) _Pragma("unroll") for (int k = 0; k < 2; ++k) \
        acc[ai][bj][m][n] = __builtin_amdgcn_mfma_f32_16x16x32_bf16(Bt[n][k], At[m][k], acc[ai][bj][m][n], 0, 0, 0); __builtin_amdgcn_s_setprio(0); } while (0)
#define PG8_WAIT_V(n) asm volatile("s_waitcnt vmcnt(" #n ")" ::: "memory")
#define PG8_WAIT_L(n) asm volatile("s_waitcnt lgkmcnt(" #n ")" ::: "memory")
#define PG8_BAR __builtin_amdgcn_s_barrier()
#define PG8_SCHED __builtin_amdgcn_sched_barrier(0)
    Unit cur, nxt; int ui = 0;
    if (!S.next(0, cur)) return;
    f32x4 acc[2][2][4][2];
#pragma unroll
    for (int a = 0; a < 2; ++a)
#pragma unroll
        for (int b = 0; b < 2; ++b)
#pragma unroll
            for (int m = 0; m < 4; ++m)
#pragma unroll
                for (int n = 0; n < 2; ++n) acc[a][b][m][n] = (f32x4){0.f, 0.f, 0.f, 0.f};
    bf16x8 At[4][2], B0[2][2], B1[2][2];
    const char* cA = (const char*)g.A + (size_t)cur.pm * tstep; const char* cB = (const char*)g.Bt + (size_t)cur.pn * tstep;
    S.a_ready(cur);
    if constexpr (SP2) {
        PG8_STAGE(PG8_SB(0, 0), cB, voffB); PG8_STAGE(PG8_SB(0, 1), cB + hstep, voffB); PG8_STAGE(PG8_SA(0, 0), cA, voffA); PG8_STAGE(PG8_SA(0, 1), cA + hstep, voffA);
        if (wr == 1) PG8_BAR;
        PG8_WAIT_V(2); PG8_BAR;
        PG8_STAGE(PG8_SB(1, 0), cB + kstep, voffB); PG8_STAGE(PG8_SA(1, 0), cA + kstep, voffA); PG8_STAGE(PG8_SB(1, 1), cB + hstep + kstep, voffB);
        PG8_WAIT_V(6); PG8_BAR;
    } else {
        PG8_STAGE(PG8_SB(0, 0), cB, voffB); PG8_STAGE(PG8_SA(0, 0), cA, voffA); PG8_STAGE(PG8_SB(0, 1), cB + hstep, voffB); PG8_STAGE(PG8_SA(0, 1), cA + hstep, voffA);
        if (wr == 1) PG8_BAR;
        PG8_WAIT_V(4); PG8_BAR;
        PG8_STAGE(PG8_SB(1, 0), cB + kstep, voffB); PG8_STAGE(PG8_SA(1, 0), cA + kstep, voffA); PG8_STAGE(PG8_SB(1, 1), cB + hstep + kstep, voffB);
        PG8_WAIT_V(6); PG8_BAR;
    }
    for (;;) {
        const bool has_next = S.next(ui + 1, nxt);
        const char* nA = has_next ? (const char*)g.A + (size_t)nxt.pm * tstep : cA; const char* nB = has_next ? (const char*)g.Bt + (size_t)nxt.pn * tstep : cB;
        for (int t = 0; t < nt; t += 2) {
            const bool last = (t == nt - 2);
            const char* a1 = cA + (size_t)(t + 1) * kstep;
            const char* a2 = last ? nA : cA + (size_t)(t + 2) * kstep; const char* b2 = last ? nB : cB + (size_t)(t + 2) * kstep;
            const char* a3 = a2 + kstep; const char* b3 = b2 + kstep;
            if (last && has_next) S.a_ready(nxt);
            if constexpr (SP2) {
            PG8_LDB(B0, 0, 0); PG8_LDB(B1, 0, 1); PG8_SCHED; PG8_LDA(At, 0, 0); PG8_STAGE(PG8_SA(1, 1), a1 + hstep, voffA);
            PG8_WAIT_V(8); PG8_WAIT_L(0); PG8_BAR; PG8_MMA(0, 0, At, B0); PG8_MMA(0, 1, At, B1); PG8_BAR; PG8_SCHED;
            PG8_LDA(At, 0, 1); PG8_STAGE(PG8_SB(0, 0), b2, voffB); PG8_STAGE(PG8_SB(0, 1), b2 + hstep, voffB); PG8_STAGE(PG8_SA(0, 0), a2, voffA);
            PG8_WAIT_V(8); PG8_WAIT_L(0); PG8_BAR; PG8_MMA(1, 0, At, B0); PG8_MMA(1, 1, At, B1); PG8_BAR; PG8_SCHED;
            PG8_LDB(B0, 1, 0); PG8_LDB(B1, 1, 1); PG8_SCHED; PG8_LDA(At, 1, 0); PG8_STAGE(PG8_SA(0, 1), a2 + hstep, voffA);
            PG8_WAIT_V(8); PG8_WAIT_L(0); PG8_BAR; PG8_MMA(0, 0, At, B0); PG8_MMA(0, 1, At, B1); PG8_BAR; PG8_SCHED;
            PG8_LDA(At, 1, 1); PG8_STAGE(PG8_SB(1, 0), b3, voffB); PG8_STAGE(PG8_SB(1, 1), b3 + hstep, voffB); PG8_STAGE(PG8_SA(1, 0), a3, voffA);
            PG8_WAIT_V(8); PG8_WAIT_L(0); PG8_BAR; PG8_MMA(1, 0, At, B0); PG8_MMA(1, 1, At, B1); PG8_BAR; PG8_SCHED;
            } else {
            PG8_LDB(B0, 0, 0); PG8_SCHED; PG8_LDA(At, 0, 0); PG8_STAGE(PG8_SA(1, 1), a1 + hstep, voffA);
            PG8_WAIT_L(8); PG8_BAR; PG8_WAIT_L(0); PG8_MMA(0, 0, At, B0); PG8_BAR; PG8_SCHED;
            PG8_LDB(B1, 0, 1); PG8_STAGE(PG8_SB(0, 0), b2, voffB);
            PG8_BAR; PG8_WAIT_L(0); PG8_MMA(0, 1, At, B1); PG8_BAR;
            PG8_LDA(At, 0, 1); PG8_STAGE(PG8_SA(0, 0), a2, voffA);
            PG8_BAR; PG8_WAIT_L(0); PG8_MMA(1, 0, At, B0); PG8_BAR; PG8_SCHED;
            PG8_STAGE(PG8_SB(0, 1), b2 + hstep, voffB);
            PG8_WAIT_V(6); PG8_BAR; PG8_MMA(1, 1, At, B1); PG8_BAR;
            PG8_LDB(B0, 1, 0); PG8_SCHED; PG8_LDA(At, 1, 0); PG8_STAGE(PG8_SA(0, 1), a2 + hstep, voffA);
            PG8_WAIT_L(8); PG8_BAR; PG8_WAIT_L(0); PG8_MMA(0, 0, At, B0); PG8_BAR; PG8_SCHED;
            PG8_LDB(B1, 1, 1); PG8_STAGE(PG8_SB(1, 0), b3, voffB);
            PG8_BAR; PG8_WAIT_L(0); PG8_MMA(0, 1, At, B1); PG8_BAR;
            PG8_LDA(At, 1, 1); PG8_STAGE(PG8_SA(1, 0), a3, voffA);
            PG8_BAR; PG8_WAIT_L(0); PG8_MMA(1, 0, At, B0); PG8_BAR; PG8_SCHED;
            PG8_STAGE(PG8_SB(1, 1), b3 + hstep, voffB);
            PG8_WAIT_V(6); PG8_BAR; PG8_MMA(1, 1, At, B1); PG8_BAR;
            }
        }
        if constexpr (ALIGN_EPI) { if (wr == 0) PG8_BAR; }
        if constexpr (!Epi::AFTER_DRAIN) { E(acc, cur, wr, wc, fr, fq); S.done(cur); }
        if (!has_next) break;
#pragma unroll
        for (int a = 0; a < 2; ++a)
#pragma unroll
            for (int b = 0; b < 2; ++b)
#pragma unroll
                for (int m = 0; m < 4; ++m)
#pragma unroll
                    for (int n = 0; n < 2; ++n) acc[a][b][m][n] = (f32x4){0.f, 0.f, 0.f, 0.f};
        cur = nxt; cA = nA; cB = nB; ++ui;
        if constexpr (ALIGN_EPI) { if (wr == 1) PG8_BAR; }
    }
    PG8_WAIT_V(0);
    if constexpr (!ALIGN_EPI) { if (wr == 0) PG8_BAR; }
    PG8_BAR;
    if constexpr (Epi::AFTER_DRAIN) { E.fused(acc, cur, wr, wc, fr, fq, lds, wid, lane); S.done(cur); }
#undef PG8_SA
#undef PG8_SB
#undef PG8_STAGE
#undef PG8_LDA
#undef PG8_LDB
#undef PG8_MMA
#undef PG8_WAIT_V
#undef PG8_WAIT_L
#undef PG8_BAR
#undef PG8_SCHED
}
}
#define GAS __attribute__((address_space(1)))
#define LAS __attribute__((address_space(3)))
typedef unsigned short bf16;
typedef unsigned v4u __attribute__((ext_vector_type(4)));
typedef float f32x4 __attribute__((ext_vector_type(4)));
#define LDS_WAIT() asm volatile("s_waitcnt lgkmcnt(0)" ::: "memory")

#ifndef FAST_ATTN
#define FAST_ATTN 1
#endif
#ifndef ATTN_LDS
#define ATTN_LDS 1
#endif
#ifndef FAST_LOCAL
#define FAST_LOCAL 1
#endif
#ifndef FAST_OUT
#define FAST_OUT 1
#endif
#ifndef MK_ONE_LAUNCH
#define MK_ONE_LAUNCH 1
#endif

constexpr int M = 16384, DM = 1024, SEQ = 4096, NCHK = 64, CHK = 64, DFF = 4096, DIN_SRC = 5640;
constexpr int LD1 = 1024, LD2 = 1536, N2_MQ = 0, N2_MO = 512, N2_MK = 1024, T_MK = 0, T_AV = 512, T_MV = 1024;
constexpr int NUNIT = 1024;
constexpr float EPS = 1e-6f;

constexpr size_t MiB = 1u << 20;
constexpr size_t WS_CTL = 0, CTL_ZERO_BYTES = 1 * MiB;
constexpr size_t WS_SSQ = 1 * MiB;
constexpr size_t WS_WG = 1 * MiB + 320 * 1024;
constexpr size_t WS_GATES = 1 * MiB + 512 * 1024;
constexpr size_t WS_NLOC = 2 * MiB;
constexpr size_t WS_MLOC = 2 * MiB + 512 * 1024;
constexpr size_t WS_BLAST = WS_MLOC + 4096, WS_MST = WS_BLAST + 4096;
constexpr size_t WS_W = 3 * MiB;
constexpr size_t W_IN = 0, W_A = (size_t)5632 * 1024, W_M = W_A + 512 * 1024, W_O = W_M + 512 * 1024, W_UP = W_O + 1024 * 1024, W_DN = W_UP + (size_t)4096 * 1024, W_END = W_DN + (size_t)4096 * 1024;
static_assert(WS_W + W_END * 2 <= 34 * MiB, "weights");
constexpr size_t WS_XB = 34 * MiB;
constexpr size_t WS_N1 = 66 * MiB;
constexpr size_t WS_N2 = 98 * MiB;
constexpr size_t WS_T = 146 * MiB;
constexpr size_t WS_MOUT = 146 * MiB;
constexpr size_t WS_Y = 162 * MiB;
constexpr size_t WS_Z = 66 * MiB;
constexpr size_t WS_ATT = 194 * MiB;
constexpr size_t WS_CLOC = 210 * MiB;
constexpr size_t WS_H = 66 * MiB;
constexpr size_t WS_END = 242 * MiB;

constexpr int RING_BYTES = 131072, LDSCTL_OFF = RING_BYTES, MISC_OFF = LDSCTL_OFF + 320, LDS_BYTES = 147456;
constexpr int CW_BAR = 4096;

__device__ __forceinline__ unsigned f2bf(float f) { unsigned u = __builtin_bit_cast(unsigned, f); return (u + 0x7fffu + ((u >> 16) & 1u)) >> 16; }
__device__ __forceinline__ unsigned pk2(float lo, float hi) { return f2bf(lo) | (f2bf(hi) << 16); }
__device__ __forceinline__ float bf2f(bf16 v) { return __uint_as_float(((unsigned)v) << 16); }
__device__ __forceinline__ float blo(unsigned w) { return __uint_as_float(w << 16); }
__device__ __forceinline__ float bhi(unsigned w) { return __uint_as_float(w & 0xffff0000u); }
__device__ __forceinline__ float sigmf(float x) { return __builtin_amdgcn_rcpf(1.0f + __expf(-x)); }
__device__ __forceinline__ float wave_sum(float v) {
#pragma unroll
    for (int o = 1; o < 64; o <<= 1) v += __shfl_xor(v, o);
    return v;
}

__device__ __forceinline__ int win_src_col(int n0) {
    if (n0 >= 3584) return n0 + 8;
    const int blk = n0 >> 9; const int st = blk == 0 ? 0 : blk == 1 ? 512 : blk == 2 ? 1536 : blk == 3 ? 3072 : blk == 4 ? 2048 : blk == 5 ? 1024 : 2560;
    return st + (n0 & 511);
}
__device__ __forceinline__ void transpose_item(const float* W, int ldw, int is_win, const float* g, bf16* WT, int K, int nblk, LAS float* scr, int item, int lane) {
    const int kb = item / nblk, nb = item % nblk, k0 = 64 * kb, n0 = 32 * nb, sc0 = is_win ? win_src_col(n0) : n0;
    float tv[32];
#pragma unroll
    for (int i = 0; i < 32; ++i) { const int kk = 2 * i + (lane >> 5); tv[i] = W[(size_t)(k0 + kk) * ldw + sc0 + (lane & 31)]; }
#pragma unroll
    for (int i = 0; i < 32; ++i) { const int kk = 2 * i + (lane >> 5); const float gv = g ? g[k0 + kk] : 1.0f; scr[kk * 33 + (lane & 31)] = tv[i] * gv; }
    LDS_WAIT(); asm volatile("" ::: "memory");
    const int c = lane & 7;
#pragma unroll
    for (int j = 0; j < 4; ++j) { const int n = (lane >> 3) + 8 * j; const LAS float* s = scr + (8 * c) * 33 + n;
        v4u o; o.x = pk2(s[0 * 33], s[1 * 33]); o.y = pk2(s[2 * 33], s[3 * 33]); o.z = pk2(s[4 * 33], s[5 * 33]); o.w = pk2(s[6 * 33], s[7 * 33]);
        *(v4u*)(WT + (size_t)(n0 + n) * K + k0 + 8 * c) = o; }
    LDS_WAIT(); asm volatile("" ::: "memory");
}

__device__ __forceinline__ f32x4 ld_bf4(const bf16* p) { const unsigned long long w = *(const unsigned long long*)p; return (f32x4){blo((unsigned)w), bhi((unsigned)w), blo((unsigned)(w >> 32)), bhi((unsigned)(w >> 32))}; }
__device__ __forceinline__ void gates_phase(const float* x, const bf16* xbf, int layer, const float* wg, const float* bi, const float* bf_, float* gates, LAS float* ldsf, int bid, int tid) {
    constexpr int XP = 132, WP = 1028;
    LAS float* WS = ldsf; LAS float* XS = ldsf + 8 * WP;
    for (int i = tid; i < 8 * 256; i += 512) { const int g = i >> 8, k4 = i & 255; *(LAS f32x4*)(WS + g * WP + 4 * k4) = *(const f32x4*)(wg + g * 1024 + 4 * k4); }
    const int lr = tid >> 5, lc = tid & 31, row = tid >> 3, gate = tid & 7, lane = tid & 63;
    for (int rb = bid; rb < M / 64; rb += 256) {
        const float* xb0 = x + (size_t)rb * 64 * DM; const bf16* xh0 = xbf + (size_t)rb * 64 * DM;
#define GLOAD(i, kc_) (layer == 0 ? *(const f32x4*)(xb0 + (size_t)(lr + 16 * (i)) * DM + (kc_) * 128 + 4 * lc) : ld_bf4(xh0 + (size_t)(lr + 16 * (i)) * DM + (kc_) * 128 + 4 * lc))
        f32x4 pre[4];
#pragma unroll
        for (int i = 0; i < 4; ++i) pre[i] = GLOAD(i, 0);
        float acc = 0.f, ss = 0.f;
        for (int kc = 0; kc < 8; ++kc) {
            __syncthreads();
#pragma unroll
            for (int i = 0; i < 4; ++i) *(LAS f32x4*)(XS + (lr + 16 * i) * XP + 4 * lc) = pre[i];
            if (kc + 1 < 8) {
#pragma unroll
                for (int i = 0; i < 4; ++i) pre[i] = GLOAD(i, kc + 1);
            }
            __syncthreads();
            const LAS float* xr = XS + row * XP; const LAS float* wr = WS + gate * WP + kc * 128;
#pragma unroll 8
            for (int k4 = 0; k4 < 32; ++k4) { const f32x4 xv = *(const LAS f32x4*)(xr + 4 * k4), wv = *(const LAS f32x4*)(wr + 4 * k4);
                acc += (xv.x * wv.x + xv.y * wv.y) + (xv.z * wv.z + xv.w * wv.w); ss += (xv.x * xv.x + xv.y * xv.y) + (xv.z * xv.z + xv.w * xv.w); }
        }
        const float rs = rsqrtf(ss * (1.0f / 1024.0f) + EPS);
        float val = acc * rs + (gate < 4 ? bi[gate] : bf_[gate - 4]);
        if (gate >= 4) val = fminf(val, 0.f) - log1pf(__expf(-fabsf(val)));
        gates[((size_t)rb * 64 + row) * 8 + gate] = val;
    }
#undef GLOAD
    __syncthreads();
}

__device__ __forceinline__ void attn_naive(const bf16* n1, const bf16* tT, const float* relb, bf16* att, int bid, int G, int wave, int lane) {
    for (int unit = bid; unit < 256; unit += G) {
        const int b = unit >> 6, c = unit & 63, h = wave, t = lane;
        const size_t tok = (size_t)b * SEQ + c * CHK + t;
        float q[64], acc[64];
        { const v4u* qp = (const v4u*)(n1 + tok * LD1 + h * 64);
#pragma unroll
          for (int i = 0; i < 8; ++i) { const v4u w = qp[i]; q[8 * i + 0] = blo(w.x) * 0.125f; q[8 * i + 1] = bhi(w.x) * 0.125f; q[8 * i + 2] = blo(w.y) * 0.125f; q[8 * i + 3] = bhi(w.y) * 0.125f;
              q[8 * i + 4] = blo(w.z) * 0.125f; q[8 * i + 5] = bhi(w.z) * 0.125f; q[8 * i + 6] = blo(w.w) * 0.125f; q[8 * i + 7] = bhi(w.w) * 0.125f; } }
#pragma unroll
        for (int d = 0; d < 64; ++d) acc[d] = 0.f;
        float mx = -1e30f, l = 0.f;
        const float* bh = relb + h * 513;
        for (int j = (c >= 8 ? 0 : 8 - c); j <= 8; ++j) {
            const size_t ktok0 = (size_t)b * SEQ + (size_t)(c - 8 + j) * CHK;
            for (int u = 0; u < 64; ++u) {
                int uo = u; asm volatile("" : "+v"(uo));
                const bf16* rowp = n1 + (ktok0 + uo) * LD1 + h * 64;
                const v4u* kp = (const v4u*)(rowp + 512); float s = 0.f;
#pragma unroll
                for (int i = 0; i < 8; ++i) { const v4u w = kp[i];
                    s += q[8 * i + 0] * blo(w.x) + q[8 * i + 1] * bhi(w.x) + q[8 * i + 2] * blo(w.y) + q[8 * i + 3] * bhi(w.y) + q[8 * i + 4] * blo(w.z) + q[8 * i + 5] * bhi(w.z) + q[8 * i + 6] * blo(w.w) + q[8 * i + 7] * bhi(w.w); }
                int rel = t - u + 64 * (8 - j); rel = rel < -256 ? -256 : (rel > 256 ? 256 : rel);
                s += bh[rel + 256];
                if (s > mx) { const float corr = __expf(mx - s); l *= corr;
#pragma unroll
                    for (int d = 0; d < 64; ++d) acc[d] *= corr;
                    mx = s; }
                const float p = __expf(s - mx); l += p;
                const bf16* vp = tT + (size_t)(T_AV + h * 64) * M + (ktok0 + uo);
#pragma unroll
                for (int d = 0; d < 64; ++d) acc[d] += p * bf2f(vp[(size_t)d * M]);
            }
        }
        const float inv = 1.0f / l;
        v4u* op = (v4u*)(att + tok * 512 + h * 64);
#pragma unroll
        for (int i = 0; i < 8; ++i) { v4u o; o.x = pk2(acc[8 * i + 0] * inv, acc[8 * i + 1] * inv); o.y = pk2(acc[8 * i + 2] * inv, acc[8 * i + 3] * inv); o.z = pk2(acc[8 * i + 4] * inv, acc[8 * i + 5] * inv); o.w = pk2(acc[8 * i + 6] * inv, acc[8 * i + 7] * inv); op[i] = o; }
    }
}

typedef short bf16x8_t __attribute__((ext_vector_type(8)));
typedef float f32x16_t __attribute__((ext_vector_type(16)));
typedef float f32x2_t __attribute__((ext_vector_type(2))); typedef __bf16 bf16x2_t __attribute__((ext_vector_type(2)));
__device__ __forceinline__ unsigned cvtpk(float lo, float hi) { f32x2_t v = {lo, hi}; bf16x2_t b = __builtin_convertvector(v, bf16x2_t); return __builtin_bit_cast(unsigned, b); }
__device__ __forceinline__ void attn_mfma(const bf16* n1, const bf16* tT, const float* relb, bf16* att, LAS float* ldsf, int bid, int G, int wave, int lane) {
    constexpr float LOG2E = 1.4426950408889634f, SC = 0.125f * LOG2E;
    const int h = wave, r32 = lane & 31, hi = lane >> 5;
    LAS float* ext = ldsf + wave * 384;
    for (int r = lane; r < 384; r += 64) { const int rel = r - 63; const int idx = (rel > 256 ? 256 : rel) + 256; ext[r] = relb[h * 513 + idx] * LOG2E; }
    const float bconst = relb[h * 513 + 512] * LOG2E;
    LDS_WAIT();
    const int pir = (r32 & ~12) | ((r32 & 4) << 1) | ((r32 & 8) >> 1);
    for (int unit = bid; unit < 256; unit += G) {
        const int b = unit >> 6, c = unit & 63; const size_t tq0 = (size_t)b * SEQ + c * CHK;
        bf16x8_t qf[2][4];
#pragma unroll
        for (int qb = 0; qb < 2; ++qb)
#pragma unroll
            for (int s = 0; s < 4; ++s) qf[qb][s] = *(const bf16x8_t*)(n1 + (tq0 + qb * 32 + r32) * LD1 + h * 64 + 32 * hi + 8 * s);
        f32x16_t o[2][2];
#pragma unroll
        for (int qb = 0; qb < 2; ++qb)
#pragma unroll
            for (int db = 0; db < 2; ++db)
#pragma unroll
                for (int i = 0; i < 16; ++i) o[qb][db][i] = 0.f;
        float mrun[2] = {-1e30f, -1e30f}, lrun[2] = {0.f, 0.f};
        const int kb0 = (c >= 8 ? 0 : 8 - c) * 2;
        bf16x8_t kf[4], vf[2][2];
        { const size_t ktok = (size_t)b * SEQ + (size_t)(c - 8) * CHK + (size_t)kb0 * 32;
#pragma unroll
          for (int s = 0; s < 4; ++s) kf[s] = *(const bf16x8_t*)(n1 + (ktok + pir) * LD1 + 512 + h * 64 + 32 * hi + 8 * s);
#pragma unroll
          for (int db = 0; db < 2; ++db)
#pragma unroll
              for (int s2 = 0; s2 < 2; ++s2) vf[db][s2] = *(const bf16x8_t*)(tT + (size_t)(T_AV + h * 64 + db * 32 + r32) * M + ktok + 16 * s2 + 8 * hi); }
        for (int kbI = kb0; kbI < 18; ++kbI) {
            const int j = kbI >> 1, kb = kbI & 1;
            bf16x8_t kn[4], vn[2][2];
            { const int nx = kbI + 1 < 18 ? kbI + 1 : 17; const size_t ktok = (size_t)b * SEQ + (size_t)(c - 8) * CHK + (size_t)nx * 32;
#pragma unroll
              for (int s = 0; s < 4; ++s) kn[s] = *(const bf16x8_t*)(n1 + (ktok + pir) * LD1 + 512 + h * 64 + 32 * hi + 8 * s);
#pragma unroll
              for (int db = 0; db < 2; ++db)
#pragma unroll
                  for (int s2 = 0; s2 < 2; ++s2) vn[db][s2] = *(const bf16x8_t*)(tT + (size_t)(T_AV + h * 64 + db * 32 + r32) * M + ktok + 16 * s2 + 8 * hi); }
#pragma unroll
            for (int qb = 0; qb < 2; ++qb) {
                f32x16_t sa;
#pragma unroll
                for (int i = 0; i < 16; ++i) sa[i] = 0.f;
#pragma unroll
                for (int s = 0; s < 4; ++s) sa = __builtin_amdgcn_mfma_f32_32x32x16_bf16(kf[s], qf[qb][s], sa, 0, 0, 0);
                float sv[16];
                if (j >= 4) {
                    const int rbase = (qb * 32 + r32) - (kb * 32 + 8 * hi) + 64 * (8 - j) + 63;
#pragma unroll
                    for (int i = 0; i < 16; ++i) sv[i] = sa[i] * SC + ext[rbase - (i & 7) - 16 * (i >> 3)];
                } else {
#pragma unroll
                    for (int i = 0; i < 16; ++i) sv[i] = sa[i] * SC + bconst;
                }
                float mx = sv[0];
#pragma unroll
                for (int i = 1; i < 16; ++i) mx = fmaxf(mx, sv[i]);
                mx = fmaxf(mx, __shfl_xor(mx, 32));
                const float mnew = fmaxf(mrun[qb], mx), alpha = __builtin_amdgcn_exp2f(mrun[qb] - mnew); mrun[qb] = mnew;
                float ps = 0.f;
#pragma unroll
                for (int i = 0; i < 16; ++i) { sv[i] = __builtin_amdgcn_exp2f(sv[i] - mnew); ps += sv[i]; }
                lrun[qb] = lrun[qb] * alpha + ps;
#pragma unroll
                for (int db = 0; db < 2; ++db)
#pragma unroll
                    for (int i = 0; i < 16; ++i) o[qb][db][i] *= alpha;
                bf16x8_t pf[2];
#pragma unroll
                for (int s2 = 0; s2 < 2; ++s2) { v4u w; w.x = cvtpk(sv[8 * s2 + 0], sv[8 * s2 + 1]); w.y = cvtpk(sv[8 * s2 + 2], sv[8 * s2 + 3]); w.z = cvtpk(sv[8 * s2 + 4], sv[8 * s2 + 5]); w.w = cvtpk(sv[8 * s2 + 6], sv[8 * s2 + 7]);
                    pf[s2] = __builtin_bit_cast(bf16x8_t, w); }
#pragma unroll
                for (int db = 0; db < 2; ++db)
#pragma unroll
                    for (int s2 = 0; s2 < 2; ++s2) o[qb][db] = __builtin_amdgcn_mfma_f32_32x32x16_bf16(vf[db][s2], pf[s2], o[qb][db], 0, 0, 0);
            }
#pragma unroll
            for (int s = 0; s < 4; ++s) kf[s] = kn[s];
#pragma unroll
            for (int db = 0; db < 2; ++db)
#pragma unroll
                for (int s2 = 0; s2 < 2; ++s2) vf[db][s2] = vn[db][s2];
        }
#pragma unroll
        for (int qb = 0; qb < 2; ++qb) {
            const float lt = lrun[qb] + __shfl_xor(lrun[qb], 32), inv = 1.0f / lt;
            bf16* op = att + (tq0 + qb * 32 + r32) * 512 + h * 64 + 4 * hi;
#pragma unroll
            for (int db = 0; db < 2; ++db)
#pragma unroll
                for (int g4 = 0; g4 < 4; ++g4) { unsigned long long w = (unsigned long long)cvtpk(o[qb][db][4 * g4 + 0] * inv, o[qb][db][4 * g4 + 1] * inv) | ((unsigned long long)cvtpk(o[qb][db][4 * g4 + 2] * inv, o[qb][db][4 * g4 + 3] * inv) << 32);
                    *(unsigned long long*)(op + db * 32 + 8 * g4) = w; }
        }
    }
}

__device__ __forceinline__ float wave_max(float v) {
#pragma unroll
    for (int o = 1; o < 64; o <<= 1) v = fmaxf(v, __shfl_xor(v, o));
    return v;
}
__device__ __forceinline__ float scan_add(float v, int lane) {
#pragma unroll
    for (int o = 1; o < 64; o <<= 1) { const float t = __shfl_up(v, o); if (lane >= o) v += t; }
    return v;
}
__device__ __forceinline__ float scan_max(float v, int lane) {
#pragma unroll
    for (int o = 1; o < 64; o <<= 1) { const float t = __shfl_up(v, o); if (lane >= o) v = fmaxf(v, t); }
    return v;
}
__device__ __forceinline__ bf16x8_t pack8(const float* v) { v4u w; w.x = cvtpk(v[0], v[1]); w.y = cvtpk(v[2], v[3]); w.z = cvtpk(v[4], v[5]); w.w = cvtpk(v[6], v[7]); return __builtin_bit_cast(bf16x8_t, w); }

__device__ __forceinline__ void attn_mfma_lds(const bf16* n1, const bf16* tT, const float* relb, bf16* att, LAS unsigned char* ldsb, int bid, int G, int wave, int lane) {
    constexpr float LOG2E = 1.4426950408889634f, SC = 0.125f * LOG2E;
    const int h = wave, r32 = lane & 31, hi = lane >> 5;
    LAS float* ext = (LAS float*)(ldsb + RING_BYTES + 1024) + wave * 384;
    for (int r = lane; r < 384; r += 64) { const int rel = r - 63; const int idx = (rel > 256 ? 256 : rel) + 256; ext[r] = relb[h * 513 + idx] * LOG2E; }
    const float bconst = relb[h * 513 + 512] * LOG2E;
    LAS unsigned char* KI = ldsb + wave * 8192; LAS unsigned char* VI = KI + 4096;
    const int pir = (r32 & ~12) | ((r32 & 4) << 1) | ((r32 & 8) >> 1);
    const int krow_s = lane >> 3, kch_s = lane & 7, vrow_s = lane >> 2, vch_s = lane & 3;
    const int kwev = krow_s * 128 + ((kch_s ^ (krow_s >> 1)) << 4), kwod = krow_s * 128 + ((kch_s ^ (krow_s >> 1) ^ 4) << 4);
    const int vw = vrow_s * 64 + ((vch_s ^ ((vrow_s >> 2) & 3)) << 4);
    int koff[4], voff[2];
#pragma unroll
    for (int s = 0; s < 4; ++s) koff[s] = pir * 128 + (((4 * hi + s) ^ ((pir >> 1) & 7)) << 4);
#pragma unroll
    for (int s2 = 0; s2 < 2; ++s2) voff[s2] = r32 * 64 + (((2 * s2 + hi) ^ ((r32 >> 2) & 3)) << 4);
    const bf16* kbase = n1 + (size_t)krow_s * LD1 + 512 + h * 64 + kch_s * 8;
    const bf16* vbase = tT + (size_t)(T_AV + h * 64 + vrow_s) * M + vch_s * 8;
    for (int u0 = bid; u0 < 256; u0 += G) {
        const int unit = (u0 & 7) * 32 + (u0 >> 3);
        const int b = unit >> 6, c = unit & 63; const size_t tq0 = (size_t)b * SEQ + c * CHK;
        bf16x8_t qf[2][4];
#pragma unroll
        for (int qb = 0; qb < 2; ++qb)
#pragma unroll
            for (int s = 0; s < 4; ++s) qf[qb][s] = *(const bf16x8_t*)(n1 + (tq0 + qb * 32 + r32) * LD1 + h * 64 + 32 * hi + 8 * s);
        f32x16_t o[2][2];
#pragma unroll
        for (int qb = 0; qb < 2; ++qb)
#pragma unroll
            for (int db = 0; db < 2; ++db)
#pragma unroll
                for (int i = 0; i < 16; ++i) o[qb][db][i] = 0.f;
        float mrun[2] = {-1e30f, -1e30f}, lrun[2] = {0.f, 0.f};
        const int kb0 = (c >= 8 ? 0 : 8 - c) * 2;
        const size_t kt00 = (size_t)b * SEQ + (size_t)(c - 8) * CHK;
        v4u gk[4], gv[4];
        { const size_t ktok = kt00 + (size_t)kb0 * 32;
#pragma unroll
          for (int i = 0; i < 4; ++i) { gk[i] = *(const v4u*)(kbase + (ktok + 8 * i) * LD1); gv[i] = *(const v4u*)(vbase + (size_t)(16 * i) * M + ktok); } }
        for (int kbI = kb0; kbI < 18; ++kbI) {
            const int j = kbI >> 1, kb = kbI & 1;
#pragma unroll
            for (int i = 0; i < 4; ++i) { *(LAS v4u*)(KI + ((i & 1) ? kwod : kwev) + 1024 * i) = gk[i]; *(LAS v4u*)(VI + vw + 1024 * i) = gv[i]; }
            { const int nx = kbI + 1 < 18 ? kbI + 1 : 17; const size_t ktok = kt00 + (size_t)nx * 32;
#pragma unroll
              for (int i = 0; i < 4; ++i) { gk[i] = *(const v4u*)(kbase + (ktok + 8 * i) * LD1); gv[i] = *(const v4u*)(vbase + (size_t)(16 * i) * M + ktok); } }
            bf16x8_t kf[4], vf[2][2];
#pragma unroll
            for (int s = 0; s < 4; ++s) kf[s] = *(const LAS bf16x8_t*)(KI + koff[s]);
#pragma unroll
            for (int db = 0; db < 2; ++db)
#pragma unroll
                for (int s2 = 0; s2 < 2; ++s2) vf[db][s2] = *(const LAS bf16x8_t*)(VI + db * 2048 + voff[s2]);
#pragma unroll
            for (int qb = 0; qb < 2; ++qb) {
                f32x16_t sa;
#pragma unroll
                for (int i = 0; i < 16; ++i) sa[i] = 0.f;
#pragma unroll
                for (int s = 0; s < 4; ++s) sa = __builtin_amdgcn_mfma_f32_32x32x16_bf16(kf[s], qf[qb][s], sa, 0, 0, 0);
                float sv[16];
                if (j >= 4) {
                    const int rbase = (qb * 32 + r32) - (kb * 32 + 8 * hi) + 64 * (8 - j) + 63;
#pragma unroll
                    for (int i = 0; i < 16; ++i) sv[i] = sa[i] * SC + ext[rbase - (i & 7) - 16 * (i >> 3)];
                } else {
#pragma unroll
                    for (int i = 0; i < 16; ++i) sv[i] = sa[i] * SC + bconst;
                }
                float mx = sv[0];
#pragma unroll
                for (int i = 1; i < 16; ++i) mx = fmaxf(mx, sv[i]);
                mx = fmaxf(mx, __shfl_xor(mx, 32));
                const float mnew = fmaxf(mrun[qb], mx), alpha = __builtin_amdgcn_exp2f(mrun[qb] - mnew); mrun[qb] = mnew;
                float ps = 0.f;
#pragma unroll
                for (int i = 0; i < 16; ++i) { sv[i] = __builtin_amdgcn_exp2f(sv[i] - mnew); ps += sv[i]; }
                lrun[qb] = lrun[qb] * alpha + ps;
#pragma unroll
                for (int db = 0; db < 2; ++db)
#pragma unroll
                    for (int i = 0; i < 16; ++i) o[qb][db][i] *= alpha;
                bf16x8_t pf[2] = {pack8(sv), pack8(sv + 8)};
#pragma unroll
                for (int db = 0; db < 2; ++db)
#pragma unroll
                    for (int s2 = 0; s2 < 2; ++s2) o[qb][db] = __builtin_amdgcn_mfma_f32_32x32x16_bf16(vf[db][s2], pf[s2], o[qb][db], 0, 0, 0);
            }
        }
#pragma unroll
        for (int qb = 0; qb < 2; ++qb) {
            const float lt = lrun[qb] + __shfl_xor(lrun[qb], 32), inv = 1.0f / lt;
            bf16* op = att + (tq0 + qb * 32 + r32) * 512 + h * 64 + 4 * hi;
#pragma unroll
            for (int db = 0; db < 2; ++db)
#pragma unroll
                for (int g4 = 0; g4 < 4; ++g4) { unsigned long long w = (unsigned long long)cvtpk(o[qb][db][4 * g4 + 0] * inv, o[qb][db][4 * g4 + 1] * inv) | ((unsigned long long)cvtpk(o[qb][db][4 * g4 + 2] * inv, o[qb][db][4 * g4 + 3] * inv) << 32);
                    *(unsigned long long*)(op + db * 32 + 8 * g4) = w; }
        }
    }
}


__device__ __forceinline__ void mlstm_local_mfma(const bf16* tT, const float* gates, const float* cw, const float* cb, bf16* cloc, float* nloc, float* mloc, float* blast, LAS float* ldsf, int bid, int G, int wave, int lane) {
    LAS float* wsm = ldsf + wave * 64;
    const int r32 = lane & 31, hi = lane >> 5;
    for (int task = bid * 8 + wave; task < 2 * NUNIT; task += G * 8) {
        const int unit = task >> 1, kh = task & 1, b = unit >> 8, c = (unit >> 2) & 63, h = unit & 3; const size_t tok0 = (size_t)b * SEQ + c * CHK;
        const float lf = gates[(tok0 + lane) * 8 + 4 + h], ig = gates[(tok0 + lane) * 8 + h];
        const float cum = scan_add(lf, lane), bl = __shfl(cum, 63), a = bl - cum + ig, mxa = wave_max(a);
        wsm[lane] = __expf(a - mxa);
        LDS_WAIT();
        if (kh == 0 && lane == 0) { mloc[unit] = mxa; blast[unit] = bl; }
        f32x16_t acc[2][4];
#pragma unroll
        for (int kb2 = 0; kb2 < 2; ++kb2)
#pragma unroll
            for (int vb = 0; vb < 4; ++vb)
#pragma unroll
                for (int i = 0; i < 16; ++i) acc[kb2][vb][i] = 0.f;
        float nsum[2] = {0.f, 0.f};
        float cwr[2][4], cbr[2];
#pragma unroll
        for (int kb2 = 0; kb2 < 2; ++kb2) { const int ch = 512 + h * 128 + kh * 64 + kb2 * 32 + r32; cbr[kb2] = cb[ch];
#pragma unroll
            for (int j = 0; j < 4; ++j) cwr[kb2][j] = cw[j * 1024 + ch]; }
#pragma unroll
        for (int s = 0; s < 4; ++s) {
            const int l0 = 16 * s + 8 * hi;
            float wv[8];
            { const f32x4 w0 = *(const LAS f32x4*)(wsm + l0), w1 = *(const LAS f32x4*)(wsm + l0 + 4); wv[0] = w0.x; wv[1] = w0.y; wv[2] = w0.z; wv[3] = w0.w; wv[4] = w1.x; wv[5] = w1.y; wv[6] = w1.z; wv[7] = w1.w; }
            bf16x8_t af[2];
#pragma unroll
            for (int kb2 = 0; kb2 < 2; ++kb2) {
                const bf16* rp = tT + (size_t)(T_MK + h * 128 + kh * 64 + kb2 * 32 + r32) * M + tok0 + l0;
                const v4u cur = *(const v4u*)rp; unsigned long long prev = *(const unsigned long long*)(rp - 4);
                if (c == 0 && l0 == 0) prev = 0ull;
                float x[11];
                x[0] = bhi((unsigned)prev); x[1] = blo((unsigned)(prev >> 32)); x[2] = bhi((unsigned)(prev >> 32));
                x[3] = blo(cur.x); x[4] = bhi(cur.x); x[5] = blo(cur.y); x[6] = bhi(cur.y); x[7] = blo(cur.z); x[8] = bhi(cur.z); x[9] = blo(cur.w); x[10] = bhi(cur.w);
                float kv[8];
#pragma unroll
                for (int j = 0; j < 8; ++j) { const float av = cbr[kb2] + cwr[kb2][0] * x[j] + cwr[kb2][1] * x[j + 1] + cwr[kb2][2] * x[j + 2] + cwr[kb2][3] * x[j + 3];
                    const float kw = av * sigmf(av) * 0.08838834764831845f * wv[j]; kv[j] = kw; nsum[kb2] += kw; }
                af[kb2] = pack8(kv);
            }
#pragma unroll
            for (int vb = 0; vb < 4; ++vb) {
                const bf16x8_t vfr = *(const bf16x8_t*)(tT + (size_t)(T_MV + h * 128 + vb * 32 + r32) * M + tok0 + l0);
#pragma unroll
                for (int kb2 = 0; kb2 < 2; ++kb2) acc[kb2][vb] = __builtin_amdgcn_mfma_f32_32x32x16_bf16(af[kb2], vfr, acc[kb2][vb], 0, 0, 0);
            }
        }
#pragma unroll
        for (int kb2 = 0; kb2 < 2; ++kb2) { const float ns = nsum[kb2] + __shfl_xor(nsum[kb2], 32); if (hi == 0) nloc[unit * 128 + kh * 64 + kb2 * 32 + r32] = ns; }
#pragma unroll
        for (int kb2 = 0; kb2 < 2; ++kb2)
#pragma unroll
            for (int vb = 0; vb < 4; ++vb) { bf16* cp = cloc + (size_t)unit * 16384 + (size_t)(vb * 32 + r32) * 128 + kh * 64 + kb2 * 32 + 4 * hi;
#pragma unroll
                for (int g4 = 0; g4 < 4; ++g4) *(unsigned long long*)(cp + 8 * g4) = (unsigned long long)cvtpk(acc[kb2][vb][4 * g4 + 0], acc[kb2][vb][4 * g4 + 1]) | ((unsigned long long)cvtpk(acc[kb2][vb][4 * g4 + 2], acc[kb2][vb][4 * g4 + 3]) << 32); }
    }
}

__device__ __forceinline__ void conv_prepass(const bf16* n2, const float* cw, const float* cb, bf16* qk, int bid, int G, int tid) {
    for (int it = bid * 512 + tid; it < (M / 16) * 128; it += G * 512) {
        const int cg = it & 127, tr = it >> 7, ch0 = 8 * cg; const size_t t0 = (size_t)tr * 16;
        const bf16* src = n2 + (ch0 < 512 ? N2_MQ + ch0 : N2_MK + (ch0 - 512));
        const float sc = ch0 < 512 ? 1.0f : 0.08838834764831845f;
        float w[4][8], bb[8];
#pragma unroll
        for (int e = 0; e < 8; ++e) { bb[e] = cb[ch0 + e];
#pragma unroll
            for (int j = 0; j < 4; ++j) w[j][e] = cw[j * 1024 + ch0 + e]; }
        float x0[8], x1[8], x2[8];
        const bool first = (t0 & (SEQ - 1)) == 0;
#pragma unroll
        for (int r = 0; r < 3; ++r) { v4u v = {0u, 0u, 0u, 0u}; if (!first) v = *(const v4u*)(src + (t0 - 3 + r) * LD2);
            float* d = r == 0 ? x0 : (r == 1 ? x1 : x2);
            d[0] = blo(v.x); d[1] = bhi(v.x); d[2] = blo(v.y); d[3] = bhi(v.y); d[4] = blo(v.z); d[5] = bhi(v.z); d[6] = blo(v.w); d[7] = bhi(v.w); }
#pragma unroll 4
        for (int i = 0; i < 16; ++i) {
            const v4u v = *(const v4u*)(src + (t0 + i) * LD2); float x3[8] = {blo(v.x), bhi(v.x), blo(v.y), bhi(v.y), blo(v.z), bhi(v.z), blo(v.w), bhi(v.w)}; float o[8];
#pragma unroll
            for (int e = 0; e < 8; ++e) { const float a = bb[e] + w[0][e] * x0[e] + w[1][e] * x1[e] + w[2][e] * x2[e] + w[3][e] * x3[e]; o[e] = a * sigmf(a) * sc; x0[e] = x1[e]; x1[e] = x2[e]; x2[e] = x3[e]; }
            v4u ov; ov.x = cvtpk(o[0], o[1]); ov.y = cvtpk(o[2], o[3]); ov.z = cvtpk(o[4], o[5]); ov.w = cvtpk(o[6], o[7]);
            *(v4u*)(qk + (t0 + i) * 1024 + ch0) = ov;
        }
    }
}

__device__ __forceinline__ void mlstm_out_mfma(const bf16* qk, const bf16* n2, const bf16* tT, const float* gates, const bf16* cst, const float* nst, const float* mst, const float* mhg, bf16* mout, LAS float* ldsf, int bid, int G, int wave, int lane) {
    LAS float* sm = ldsf + wave * 256;
    const int r32 = lane & 31, hi = lane >> 5;
    const int pir = (r32 & ~12) | ((r32 & 4) << 1) | ((r32 & 8) >> 1);
    for (int task = bid * 8 + wave; task < 2 * NUNIT; task += G * 8) {
        const int unit = task >> 1, tb = task & 1, b = unit >> 8, c = (unit >> 2) & 63, h = unit & 3; const size_t tok0 = (size_t)b * SEQ + c * CHK;
        { const float lf = gates[(tok0 + lane) * 8 + 4 + h], ig = gates[(tok0 + lane) * 8 + h];
          const float cum = scan_add(lf, lane), e = ig - cum, pm = scan_max(e, lane), g = cum + mst[unit], mt = fmaxf(g, cum + pm);
          sm[lane] = e; sm[64 + lane] = cum; sm[128 + lane] = mt; sm[192 + lane] = __expf(g - mt); }
        LDS_WAIT();
        const int t = tb * 32 + r32; const float bc_t = sm[64 + t], mt_t = sm[128 + t], in_t = sm[192 + t];
        bf16x8_t qf[8];
#pragma unroll
        for (int s = 0; s < 8; ++s) qf[s] = *(const bf16x8_t*)(qk + (tok0 + t) * 1024 + h * 128 + 64 * hi + 8 * s);
        float nq = 0.f;
#pragma unroll
        for (int s = 0; s < 8; ++s) { const f32x4 n0 = *(const f32x4*)(nst + unit * 128 + 64 * hi + 8 * s), n1 = *(const f32x4*)(nst + unit * 128 + 64 * hi + 8 * s + 4); const v4u q = __builtin_bit_cast(v4u, qf[s]);
            nq += n0.x * blo(q.x) + n0.y * bhi(q.x) + n0.z * blo(q.y) + n0.w * bhi(q.y) + n1.x * blo(q.z) + n1.y * bhi(q.z) + n1.z * blo(q.w) + n1.w * bhi(q.w); }
        nq += __shfl_xor(nq, 32);
        f32x16_t num[4];
#pragma unroll
        for (int vb = 0; vb < 4; ++vb) {
#pragma unroll
            for (int i = 0; i < 16; ++i) num[vb][i] = 0.f;
#pragma unroll
            for (int s = 0; s < 8; ++s) { const bf16x8_t cf = *(const bf16x8_t*)(cst + (size_t)unit * 16384 + (size_t)(vb * 32 + r32) * 128 + 64 * hi + 8 * s);
                num[vb] = __builtin_amdgcn_mfma_f32_32x32x16_bf16(cf, qf[s], num[vb], 0, 0, 0); }
#pragma unroll
            for (int i = 0; i < 16; ++i) num[vb][i] *= in_t;
        }
        float dsum = 0.f;
        for (int sb = 0; sb <= tb; ++sb) {
            f32x16_t sa;
#pragma unroll
            for (int i = 0; i < 16; ++i) sa[i] = 0.f;
#pragma unroll
            for (int s = 0; s < 8; ++s) { const bf16x8_t kf = *(const bf16x8_t*)(qk + (tok0 + sb * 32 + pir) * 1024 + 512 + h * 128 + 64 * hi + 8 * s);
                sa = __builtin_amdgcn_mfma_f32_32x32x16_bf16(kf, qf[s], sa, 0, 0, 0); }
            float dv[16];
#pragma unroll
            for (int hf = 0; hf < 2; ++hf) { const int sbase = sb * 32 + 16 * hf + 8 * hi;
                const f32x4 e0 = *(const LAS f32x4*)(sm + sbase), e1 = *(const LAS f32x4*)(sm + sbase + 4); const float ev[8] = {e0.x, e0.y, e0.z, e0.w, e1.x, e1.y, e1.z, e1.w};
#pragma unroll
                for (int j = 0; j < 8; ++j) { float val = sa[8 * hf + j] * __expf(bc_t - mt_t + ev[j]); val = (sbase + j > t) ? 0.f : val; dv[8 * hf + j] = val; dsum += val; } }
            bf16x8_t pf[2] = {pack8(dv), pack8(dv + 8)};
#pragma unroll
            for (int vb = 0; vb < 4; ++vb)
#pragma unroll
                for (int s2 = 0; s2 < 2; ++s2) { const bf16x8_t vfr = *(const bf16x8_t*)(tT + (size_t)(T_MV + h * 128 + vb * 32 + r32) * M + tok0 + sb * 32 + 16 * s2 + 8 * hi);
                    num[vb] = __builtin_amdgcn_mfma_f32_32x32x16_bf16(vfr, pf[s2], num[vb], 0, 0, 0); }
        }
        dsum += __shfl_xor(dsum, 32);
        const float den = in_t * nq + dsum, inv = 1.0f / fmaxf(fabsf(den), __expf(-mt_t));
        float ss = 0.f;
#pragma unroll
        for (int vb = 0; vb < 4; ++vb)
#pragma unroll
            for (int i = 0; i < 16; ++i) { const float hv = num[vb][i] * inv; num[vb][i] = hv; ss += hv * hv; }
        ss += __shfl_xor(ss, 32);
        const float rms = rsqrtf(ss * (1.0f / 128.0f) + EPS);
#pragma unroll
        for (int vb = 0; vb < 4; ++vb)
#pragma unroll
            for (int g4 = 0; g4 < 4; ++g4) { const int v0 = vb * 32 + 8 * g4 + 4 * hi;
                const unsigned long long mo = *(const unsigned long long*)(n2 + (tok0 + t) * LD2 + N2_MO + h * 128 + v0); const f32x4 gg = *(const f32x4*)(mhg + h * 128 + v0);
                const float o0 = sigmf(blo((unsigned)mo)) * num[vb][4 * g4 + 0] * rms * gg.x, o1 = sigmf(bhi((unsigned)mo)) * num[vb][4 * g4 + 1] * rms * gg.y;
                const float o2 = sigmf(blo((unsigned)(mo >> 32))) * num[vb][4 * g4 + 2] * rms * gg.z, o3 = sigmf(bhi((unsigned)(mo >> 32))) * num[vb][4 * g4 + 3] * rms * gg.w;
                *(unsigned long long*)(mout + (tok0 + t) * 512 + h * 128 + v0) = (unsigned long long)cvtpk(o0, o1) | ((unsigned long long)cvtpk(o2, o3) << 32); }
    }
}

__device__ __forceinline__ void mlstm_local_naive(const bf16* n2, const bf16* tT, const float* gates, const float* cw, const float* cb, bf16* cloc, float* nloc, float* mloc, float* blast, float* lds, int bid, int G, int tid) {
    float* KS = lds; float* WV = lds + 8192; float* sm = lds + 16384;
    for (int unit = bid; unit < NUNIT; unit += G) {
        const int b = unit >> 8, c = (unit >> 2) & 63, h = unit & 3; const size_t tok0 = (size_t)b * SEQ + c * CHK;
        if (tid < 64) { sm[tid] = gates[(tok0 + tid) * 8 + 4 + h]; sm[64 + tid] = gates[(tok0 + tid) * 8 + h]; }
        __syncthreads();
        if (tid == 0) { float cum = 0.f; for (int l = 0; l < 64; ++l) { cum += sm[l]; sm[128 + l] = cum; }
            float mxa = -INFINITY; for (int l = 0; l < 64; ++l) { const float a = cum - sm[128 + l] + sm[64 + l]; sm[192 + l] = a; mxa = fmaxf(mxa, a); }
            for (int l = 0; l < 64; ++l) sm[192 + l] = __expf(sm[192 + l] - mxa);
            sm[256] = mxa; sm[257] = cum; }
        __syncthreads();
        for (int e = tid; e < 8192; e += 512) { const int l = e >> 7, d = e & 127, pos = c * CHK + l, ch = 512 + h * 128 + d;
            float a = cb[ch];
#pragma unroll
            for (int j = 0; j < 4; ++j) { const int p = pos - 3 + j; if (p >= 0) a += cw[j * 1024 + ch] * bf2f(n2[((size_t)b * SEQ + p) * LD2 + N2_MK + h * 128 + d]); }
            KS[e] = a * sigmf(a) * 0.08838834764831845f;
            WV[e] = sm[192 + l] * bf2f(tT[(size_t)(T_MV + h * 128 + d) * M + tok0 + l]); }
        __syncthreads();
        { const int k = tid & 127, vg = tid >> 7; float a[32];
#pragma unroll
          for (int i = 0; i < 32; ++i) a[i] = 0.f;
          for (int l = 0; l < 64; ++l) { const float kk = KS[l * 128 + k];
#pragma unroll
              for (int i = 0; i < 32; ++i) a[i] += WV[l * 128 + vg * 32 + i] * kk; }
          bf16* cp = cloc + (size_t)unit * 16384 + (size_t)(vg * 32) * 128 + k;
#pragma unroll
          for (int i = 0; i < 32; ++i) cp[i * 128] = (bf16)f2bf(a[i]); }
        if (tid < 128) { float s = 0.f; for (int l = 0; l < 64; ++l) s += sm[192 + l] * KS[l * 128 + tid]; nloc[unit * 128 + tid] = s; }
        if (tid == 0) { mloc[unit] = sm[256]; blast[unit] = sm[257]; }
        __syncthreads();
    }
}

__device__ __forceinline__ void mlstm_scan(bf16* cloc, float* nloc, const float* mloc, const float* blast, float* mst, int bid, int G, int tid, int dry) {
    const int gt = bid * 512 + tid, NT = G * 512;
    for (int it = gt; it < 16 * 8192; it += NT) {
        const int bh = it >> 13, e2 = it & 8191, b = bh >> 2, h = bh & 3; float C0 = 0.f, C1 = 0.f, m = 0.f;
        unsigned* base = (unsigned*)cloc + e2; const int u0 = b * NCHK * 4 + h;
        constexpr int PD = 16;
        unsigned w[PD]; float ml[PD], bl[PD];
#pragma unroll
        for (int i = 0; i < PD; ++i) { const int unit = u0 + 4 * i; w[i] = base[(size_t)unit * 8192]; ml[i] = mloc[unit]; bl[i] = blast[unit]; }
        for (int c0 = 0; c0 < NCHK; c0 += PD) {
#pragma unroll
            for (int i = 0; i < PD; ++i) {
                const int unit = u0 + 4 * (c0 + i); const unsigned wc = w[i]; const float mlc = ml[i], blc = bl[i];
                if (c0 + PD < NCHK) { const int un = unit + 4 * PD; w[i] = base[(size_t)un * 8192]; ml[i] = mloc[un]; bl[i] = blast[un]; }
                if (!dry) base[(size_t)unit * 8192] = pk2(C0, C1);
                if (e2 == 0 && !dry) mst[unit] = m;
                const float mn = fmaxf(blc + m, mlc), sp = __expf(blc + m - mn), sl = __expf(mlc - mn);
                C0 = sp * C0 + sl * blo(wc); C1 = sp * C1 + sl * bhi(wc); m = mn;
            }
        }
    }
    for (int it = gt; it < 16 * 128; it += NT) {
        const int bh = it >> 7, k = it & 127, b = bh >> 2, h = bh & 3; float n = 0.f, m = 0.f;
        for (int c = 0; c < NCHK; ++c) { const int unit = (b * NCHK + c) * 4 + h; const float ml = mloc[unit], bl = blast[unit];
            const float nl = nloc[unit * 128 + k]; if (!dry) nloc[unit * 128 + k] = n;
            const float mn = fmaxf(bl + m, ml), sp = __expf(bl + m - mn), sl = __expf(ml - mn);
            n = sp * n + sl * nl; m = mn; }
    }
}

__device__ __forceinline__ void mlstm_out_naive(const bf16* n2, const bf16* tT, const float* gates, const float* cw, const float* cb, const bf16* cst, const float* nst, const float* mst, const float* mhg, bf16* mout, float* lds, int bid, int G, int tid) {
    constexpr int QP = 129, DP = 65;
    float* QS = lds; float* KS = lds + 64 * QP; float* VS = lds + 2 * 64 * QP; float* DS = VS + 8192; float* sm = DS + 64 * DP;
    for (int unit = bid; unit < NUNIT; unit += G) {
        const int b = unit >> 8, c = (unit >> 2) & 63, h = unit & 3; const size_t tok0 = (size_t)b * SEQ + c * CHK;
        for (int e = tid; e < 8192; e += 512) { const int l = e >> 7, d = e & 127, pos = c * CHK + l, chq = h * 128 + d, chk = 512 + chq;
            float aq = cb[chq], ak = cb[chk];
#pragma unroll
            for (int j = 0; j < 4; ++j) { const int p = pos - 3 + j; if (p >= 0) { const bf16* rp = n2 + ((size_t)b * SEQ + p) * LD2; aq += cw[j * 1024 + chq] * bf2f(rp[N2_MQ + chq]); ak += cw[j * 1024 + chk] * bf2f(rp[N2_MK + chq]); } }
            QS[l * QP + d] = aq * sigmf(aq); KS[l * QP + d] = ak * sigmf(ak) * 0.08838834764831845f;
            VS[e] = bf2f(tT[(size_t)(T_MV + chq) * M + tok0 + l]); }
        if (tid < 64) { sm[tid] = gates[(tok0 + tid) * 8 + 4 + h]; sm[64 + tid] = gates[(tok0 + tid) * 8 + h]; }
        __syncthreads();
        if (tid == 0) { float cum = 0.f, pm = -INFINITY; const float ms = mst[unit];
            for (int t = 0; t < 64; ++t) { cum += sm[t]; sm[128 + t] = cum; pm = fmaxf(pm, sm[64 + t] - cum); const float g = cum + ms, mt = fmaxf(g, cum + pm); sm[192 + t] = mt; sm[256 + t] = __expf(g - mt); } }
        __syncthreads();
        for (int e = tid; e < 4096; e += 512) { const int t = e >> 6, s = e & 63; float val = 0.f;
            if (s <= t) { float dot = 0.f;
#pragma unroll 8
                for (int d = 0; d < 128; ++d) dot += QS[t * QP + d] * KS[s * QP + d];
                val = dot * __expf(sm[128 + t] - sm[128 + s] + sm[64 + s] - sm[192 + t]); }
            DS[t * DP + s] = val; }
        __syncthreads();
        if (tid < 64) { const int t = tid; float sq = 0.f, sd = 0.f;
            for (int k = 0; k < 128; ++k) sq += nst[unit * 128 + k] * QS[t * QP + k];
            for (int s = 0; s < 64; ++s) sd += DS[t * DP + s];
            const float den = sm[256 + t] * sq + sd; sm[320 + t] = fmaxf(fabsf(den), __expf(-sm[192 + t])); }
        const int v = tid & 127, tg = tid >> 7; float a[16];
#pragma unroll
        for (int i = 0; i < 16; ++i) a[i] = 0.f;
        { const bf16* crow = cst + (size_t)unit * 16384 + (size_t)v * 128;
          for (int k = 0; k < 128; ++k) { const float cv = bf2f(crow[k]);
#pragma unroll
              for (int i = 0; i < 16; ++i) a[i] += cv * QS[(tg * 16 + i) * QP + k]; } }
#pragma unroll
        for (int i = 0; i < 16; ++i) a[i] *= sm[256 + tg * 16 + i];
        for (int s = 0; s < 64; ++s) { const float vv = VS[s * 128 + v];
#pragma unroll
            for (int i = 0; i < 16; ++i) a[i] += DS[(tg * 16 + i) * DP + s] * vv; }
        __syncthreads();
        float* HS = KS;
#pragma unroll
        for (int i = 0; i < 16; ++i) HS[(tg * 16 + i) * QP + v] = a[i] / sm[320 + tg * 16 + i];
        __syncthreads();
        if (tid < 64) { float s = 0.f; for (int k = 0; k < 128; ++k) { const float x = HS[tid * QP + k]; s += x * x; } sm[384 + tid] = rsqrtf(s * (1.0f / 128.0f) + EPS); }
        __syncthreads();
        for (int e = tid; e < 8192; e += 512) { const int t = e >> 7, vv = e & 127;
            const float mo = bf2f(n2[(tok0 + t) * LD2 + N2_MO + h * 128 + vv]);
            mout[(tok0 + t) * 512 + h * 128 + vv] = (bf16)f2bf(sigmf(mo) * HS[t * QP + vv] * sm[384 + t] * mhg[h * 128 + vv]); }
        __syncthreads();
    }
}

#define XB_TMO      128
#define XB_XCNT(j)  (256  + 64 * (j))
#define XB_XSUB(j)  (1280 + 64 * (j))
#define XB_XGEN(j)  (2304 + 64 * (j))
#define XB_TOP      3328
#define XB_TOPGEN   3392
#define XCD_BAR_WORDS 3456
#define XB_SPIN_CAP (1u << 18)

__device__ __forceinline__ unsigned xb_ld(unsigned* p)              { return __hip_atomic_load(p, __ATOMIC_RELAXED, __HIP_MEMORY_SCOPE_AGENT); }
__device__ __forceinline__ unsigned xb_add(unsigned* p, unsigned v) { return __hip_atomic_fetch_add(p, v, __ATOMIC_RELAXED, __HIP_MEMORY_SCOPE_AGENT); }
__device__ __forceinline__ unsigned xb_xcc_id() { return (unsigned)__builtin_amdgcn_s_getreg((3 << 11) | 20) & 0xFu; }
#define XB_SPIN(cond, bar) do { unsigned _sp = 0; while (cond) { __builtin_amdgcn_s_sleep(1); \
    if ((++_sp & 255u) == 0u) { if (xb_ld(&(bar)[XB_TMO])) break; if (_sp > XB_SPIN_CAP) { atomicAdd(&(bar)[XB_TMO], 1u); break; } } } } while (0)

struct XcdBarrier {
    unsigned* bar; unsigned x;
    volatile LAS unsigned* st;
};

__device__ __forceinline__ XcdBarrier xcd_barrier_post(unsigned* bar, volatile LAS unsigned* st) {
    XcdBarrier b; b.bar = bar; b.x = xb_xcc_id(); b.st = st;
    if (threadIdx.x == 0) (void)xb_add(&bar[XB_XCNT(b.x)], 1u);
    return b;
}
__device__ __forceinline__ void xcd_barrier_complete(unsigned* bar, unsigned x, unsigned& nloc, unsigned& nx) {
    const unsigned G = gridDim.x * gridDim.y * gridDim.z;
    unsigned sum, cnt, mine, sp = 0u;
    for (;;) {
        sum = 0u; cnt = 0u; mine = 0u;
#pragma unroll
        for (unsigned j = 0; j < 16; ++j) { const unsigned c = xb_ld(&bar[XB_XCNT(j)]); sum += c; cnt += (c > 0u) ? 1u : 0u; mine = (j == x) ? c : mine; }
        if (sum == G) break;
        __builtin_amdgcn_s_sleep(1);
        if ((++sp & 255u) == 0u) { if (xb_ld(&bar[XB_TMO])) break; if (sp > XB_SPIN_CAP) { atomicAdd(&bar[XB_TMO], 1u); break; } }
    }
    nloc = mine > 0u ? mine : 1u; nx = cnt > 0u ? cnt : 1u;
}

__device__ __forceinline__ void xcd_barrier(const XcdBarrier& b) {
    asm volatile("s_waitcnt vmcnt(0)" ::: "memory");
    __syncthreads();
    if (threadIdx.x == 0) {
        unsigned* bar = b.bar;
        __builtin_amdgcn_s_waitcnt(0);
        unsigned nloc = b.st[0], nx = b.st[1];
        if (nloc == 0u) { xcd_barrier_complete(bar, b.x, nloc, nx); b.st[0] = nloc; b.st[1] = nx; }
        const unsigned old = xb_add(&bar[XB_XSUB(b.x)], 1u);
        const unsigned gen = old / nloc;
        if (old + 1u == (gen + 1u) * nloc) {
            __builtin_amdgcn_fence(__ATOMIC_RELEASE, "agent");
            asm volatile("s_waitcnt vmcnt(0)" ::: "memory");
            const unsigned og = xb_add(&bar[XB_TOP], 1u);
            const unsigned tg = og / nx;
            if (og + 1u == (tg + 1u) * nx) xb_add(&bar[XB_TOPGEN], 1u);
            else XB_SPIN(xb_ld(&bar[XB_TOPGEN]) == tg, bar);
            __builtin_amdgcn_fence(__ATOMIC_ACQUIRE, "agent");
            xb_add(&bar[XB_XGEN(b.x)], 1u);
            asm volatile("s_waitcnt vmcnt(0)" ::: "memory");
        } else {
            XB_SPIN(xb_ld(&bar[XB_XGEN(b.x)]) == gen, bar);
            __builtin_amdgcn_fence(__ATOMIC_ACQUIRE, "agent");
            asm volatile("s_waitcnt vmcnt(0)" ::: "memory");
        }
    }
    __syncthreads();
}
constexpr int N_STEPS = 27, STEP_PRO1 = 13, STEP_FIN = 26, KPL = 13;
enum { K_PRO = 100, K_FIN = 101, K_A = 0, K_A2 = 1, K_B = 2, K_C = 3, K_D = 4, K_E1 = 5, K_E2 = 6, K_E3 = 7, K_E4 = 8, K_F = 9, K_G = 10, K_H = 11 };
struct Args { const float* in[16]; float* out; unsigned char* ws; int ph_lo, ph_hi; };

enum { SEL_ALL = 0, SEL_PRO = 1, SEL_FIN = 2, SEL_B = 3, SEL_C = 4, SEL_D = 5, SEL_GEMM = 6, SEL_GATES = 7 };
template <int SEL> __global__ void __launch_bounds__(512, 2) mk_fwd(Args args) {
    extern __shared__ __attribute__((aligned(16))) unsigned char lds[];
    constexpr int G = 256; const int bid = blockIdx.x;
    {
        LAS unsigned char* ldsl0 = (LAS unsigned char*)lds;
        for (int u = threadIdx.x; u < (LDS_BYTES - LDSCTL_OFF) / 4; u += 512) ((LAS unsigned*)(ldsl0 + LDSCTL_OFF))[u] = 0u;
        __syncthreads();
    }
    if (MK_ONE_LAUNCH) (void)xcd_barrier_post((unsigned*)(args.ws + WS_CTL) + CW_BAR, (volatile LAS unsigned*)((LAS unsigned char*)lds + MISC_OFF) + 8);
#define GRID_BARRIER() do { XcdBarrier bar_; bar_.bar = (unsigned*)(ws + WS_CTL) + CW_BAR; bar_.x = xb_xcc_id(); bar_.st = (volatile LAS unsigned*)((LAS unsigned char*)lds + MISC_OFF) + 8; xcd_barrier(bar_); } while (0)

    int prep = 0;
    for (int step = args.ph_lo; step < args.ph_hi;) {
        int tid = threadIdx.x; asm volatile("" : "+v"(tid));
        const int lane = tid & 63, wave = __builtin_amdgcn_readfirstlane(tid >> 6), gw = bid * 8 + wave, NGW = G * 8;
        size_t zo = 0; asm volatile("" : "+s"(zo));
        unsigned char* ws = args.ws + zo;
        int zi = 0; asm volatile("" : "+s"(zi));
#define INP(k) (args.in[(k) + zi])
        LAS unsigned char* ldsl = (LAS unsigned char*)lds;
        const float* x_in = INP(0); float* xout = args.out + zo;
        float* ssq = (float*)(ws + WS_SSQ); float* wg = (float*)(ws + WS_WG); float* gates = (float*)(ws + WS_GATES);
        float* nloc = (float*)(ws + WS_NLOC); float* mloc = (float*)(ws + WS_MLOC); float* blast = (float*)(ws + WS_BLAST); float* mst = (float*)(ws + WS_MST);
        bf16* Wb = (bf16*)(ws + WS_W); bf16* xb = (bf16*)(ws + WS_XB); bf16* n1 = (bf16*)(ws + WS_N1); bf16* n2 = (bf16*)(ws + WS_N2); bf16* tT = (bf16*)(ws + WS_T); bf16* att = (bf16*)(ws + WS_ATT);
        bf16* cloc = (bf16*)(ws + WS_CLOC); bf16* mout = (bf16*)(ws + WS_MOUT); bf16* Yb = (bf16*)(ws + WS_Y); bf16* Zb = (bf16*)(ws + WS_Z); bf16* Hb = (bf16*)(ws + WS_H);
        const int layer = step >= STEP_PRO1 ? 1 : 0;
        const int kind = (step == 0 || step == STEP_PRO1) ? K_PRO : (step == STEP_FIN ? K_FIN : (step - 1) % KPL);
        float* ssqA = ssq + (size_t)(2 * layer) * M; float* ssqF = ssq + (size_t)(2 * layer + 1) * M; float* ssqN = ssq + (size_t)(2 * layer + 2) * M;

        if ((SEL == SEL_ALL || SEL == SEL_PRO) && kind == K_PRO) {
            LAS float* scr = (LAS float*)(ldsl + wave * 16384);
            const float* w_in = INP(2) + (size_t)layer * DM * DIN_SRC; const float* g_mix = INP(1) + layer * DM;
            const float* w_a = INP(9) + (size_t)layer * 512 * DM; const float* w_m = INP(10) + (size_t)layer * 512 * DM;
            const float* w_o = INP(11) + (size_t)layer * DM * DM; const float* g_ffn = INP(12) + layer * DM;
            const float* w_up = INP(13) + (size_t)layer * DM * DFF; const float* w_dn = INP(14) + (size_t)layer * DFF * DM;
            constexpr int I_IN = 16 * 176, I_A = 8 * 32, I_M = 8 * 32, I_O = 16 * 32, I_UP = 16 * 128, I_DN = 64 * 32, NITEMS = I_IN + I_A + I_M + I_O + I_UP + I_DN;
            for (int it = gw; it < NITEMS; it += NGW) {
                int r = it;
                if (r < I_IN) { transpose_item(w_in, DIN_SRC, 1, g_mix, Wb + W_IN, 1024, 176, scr, r, lane); continue; } r -= I_IN;
                if (r < I_A) { transpose_item(w_a, DM, 0, nullptr, Wb + W_A, 512, 32, scr, r, lane); continue; } r -= I_A;
                if (r < I_M) { transpose_item(w_m, DM, 0, nullptr, Wb + W_M, 512, 32, scr, r, lane); continue; } r -= I_M;
                if (r < I_O) { transpose_item(w_o, DM, 0, nullptr, Wb + W_O, 1024, 32, scr, r, lane); continue; } r -= I_O;
                if (r < I_UP) { transpose_item(w_up, DFF, 0, g_ffn, Wb + W_UP, 1024, 128, scr, r, lane); continue; } r -= I_UP;
                transpose_item(w_dn, DM, 0, nullptr, Wb + W_DN, 4096, 32, scr, r, lane);
            }
            for (int i = bid * 512 + tid; i < 8 * 1024; i += G * 512) { const int j = i >> 10, k = i & 1023; wg[i] = g_mix[k] * w_in[(size_t)k * DIN_SRC + 3584 + j]; }
            if (layer == 0) {
                for (int i = bid * 512 + tid; i < 4 * M; i += G * 512) ssq[M + i] = 0.f;
                for (int m = gw; m < M; m += NGW) {
                    const f32x4* xr = (const f32x4*)(x_in + (size_t)m * DM) + lane; f32x4 v[4]; float s = 0.f;
#pragma unroll
                    for (int j = 0; j < 4; ++j) { v[j] = xr[64 * j]; s += (v[j].x * v[j].x + v[j].y * v[j].y) + (v[j].z * v[j].z + v[j].w * v[j].w); }
                    s = wave_sum(s); if (lane == 0) ssq[m] = s;
                    unsigned long long* o8 = (unsigned long long*)(xb + (size_t)m * DM) + lane;
#pragma unroll
                    for (int j = 0; j < 4; ++j) o8[64 * j] = (unsigned long long)pk2(v[j].x, v[j].y) | ((unsigned long long)pk2(v[j].z, v[j].w) << 32);
                }
            }
        } else if ((SEL == SEL_ALL || SEL == SEL_FIN) && kind == K_FIN) {
            const float* gf = INP(15);
            for (int m = gw; m < M; m += NGW) {
                const float rs = rsqrtf(ssqN[m] * (1.0f / 1024.0f) + EPS);
                f32x4* xr = (f32x4*)(xout + (size_t)m * DM) + lane; const f32x4* gr = (const f32x4*)gf + lane;
#pragma unroll
                for (int j = 0; j < 4; ++j) { const f32x4 v = xr[64 * j], g = gr[64 * j]; xr[64 * j] = v * rs * g; }
            }
        } else if ((SEL == SEL_ALL || SEL == SEL_B) && kind == K_B) {
#if FAST_ATTN
#ifdef PROBE_SKIP_ATTN_REP
            if (prep == 0)
#endif
#if ATTN_LDS
            attn_mfma_lds(n1, tT, INP(7) + (size_t)layer * 8 * 513, att, ldsl, bid, G, wave, lane);
#else
            attn_mfma(n1, tT, INP(7) + (size_t)layer * 8 * 513, att, (LAS float*)ldsl, bid, G, wave, lane);
#endif
            __syncthreads();
#else
            attn_naive(n1, tT, INP(7) + (size_t)layer * 8 * 513, att, bid, G, wave, lane);
#endif
#if FAST_LOCAL
#ifdef PROBE_SKIP_LOCAL_REP
            if (prep == 0)
#endif
            mlstm_local_mfma(tT, gates, INP(3) + (size_t)layer * 4096, INP(4) + (size_t)layer * 1024, cloc, nloc, mloc, blast, (LAS float*)ldsl, bid, G, wave, lane);
#else
            mlstm_local_naive(n2, tT, gates, INP(3) + (size_t)layer * 4096, INP(4) + (size_t)layer * 1024, cloc, nloc, mloc, blast, (float*)lds, bid, G, tid);
#endif
        } else if ((SEL == SEL_ALL || SEL == SEL_C) && kind == K_C) {
            mlstm_scan(cloc, nloc, mloc, blast, mst, bid, G, tid, prep);
#if FAST_OUT
            conv_prepass(n2, INP(3) + (size_t)layer * 4096, INP(4) + (size_t)layer * 1024, n1, bid, G, tid);
#endif
        } else if ((SEL == SEL_ALL || SEL == SEL_D) && kind == K_D) {
#if FAST_OUT
            mlstm_out_mfma(n1, n2, tT, gates, cloc, nloc, mst, INP(8) + (size_t)layer * 512, mout, (LAS float*)ldsl, bid, G, wave, lane);
#else
            mlstm_out_naive(n2, tT, gates, INP(3) + (size_t)layer * 4096, INP(4) + (size_t)layer * 1024, cloc, nloc, mst, INP(8) + (size_t)layer * 512, mout, (float*)lds, bid, G, tid);
#endif
        } else if ((SEL == SEL_ALL || SEL == SEL_GEMM) && kind <= K_H && kind != K_A2) {
#ifndef GATES_ON
#define GATES_ON 1
#endif
#ifdef GEMM_ONLY
#define GEMM_ON(k) ((k) == GEMM_ONLY)
#else
#define GEMM_ON(k) true
#endif
            pg8::StaticOrder S;
#define RUN_GEMM_X(MODE, MR_, CU_, A_, BT_, N_, K_, O_, LDC_, Z_, SSQI_, BASE_, OUTF_, SSQO_, O2_, LDC2_, SPLIT_) do { pg8::Gemm g; g.A = (A_); g.Bt = (BT_); g.M = (MR_); g.N = (N_); g.K = (K_); \
                pg8::EpiAny<MODE> E; E.O = (O_); E.ldc = (LDC_); E.Z = (Z_); E.ssq_in = (SSQI_); E.base = (BASE_); E.outf = (OUTF_); E.ssq_out = (SSQO_); E.O2 = (O2_); E.ldc2 = (LDC2_); E.split = (SPLIT_); E.dry = prep; \
                S.init((MR_), (N_), G, (CU_)); pg8::gemm_phase<pg8::EpiAny<MODE>, pg8::StaticOrder, true, true>(ldsl, g, S, E); } while (0)
#define RUN_GEMM(MODE, A_, BT_, N_, K_, O_, LDC_, Z_, SSQI_, BASE_, OUTF_, SSQO_) RUN_GEMM_X(MODE, M, bid, A_, BT_, N_, K_, O_, LDC_, Z_, SSQI_, BASE_, OUTF_, SSQO_, nullptr, 0, 0)
            if (GEMM_ON(K_A) && kind == K_A) {
                RUN_GEMM_X(0, M, bid, xb, Wb + W_IN, 2560, 1024, n1, LD1, nullptr, ssqA, nullptr, nullptr, nullptr, n2, LD2, 1024);
                RUN_GEMM_X(6, 1536, (bid + G / 2) % G, Wb + W_IN + (size_t)2048 * 1024, xb, M, 1024, tT, M, nullptr, ssqA, nullptr, nullptr, nullptr, nullptr, 0, 0);
            }
            else if (GEMM_ON(K_E1) && kind == K_E1) RUN_GEMM(2, att, Wb + W_A, 1024, 512, Yb, 1024, nullptr, nullptr, nullptr, nullptr, nullptr);
            else if (GEMM_ON(K_E2) && kind == K_E2) RUN_GEMM(3, xb, Wb + W_IN + (size_t)3584 * 1024, 1024, 1024, Yb, 1024, nullptr, ssqA, nullptr, nullptr, nullptr);
            else if (GEMM_ON(K_E3) && kind == K_E3) RUN_GEMM(2, mout, Wb + W_M, 1024, 512, Zb, 1024, nullptr, nullptr, nullptr, nullptr, nullptr);
            else if (GEMM_ON(K_E4) && kind == K_E4) RUN_GEMM(4, xb, Wb + W_IN + (size_t)4608 * 1024, 1024, 1024, Yb, 1024, Zb, ssqA, nullptr, nullptr, nullptr);
            else if (GEMM_ON(K_F) && kind == K_F) { if (layer == 0) RUN_GEMM(5, Yb, Wb + W_O, 1024, 1024, xb, 1024, nullptr, nullptr, x_in, nullptr, ssqF);
                                                  else RUN_GEMM(7, Yb, Wb + W_O, 1024, 1024, xb, 1024, nullptr, nullptr, nullptr, nullptr, ssqF); }
            else if (GEMM_ON(K_G) && kind == K_G)  RUN_GEMM(1, xb, Wb + W_UP, 4096, 1024, Hb, DFF, nullptr, ssqF, nullptr, nullptr, nullptr);
            else if (GEMM_ON(K_H)) { if (layer == 0) RUN_GEMM(7, Hb, Wb + W_DN, 1024, 4096, xb, 1024, nullptr, nullptr, nullptr, nullptr, ssqN);
                                     else RUN_GEMM(8, Hb, Wb + W_DN, 1024, 4096, xb, 1024, nullptr, nullptr, nullptr, xout, ssqN); }
        } else if ((SEL == SEL_ALL || SEL == SEL_GATES) && kind == K_A2) {
            gates_phase(x_in, xb, layer, wg, INP(5) + layer * 4, INP(6) + layer * 4, gates, (LAS float*)ldsl, bid, tid);
        }
        const bool seam = !(kind == K_A || kind == K_E1 || kind == K_E2 || kind == K_E3);
        if (seam && step + 1 < args.ph_hi) { if (MK_ONE_LAUNCH) GRID_BARRIER(); }
#ifdef PROBE_BAR
        if (step == 3) { for (int pb = 0; pb < PROBE_BAR; ++pb) GRID_BARRIER(); }
#endif
#ifdef PROBE_REPEAT
        if ((PROBE_REPEAT_COND) && prep + 1 < PROBE_REPEAT) { ++prep; } else { prep = 0; ++step; }
#else
        ++step;
#endif
    }
}

extern "C" void kernel_launch(void* const* d_in, const int* in_sizes, int n_in, void* d_out, int out_size, void* d_ws, size_t ws_size, hipStream_t stream) {
    static int grid = 0;
    if (grid == 0) {
        if (n_in != 16 || in_sizes[0] != M * DM || out_size != M * DM || ws_size < WS_END) { fprintf(stderr, "kernel_launch: unexpected shapes (n_in %d, in0 %d, out %d, ws %zu)\n", n_in, n_in > 0 ? in_sizes[0] : -1, out_size, ws_size); grid = -1; return; }
        int dev = 0, cus = 0;
        if (hipGetDevice(&dev) != hipSuccess || hipDeviceGetAttribute(&cus, hipDeviceAttributeMultiprocessorCount, dev) != hipSuccess) { grid = -1; return; }
        bool ok = true;
#if MK_ONE_LAUNCH
        ok &= hipFuncSetAttribute((const void*)mk_fwd<SEL_ALL>, hipFuncAttributeMaxDynamicSharedMemorySize, LDS_BYTES) == hipSuccess;
#endif
#if !MK_ONE_LAUNCH
        ok &= hipFuncSetAttribute((const void*)mk_fwd<SEL_PRO>, hipFuncAttributeMaxDynamicSharedMemorySize, LDS_BYTES) == hipSuccess;
        ok &= hipFuncSetAttribute((const void*)mk_fwd<SEL_FIN>, hipFuncAttributeMaxDynamicSharedMemorySize, LDS_BYTES) == hipSuccess;
        ok &= hipFuncSetAttribute((const void*)mk_fwd<SEL_B>, hipFuncAttributeMaxDynamicSharedMemorySize, LDS_BYTES) == hipSuccess;
        ok &= hipFuncSetAttribute((const void*)mk_fwd<SEL_C>, hipFuncAttributeMaxDynamicSharedMemorySize, LDS_BYTES) == hipSuccess;
        ok &= hipFuncSetAttribute((const void*)mk_fwd<SEL_D>, hipFuncAttributeMaxDynamicSharedMemorySize, LDS_BYTES) == hipSuccess;
        ok &= hipFuncSetAttribute((const void*)mk_fwd<SEL_GATES>, hipFuncAttributeMaxDynamicSharedMemorySize, LDS_BYTES) == hipSuccess;
        ok &= hipFuncSetAttribute((const void*)mk_fwd<SEL_GEMM>, hipFuncAttributeMaxDynamicSharedMemorySize, LDS_BYTES) == hipSuccess;
#endif
        if (!ok) { fprintf(stderr, "kernel_launch: hipFuncSetAttribute failed\n"); grid = -1; return; }
        (void)hipGetLastError();
        if (cus < 256) { fprintf(stderr, "kernel_launch: needs 256 CUs, device has %d\n", cus); grid = -1; return; }
        grid = 256;
    }
    if (grid < 0) return;
    if (hipMemsetAsync((char*)d_ws + WS_CTL, 0, CTL_ZERO_BYTES, stream) != hipSuccess) return;
    Args a{};
    for (int i = 0; i < 16; ++i) a.in[i] = (const float*)d_in[i];
    a.out = (float*)d_out; a.ws = (unsigned char*)d_ws;
#if MK_ONE_LAUNCH
    {
        a.ph_lo = 0; a.ph_hi = N_STEPS;
        hipLaunchKernelGGL(mk_fwd<SEL_ALL>, dim3(grid), dim3(512), LDS_BYTES, stream, a);
    }
#else
    {
        int s = 0;
        while (s < N_STEPS) {
            int e = s + 1;
            const int k = (s == 0 || s == STEP_PRO1 || s == STEP_FIN) ? -1 : (s - 1) % KPL;
            if (k == K_E1) e = s + 4;
            a.ph_lo = s; a.ph_hi = e;
            if (k == -1 && s != STEP_FIN) hipLaunchKernelGGL(mk_fwd<SEL_PRO>, dim3(grid), dim3(512), LDS_BYTES, stream, a);
            else if (k == -1) hipLaunchKernelGGL(mk_fwd<SEL_FIN>, dim3(grid), dim3(512), LDS_BYTES, stream, a);
            else if (k == K_A2) hipLaunchKernelGGL(mk_fwd<SEL_GATES>, dim3(grid), dim3(512), LDS_BYTES, stream, a);
            else if (k == K_B) hipLaunchKernelGGL(mk_fwd<SEL_B>, dim3(grid), dim3(512), LDS_BYTES, stream, a);
            else if (k == K_C) hipLaunchKernelGGL(mk_fwd<SEL_C>, dim3(grid), dim3(512), LDS_BYTES, stream, a);
            else if (k == K_D) hipLaunchKernelGGL(mk_fwd<SEL_D>, dim3(grid), dim3(512), LDS_BYTES, stream, a);
            else hipLaunchKernelGGL(mk_fwd<SEL_GEMM>, dim3(grid), dim3(512), LDS_BYTES, stream, a);
            s = e;
        }
    }
#endif
}
```
